# Optimizing an MI355X kernel written in HIP

```python
import math
import jax, jax.numpy as jnp
from jax import lax
import numpy as np

D_MODEL = 1024
BATCH = 32
SEQ = 2048
DEPTH = 1

HEAD_DIM = 64
DSA_HEADS = 8
KV_LATENT = 256
IDX_HEADS = 4
IDX_DIM = 64
TOPK_MAX = 256
Q_BLOCK = 128
DIL_GROUPS = ((128, 1), (512, 4), (2048, 16))
N_DIL_GROUPS = 3
DIL_HEADS_PER_GROUP = 4
DIL_HEADS = N_DIL_GROUPS * DIL_HEADS_PER_GROUP
N_BRANCHES = 2
NUM_BUCKETS = 32
MAX_DISTANCE = 2048
N_REL_HEADS = DSA_HEADS + DIL_HEADS
N_GROUPS = 4
EXPERTS_PER_GROUP = 8
N_EXPERTS = N_GROUPS * EXPERTS_PER_GROUP
EXPERT_FF = 512
TOP_K_INNER = 2
RMS_EPS = 1e-6
NEG = -1e30

COLS_DSA_Q = DSA_HEADS * HEAD_DIM
COLS_KV = KV_LATENT
COLS_IDX_Q = IDX_HEADS * IDX_DIM
COLS_IDX_K = IDX_DIM
COLS_IDX_W = IDX_HEADS
COLS_DIL = 3 * DIL_HEADS * HEAD_DIM
COLS_GATE = N_BRANCHES * D_MODEL
IN_COLS = COLS_DSA_Q + COLS_KV + COLS_IDX_Q + COLS_IDX_K + COLS_IDX_W + COLS_DIL + COLS_GATE
SPLIT_POINTS = [COLS_DSA_Q,
                COLS_DSA_Q + COLS_KV,
                COLS_DSA_Q + COLS_KV + COLS_IDX_Q,
                COLS_DSA_Q + COLS_KV + COLS_IDX_Q + COLS_IDX_K,
                COLS_DSA_Q + COLS_KV + COLS_IDX_Q + COLS_IDX_K + COLS_IDX_W,
                COLS_DSA_Q + COLS_KV + COLS_IDX_Q + COLS_IDX_K + COLS_IDX_W + COLS_DIL]
DIL_OUT = DIL_HEADS_PER_GROUP * HEAD_DIM

kernel_name = "hybrid_dsa_dilated_hmoe_block"


def rms_norm(x, g):
    xf = x.astype(jnp.float32)
    y = xf * lax.rsqrt(jnp.mean(xf * xf, axis=-1, keepdims=True) + RMS_EPS)
    return (y * g.astype(jnp.float32)).astype(x.dtype)


def rel_bucket(dist):
    max_exact = NUM_BUCKETS // 2
    n = jnp.maximum(dist, 0)
    nf = jnp.maximum(n, 1).astype(jnp.float32)
    large = max_exact + (jnp.log(nf / max_exact) / math.log(MAX_DISTANCE / max_exact)
                         * (NUM_BUCKETS - max_exact)).astype(jnp.int32)
    large = jnp.minimum(large, NUM_BUCKETS - 1)
    return jnp.where(n < max_exact, n, large)


def dsa_branch(q, c, q_idx, k_idx, w_idx, w_uk, w_uv, bias_tab):
    B, L = c.shape[:2]
    topk = min(TOPK_MAX, L // 4)
    nb = L // Q_BLOCK
    q_lat = jnp.einsum('blhd,hcd->blhc', q, w_uk) * HEAD_DIM ** -0.5
    k_idx_f = k_idx.astype(jnp.float32)
    bias_tab_f = bias_tab.astype(jnp.float32)
    key_pos = jnp.arange(L)

    def to_blocks(a):
        return jnp.moveaxis(a.reshape((B, nb, Q_BLOCK) + a.shape[2:]), 1, 0)

    def block_fn(args):
        n, qlb, qib, wib = args
        qpos = n * Q_BLOCK + jnp.arange(Q_BLOCK)
        s = jnp.einsum('bqhd,bsd->bqhs', qib.astype(jnp.float32), k_idx_f) * IDX_DIM ** -0.5
        score = jnp.einsum('bqh,bqhs->bqs', wib.astype(jnp.float32) * IDX_HEADS ** -0.5,
                           jax.nn.relu(s))
        causal = key_pos[None, :] <= qpos[:, None]
        score = jnp.where(causal[None], score, NEG)
        _, sel = lax.top_k(score, topk)
        valid = sel <= qpos[None, :, None]
        c_sel = jax.vmap(lambda cb, ib: cb[ib])(c, sel)
        logits = jnp.einsum('bqhc,bqkc->bqhk', qlb, c_sel).astype(jnp.float32)
        bias = bias_tab_f[rel_bucket(qpos[None, :, None] - sel)]
        logits = logits + jnp.moveaxis(bias, -1, 2)
        logits = jnp.where(valid[:, :, None, :], logits, NEG)
        p = jax.nn.softmax(logits, axis=-1).astype(c.dtype)
        o_lat = jnp.einsum('bqhk,bqkc->bqhc', p, c_sel)
        return jnp.einsum('bqhc,hcd->bqhd', o_lat, w_uv)

    out = lax.map(block_fn, (jnp.arange(nb), to_blocks(q_lat), to_blocks(q_idx), to_blocks(w_idx)))
    return jnp.moveaxis(out, 0, 1).reshape(B, L, DSA_HEADS * HEAD_DIM)


def dilated_group(q, k, v, window, dilation, bias_tab):
    B, L, H, dh = q.shape
    w = window // dilation
    ls = L // dilation
    nb = -(-ls // w)
    pad = nb * w - ls

    def to_sub(a):
        a = a.reshape(B, ls, dilation, H, dh).transpose(0, 2, 1, 3, 4)
        a = jnp.pad(a, ((0, 0), (0, 0), (0, pad), (0, 0), (0, 0)))
        return a.reshape(B, dilation, nb, w, H, dh)

    def with_prev(a):
        prev = jnp.pad(a, ((0, 0), (0, 0), (1, 0), (0, 0), (0, 0), (0, 0)))[:, :, :-1]
        return jnp.concatenate([prev, a], axis=3)

    qs = to_sub(q)
    kb = with_prev(to_sub(k))
    vb = with_prev(to_sub(v))
    qf = jnp.arange(w)[:, None] + w
    kf = jnp.arange(2 * w)[None, :]
    step = qf - kf
    key_sub = jnp.arange(nb)[:, None, None] * w + kf[None] - w
    mask = (step >= 0)[None] & (step <= w)[None] & (key_sub >= 0)
    bias = bias_tab.astype(jnp.float32)[rel_bucket(step * dilation)]
    logits = jnp.einsum('brnqhd,brnkhd->brnhqk', qs, kb).astype(jnp.float32) * dh ** -0.5
    logits = logits + jnp.moveaxis(bias, -1, 0)[None, None, None]
    logits = jnp.where(mask[None, None, :, None], logits, NEG)
    m = jnp.max(logits, axis=-1, keepdims=True)
    e = jnp.exp(logits - m)
    s = jnp.sum(e, axis=-1, keepdims=True)
    o = jnp.einsum('brnhqk,brnkhd->brnqhd', (e / s).astype(v.dtype), vb)
    lse = (m + jnp.log(s))[..., 0]
    o = o.reshape(B, dilation, nb * w, H, dh)[:, :, :ls].transpose(0, 2, 1, 3, 4).reshape(B, L, H, dh)
    lse = lse.transpose(0, 1, 2, 4, 3).reshape(B, dilation, nb * w, H)[:, :, :ls]
    lse = lse.transpose(0, 2, 1, 3).reshape(B, L, H)
    return o, lse


def dilated_branch(dil, bias_tab):
    B, L = dil.shape[:2]
    qkv = dil.reshape(B, L, 3, N_DIL_GROUPS, DIL_HEADS_PER_GROUP, HEAD_DIM)
    outs, lses = [], []
    for g, (window, dilation) in enumerate(DIL_GROUPS):
        tab = bias_tab[:, DSA_HEADS + g * DIL_HEADS_PER_GROUP: DSA_HEADS + (g + 1) * DIL_HEADS_PER_GROUP]
        o, lse = dilated_group(qkv[:, :, 0, g], qkv[:, :, 1, g], qkv[:, :, 2, g], window, dilation, tab)
        outs.append(o)
        lses.append(lse)
    alpha = jax.nn.softmax(jnp.stack(lses, axis=0), axis=0)
    o = jnp.sum(alpha[..., None].astype(dil.dtype) * jnp.stack(outs, axis=0), axis=0)
    return o.reshape(B, L, DIL_OUT)


def hier_moe(h, w_rg, b_rg, w_re, b_re, w_gate, w_up, w_down):
    B, L, D = h.shape
    t = h.reshape(-1, D)
    n_tok = t.shape[0]
    g_logits = (t @ w_rg + b_rg).astype(jnp.float32)
    g_prob = jax.nn.softmax(g_logits, axis=-1)
    g_sel = jnp.argmax(g_logits, axis=-1)
    p_g = jnp.take_along_axis(g_prob, g_sel[:, None], axis=1)[:, 0]
    e_logits = (jnp.einsum('nd,gde->nge', t, w_re) + b_re).astype(jnp.float32)
    e_logits = jnp.take_along_axis(e_logits, g_sel[:, None, None], axis=1)[:, 0]
    top_vals, top_idx = lax.top_k(e_logits, TOP_K_INNER)
    weights = p_g[:, None] * jax.nn.softmax(top_vals, axis=-1)
    gid = g_sel[:, None] * EXPERTS_PER_GROUP + top_idx
    combine = jnp.zeros((n_tok, N_EXPERTS), jnp.float32).at[jnp.arange(n_tok)[:, None], gid].add(weights)
    combine = combine.astype(t.dtype)
    out = jnp.zeros_like(t)
    for e in range(N_EXPERTS):
        hid = jax.nn.silu(t @ w_gate[e]) * (t @ w_up[e])
        out = out + combine[:, e:e + 1] * (hid @ w_down[e])
    return out.reshape(B, L, D)


def setup_inputs(seed: int = 0) -> dict:
    key = jax.random.key(seed)
    ks = jax.random.split(key, 20)
    f32 = jnp.float32

    def nrm(k, shape, scale):
        return jax.random.normal(k, shape, f32) * scale

    def gain(k, shape):
        return jnp.ones(shape, f32) + 0.01 * jax.random.normal(k, shape, f32)

    return {
        "x": jax.random.normal(ks[0], (BATCH, SEQ, D_MODEL), f32),
        "attn_norm": gain(ks[1], (DEPTH, D_MODEL)),
        "w_in": nrm(ks[2], (DEPTH, D_MODEL, IN_COLS), D_MODEL ** -0.5),
        "kv_norm": gain(ks[3], (DEPTH, KV_LATENT)),
        "w_uk": nrm(ks[4], (DEPTH, DSA_HEADS, KV_LATENT, HEAD_DIM), KV_LATENT ** -0.5),
        "w_uv": nrm(ks[5], (DEPTH, DSA_HEADS, KV_LATENT, HEAD_DIM), KV_LATENT ** -0.5),
        "rel_bias": nrm(ks[6], (NUM_BUCKETS, N_REL_HEADS), 0.1),
        "w_branch_a": nrm(ks[7], (DEPTH, DSA_HEADS * HEAD_DIM, D_MODEL), (DSA_HEADS * HEAD_DIM) ** -0.5),
        "w_branch_b": nrm(ks[8], (DEPTH, DIL_OUT, D_MODEL), DIL_OUT ** -0.5),
        "w_out": nrm(ks[9], (DEPTH, D_MODEL, D_MODEL), D_MODEL ** -0.5),
        "ffn_norm": gain(ks[10], (DEPTH, D_MODEL)),
        "w_router_group": nrm(ks[11], (DEPTH, D_MODEL, N_GROUPS), D_MODEL ** -0.5),
        "b_router_group": nrm(ks[12], (DEPTH, N_GROUPS), 0.01),
        "w_router_expert": nrm(ks[13], (DEPTH, N_GROUPS, D_MODEL, EXPERTS_PER_GROUP), D_MODEL ** -0.5),
        "b_router_expert": nrm(ks[14], (DEPTH, N_GROUPS, EXPERTS_PER_GROUP), 0.01),
        "w_gate": nrm(ks[15], (DEPTH, N_EXPERTS, D_MODEL, EXPERT_FF), D_MODEL ** -0.5),
        "w_up": nrm(ks[16], (DEPTH, N_EXPERTS, D_MODEL, EXPERT_FF), D_MODEL ** -0.5),
        "w_down": nrm(ks[17], (DEPTH, N_EXPERTS, EXPERT_FF, D_MODEL), EXPERT_FF ** -0.5),
        "final_norm": gain(ks[18], (D_MODEL,)),
    }


def reference(x, attn_norm, w_in, kv_norm, w_uk, w_uv, rel_bias, w_branch_a, w_branch_b, w_out,
              ffn_norm, w_router_group, b_router_group, w_router_expert, b_router_expert,
              w_gate, w_up, w_down, final_norm):
    B, L, D = x.shape
    h = x
    for layer in range(DEPTH):
        u = rms_norm(h, attn_norm[layer])
        proj = u @ w_in[layer]
        q_a, c_kv, q_idx, k_idx, w_idx, dil, gates = jnp.split(proj, SPLIT_POINTS, axis=-1)
        c_kv = rms_norm(c_kv, kv_norm[layer])
        y_a = dsa_branch(q_a.reshape(B, L, DSA_HEADS, HEAD_DIM), c_kv,
                         q_idx.reshape(B, L, IDX_HEADS, IDX_DIM), k_idx, w_idx,
                         w_uk[layer], w_uv[layer], rel_bias[:, :DSA_HEADS])
        y_b = dilated_branch(dil, rel_bias)
        g = jax.nn.sigmoid(gates.reshape(B, L, N_BRANCHES, D).astype(jnp.float32)).astype(x.dtype)
        mixed = g[:, :, 0] * (y_a @ w_branch_a[layer]) + g[:, :, 1] * (y_b @ w_branch_b[layer])
        h = h + mixed @ w_out[layer]
        h = h + hier_moe(rms_norm(h, ffn_norm[layer]), w_router_group[layer], b_router_group[layer],
                         w_router_expert[layer], b_router_expert[layer],
                         w_gate[layer], w_up[layer], w_down[layer])
    return rms_norm(h, final_norm)
```

```cpp
#include <hip/hip_runtime.h>
#include <stdint.h>
#include <stdio.h>
#define PROBE_DUP 0
#define TK_REP_SEL 1
#define TK_REP_TIE 1

typedef unsigned short bf16_t;
#define DEVI __device__ __forceinline__

constexpr int BATCH = 32, SEQ = 2048, DM = 1024, NTOK = BATCH * SEQ;
constexpr int IN_COLS = 5444;
constexpr int NEXP = 32, EFF = 512;
constexpr float RMS_EPS = 1e-6f;
constexpr float LOG2E = 1.4426950408889634f;
constexpr float QSCALE = 0.125f * LOG2E;

constexpr size_t MiB = 1ull << 20;
constexpr size_t OFF_BAR   = 0;
constexpr size_t OFF_SSQ   = 1 * MiB;
constexpr size_t OFF_WI    = 2 * MiB;
constexpr size_t OFF_ECNT  = 3 * MiB;
constexpr size_t OFF_LSE   = 4 * MiB;
constexpr size_t OFF_WTIN  = 8 * MiB;
constexpr size_t OFF_WSM   = 20 * MiB;
constexpr size_t OFF_OG    = 24 * MiB;
constexpr size_t OFF_R1    = 120 * MiB;
constexpr size_t OFF_QA    = 248 * MiB;
constexpr size_t OFF_CR    = 312 * MiB;
constexpr size_t OFF_QI    = 344 * MiB;
constexpr size_t OFF_YA    = 312 * MiB;
constexpr int    YAB_LD    = 768;
constexpr size_t OFF_KI    = 376 * MiB;
constexpr size_t OFF_DIL   = 384 * MiB;
constexpr size_t DIL_SZ    = (size_t)12 * NTOK * 64;
constexpr size_t OFF_YB    = 944 * MiB;
constexpr size_t OFF_MIX   = 416 * MiB;
constexpr size_t OFF_G     = 672 * MiB;
constexpr size_t OFF_H     = 672 * MiB;
constexpr size_t OFF_SEL   = 928 * MiB;

DEVI float bf2f(bf16_t v) { return __uint_as_float(((unsigned)v) << 16); }
DEVI bf16_t f2bf(float f) { unsigned u = __float_as_uint(f); u += 0x7FFFu + ((u >> 16) & 1u); return (bf16_t)(u >> 16); }

DEVI int rel_bucket(int n) {
    if (n < 16) return n < 0 ? 0 : n;
    int b = 16;
    b += (n >= 22) + (n >= 30) + (n >= 40) + (n >= 54) + (n >= 73) + (n >= 99) + (n >= 134) + (n >= 182);
    b += (n >= 246) + (n >= 332) + (n >= 450) + (n >= 609) + (n >= 825) + (n >= 1117) + (n >= 1513);
    return b;
}
DEVI int dil_r(int g) { return g == 0 ? 1 : (g == 1 ? 4 : 16); }


#define LAS3 __attribute__((address_space(3)))
DEVI int opaque_tid() { int t = threadIdx.x; asm volatile("" : "+v"(t)); return t; }
typedef short bf16x8 __attribute__((ext_vector_type(8)));
typedef float f32x4 __attribute__((ext_vector_type(4)));
typedef float f32x2 __attribute__((ext_vector_type(2)));
typedef unsigned u32x4 __attribute__((ext_vector_type(4)));
typedef unsigned u32x2 __attribute__((ext_vector_type(2)));

constexpr int LDS_TOTAL = 163840;
constexpr int LDS_TAB   = 131072;
constexpr int LDS_XB    = LDS_TOTAL - 16;

constexpr size_t OFF_LIST  = 8 * MiB;
constexpr size_t OFF_WEXP  = 16 * MiB;
constexpr size_t OFF_WDN   = OFF_WEXP + 64 * MiB;
constexpr size_t OFF_TT    = OFF_R1;
constexpr size_t OFF_HID   = 248 * MiB;
constexpr size_t OFF_EO    = 384 * MiB;
constexpr size_t OFF_RT    = 5 * MiB;
constexpr size_t OFF_U     = OFF_R1;
constexpr size_t OFF_WKV   = OFF_WSM;
constexpr size_t OFF_WAT   = OFF_WSM + 512 * 1024;
constexpr size_t OFF_WBT   = OFF_WSM + 1536 * 1024;
constexpr size_t OFF_WOT   = 984 * MiB;
constexpr size_t OFF_U8    = OFF_OG;
constexpr size_t OFF_WT8   = 976 * MiB;
constexpr size_t OFF_WAB   = 982 * MiB;
constexpr int NPAD = 5632;

typedef __bf16 bf16x2_t __attribute__((ext_vector_type(2)));
DEVI float fadd1(float a, float b) { float d; asm("v_add_f32 %0, %1, %2" : "=v"(d) : "v"(a), "v"(b)); return d; }
DEVI unsigned cvt_pk_bf16(float lo, float hi) { f32x2 v = {lo, hi}; bf16x2_t r = __builtin_convertvector(v, bf16x2_t); return __builtin_bit_cast(unsigned, r); }
DEVI u32x4 pack8(const f32x4& a, const f32x4& b) { u32x4 w; w.x = cvt_pk_bf16(a[0], a[1]); w.y = cvt_pk_bf16(a[2], a[3]); w.z = cvt_pk_bf16(b[0], b[1]); w.w = cvt_pk_bf16(b[2], b[3]); return w; }
DEVI unsigned pk4_fp8(float a, float b, float c, float d) { unsigned w = 0u; w = __builtin_amdgcn_cvt_pk_fp8_f32(a, b, w, false); w = __builtin_amdgcn_cvt_pk_fp8_f32(c, d, w, true); return w; }
constexpr float D8_SCALE = 8.0f;
constexpr float W8_SCALE = 32.0f, W8_INV = 1.0f / 32.0f;
DEVI u32x4 fp8x8_to_bf16(u32x2 w, float scale) {
    const f32x2 a = __builtin_amdgcn_cvt_pk_f32_fp8(w.x, false), b = __builtin_amdgcn_cvt_pk_f32_fp8(w.x, true), c = __builtin_amdgcn_cvt_pk_f32_fp8(w.y, false), d = __builtin_amdgcn_cvt_pk_f32_fp8(w.y, true);
    u32x4 r; r.x = cvt_pk_bf16(a[0] * scale, a[1] * scale); r.y = cvt_pk_bf16(b[0] * scale, b[1] * scale); r.z = cvt_pk_bf16(c[0] * scale, c[1] * scale); r.w = cvt_pk_bf16(d[0] * scale, d[1] * scale); return r;
}
DEVI u32x4 fp8x8_to_bf16(u32x2 w) {
    const f32x2 a = __builtin_amdgcn_cvt_pk_f32_fp8(w.x, false), b = __builtin_amdgcn_cvt_pk_f32_fp8(w.x, true), c = __builtin_amdgcn_cvt_pk_f32_fp8(w.y, false), d = __builtin_amdgcn_cvt_pk_f32_fp8(w.y, true);
    u32x4 r; r.x = cvt_pk_bf16(a[0], a[1]); r.y = cvt_pk_bf16(b[0], b[1]); r.z = cvt_pk_bf16(c[0], c[1]); r.w = cvt_pk_bf16(d[0], d[1]); return r;
}
DEVI unsigned pk4_u8(float a, float b, float c, float d) { unsigned w = 0u; w = __builtin_amdgcn_cvt_pk_u8_f32(a, 0, w); w = __builtin_amdgcn_cvt_pk_u8_f32(b, 1, w); w = __builtin_amdgcn_cvt_pk_u8_f32(c, 2, w); return __builtin_amdgcn_cvt_pk_u8_f32(d, 3, w); }
DEVI float bflo(unsigned w) { return __uint_as_float(w << 16); }
DEVI float bfhi(unsigned w) { return __uint_as_float(w & 0xFFFF0000u); }
DEVI float fast_sigmoid(float v) { return __builtin_amdgcn_rcpf(1.0f + __expf(-v)); }

struct Params {
    const float *x, *attn_norm, *w_in, *kv_norm, *w_uk, *w_uv, *rel_bias, *w_a, *w_b, *w_out, *ffn_norm, *w_rg, *b_rg, *w_re, *b_re, *w_gate, *w_up, *w_down, *final_norm;
    float* out; char* ws;
};

DEVI void tr_tile(const float* src, int lds_, int ncols_valid, bf16_t* dst, int ldd, const float* rs, LAS3 float* tile) {
    const int tid = opaque_tid();
    { const int c = tid & 63, cs = c < ncols_valid ? c : 0; float v[8], sc[8];
#pragma unroll
      for (int i = 0; i < 8; ++i) { const int r = (tid >> 6) + 8 * i; v[i] = src[(size_t)r * lds_ + cs]; sc[i] = rs ? rs[r] : 1.0f; }
#pragma unroll
      for (int i = 0; i < 8; ++i) tile[((tid >> 6) + 8 * i) * 65 + c] = c < ncols_valid ? v[i] * sc[i] : 0.f; }
    __syncthreads();
    { const int c = tid >> 3, r0 = (tid & 7) * 8;
      u32x4 w;
#pragma unroll
      for (int q = 0; q < 4; ++q) w[q] = cvt_pk_bf16(tile[(r0 + 2 * q) * 65 + c], tile[(r0 + 2 * q + 1) * 65 + c]);
      *(u32x4*)(dst + (size_t)c * ldd + r0) = w; }
    __syncthreads();
}

DEVI void tr_tile8(const float* src, int lds_, unsigned char* dst, int ldd, float scale, LAS3 float* tile, int ncols_valid = 64) {
    const int tid = opaque_tid();
    { const int c = tid & 63, cs = c < ncols_valid ? c : 0; float v[8];
#pragma unroll
      for (int i = 0; i < 8; ++i) v[i] = src[(size_t)((tid >> 6) + 8 * i) * lds_ + cs];
#pragma unroll
      for (int i = 0; i < 8; ++i) tile[((tid >> 6) + 8 * i) * 65 + c] = c < ncols_valid ? v[i] * scale : 0.f; }
    __syncthreads();
    { const int c = tid >> 3, r0 = (tid & 7) * 8; u32x2 w;
      w.x = pk4_fp8(tile[(r0 + 0) * 65 + c], tile[(r0 + 1) * 65 + c], tile[(r0 + 2) * 65 + c], tile[(r0 + 3) * 65 + c]);
      w.y = pk4_fp8(tile[(r0 + 4) * 65 + c], tile[(r0 + 5) * 65 + c], tile[(r0 + 6) * 65 + c], tile[(r0 + 7) * 65 + c]);
      *(u32x2*)(dst + (size_t)c * ldd + r0) = w; }
    __syncthreads();
}

DEVI void phase_prologue(const Params& p, LAS3 unsigned char* lds) {
    LAS3 float* tile = (LAS3 float*)lds;
    const int G = gridDim.x, c = blockIdx.x;
    for (int t = c; t < 88 * 16; t += G) {
        const int nt = t >> 4, kt = t & 15, n0 = nt * 64;
        int sc, nv;
        if (n0 < 1088) { sc = n0; nv = 64; } else if (n0 == 1088) { sc = 1088; nv = 4; } else if (n0 < 1280) { sc = 0; nv = 0; }
        else if (n0 < 3584) { sc = 1092 + (n0 - 1280); nv = 64; } else { sc = 3396 + (n0 - 3584); nv = 64; }
        tr_tile8(p.w_in + (size_t)kt * 64 * IN_COLS + sc, IN_COLS, (unsigned char*)(p.ws + OFF_WT8) + (size_t)n0 * 1024 + kt * 64, 1024, W8_SCALE, tile, nv);
    }
    for (int t = c; t < 16 * 4; t += G) {
        const int which = t >> 5, h = (t >> 2) & 7, kt = t & 3; const float* W = which ? p.w_uv : p.w_uk;
        tr_tile(W + ((size_t)h * 256 + kt * 64) * 64, 64, 64, (bf16_t*)(p.ws + OFF_WKV) + (size_t)(which * 512 + h * 64) * 256 + kt * 64, 256, p.kv_norm + kt * 64, tile);
    }
    for (int t = c; t < 16 * 12 * 2; t += G) {
        const int half = t / 192, r = t % 192, nt = r / 12, kt = r % 12; const bool real = half == 0 ? kt < 8 : kt >= 8;
        const float* src = half == 0 ? p.w_a + (size_t)kt * 64 * 1024 + nt * 64 : p.w_b + (size_t)(kt - 8) * 64 * 1024 + nt * 64;
        tr_tile8(real ? src : p.w_a, 1024, (unsigned char*)(p.ws + OFF_WAB) + (size_t)((nt >> 1) * 256 + half * 128 + (nt & 1) * 64) * YAB_LD + kt * 64, YAB_LD, W8_SCALE, tile, real ? 64 : 0);
    }
    for (int t = c; t < 16 * 16; t += G) { const int nt = t >> 4, kt = t & 15; tr_tile8(p.w_out + (size_t)kt * 64 * 1024 + nt * 64, 1024, (unsigned char*)(p.ws + OFF_WOT) + (size_t)nt * 64 * 1024 + kt * 64, 1024, W8_SCALE, tile); }
    const int lane = opaque_tid() & 63, wv = opaque_tid() >> 6;
    f32x4 gn[4];
#pragma unroll
    for (int q = 0; q < 4; ++q) gn[q] = *(const f32x4*)(p.attn_norm + q * 256 + 4 * lane);
    {
        const int st = G * 8; int tok = c * 8 + wv; f32x4 nx[2][4];
#pragma unroll
        for (int k = 0; k < 2; ++k) if (tok + k * st < NTOK) {
#pragma unroll
            for (int q = 0; q < 4; ++q) nx[k][q] = *(const f32x4*)(p.x + (size_t)(tok + k * st) * 1024 + q * 256 + 4 * lane);
        }
#pragma unroll 1
        for (; tok < NTOK; tok += 2 * st) {
            f32x4 v[2][4];
#pragma unroll
            for (int k = 0; k < 2; ++k)
#pragma unroll
                for (int q = 0; q < 4; ++q) v[k][q] = nx[k][q];
#pragma unroll
            for (int k = 0; k < 2; ++k) if (tok + (2 + k) * st < NTOK) {
#pragma unroll
                for (int q = 0; q < 4; ++q) nx[k][q] = *(const f32x4*)(p.x + (size_t)(tok + (2 + k) * st) * 1024 + q * 256 + 4 * lane);
            }
#pragma unroll
            for (int k = 0; k < 2; ++k) if (tok + k * st < NTOK) {
                float ss = 0.f;
#pragma unroll
                for (int q = 0; q < 4; ++q) ss += v[k][q][0] * v[k][q][0] + v[k][q][1] * v[k][q][1] + v[k][q][2] * v[k][q][2] + v[k][q][3] * v[k][q][3];
#pragma unroll
                for (int o = 32; o > 0; o >>= 1) ss += __shfl_xor(ss, o);
                const float rinv = rsqrtf(ss * (1.0f / 1024.0f) + RMS_EPS);
#pragma unroll
                for (int q = 0; q < 4; ++q)
                    *(unsigned*)((unsigned char*)(p.ws + OFF_U8) + (size_t)(tok + k * st) * 1024 + q * 256 + 4 * lane) = pk4_fp8(v[k][q][0] * rinv * gn[q][0], v[k][q][1] * rinv * gn[q][1], v[k][q][2] * rinv * gn[q][2], v[k][q][3] * rinv * gn[q][3]);
            }
        }
    }
}

DEVI void phase_expert_weights(const Params& p, LAS3 unsigned char* lds) {
    LAS3 float* tile = (LAS3 float*)lds;
    const int G = gridDim.x, c = blockIdx.x, tid = opaque_tid();
    constexpr int NT = NEXP * 256 + NEXP * 128, TB = 4, TSZ = 64 * 65;
#pragma unroll 1
    for (int t0 = c * TB; t0 < NT; t0 += G * TB) {
        const float* src[TB]; int ld[TB]; unsigned char* dst[TB]; int ldd[TB]; float rg[TB][8];
#pragma unroll
        for (int q = 0; q < TB; ++q) {
            const int t = t0 + q;
            if (t < NEXP * 256) { const int e = t >> 8, r = t & 255, half = r >> 7, ft = (r >> 4) & 7, kt = r & 15, pnl = ft >> 1, n = pnl * 256 + half * 128 + (ft & 1) * 64;
                src[q] = (half ? p.w_up : p.w_gate) + (size_t)e * 1024 * 512 + (size_t)kt * 64 * 512 + ft * 64; ld[q] = 512;
                dst[q] = (unsigned char*)(p.ws + OFF_WEXP) + ((size_t)e * 1024 + n) * 1024 + kt * 64; ldd[q] = 1024; }
            else { const int t2 = t - NEXP * 256, e = t2 >> 7, nt = (t2 >> 3) & 15, kt = t2 & 7;
                src[q] = p.w_down + (size_t)e * 512 * 1024 + (size_t)kt * 64 * 1024 + nt * 64; ld[q] = 1024;
                dst[q] = (unsigned char*)(p.ws + OFF_WDN) + ((size_t)e * 1024 + nt * 64) * 512 + kt * 64; ldd[q] = 512; }
#pragma unroll
            for (int i = 0; i < 8; ++i) rg[q][i] = src[q][(size_t)((tid >> 6) + 8 * i) * ld[q] + (tid & 63)];
        }
#pragma unroll
        for (int q = 0; q < TB; ++q)
#pragma unroll
            for (int i = 0; i < 8; ++i) tile[q * TSZ + ((tid >> 6) + 8 * i) * 65 + (tid & 63)] = rg[q][i] * W8_SCALE;
        __syncthreads();
#pragma unroll
        for (int q = 0; q < TB; ++q) { const int cc = tid >> 3, r0 = (tid & 7) * 8; const LAS3 float* tq = tile + q * TSZ; u32x2 w;
            w.x = pk4_fp8(tq[(r0 + 0) * 65 + cc], tq[(r0 + 1) * 65 + cc], tq[(r0 + 2) * 65 + cc], tq[(r0 + 3) * 65 + cc]);
            w.y = pk4_fp8(tq[(r0 + 4) * 65 + cc], tq[(r0 + 5) * 65 + cc], tq[(r0 + 6) * 65 + cc], tq[(r0 + 7) * 65 + cc]);
            *(u32x2*)(dst[q] + (size_t)cc * ldd[q] + r0) = w; }
        __syncthreads();
    }
}

namespace pg {
constexpr int BM = 256, BK = 64, HALF = 128, HTB = HALF * BK * 2, STAGE_BYTES = 8 * HTB, NXCD = 8, WGM = 8;
__host__ __device__ __forceinline__ int lds_byte(int r, int c) { const int st = (r >> 4) * 2 + (c >> 5), rr = r & 15, cc = c & 31, ob = rr * 64 + cc * 2; return st * 1024 + (ob ^ (((ob >> 9) & 1) << 5)); }
__host__ __device__ __forceinline__ void stage_rc(int b, int& R, int& C) { const int st = b / 1024, sb = b % 1024, swz = sb ^ (((sb >> 9) & 1) << 5); R = (st >> 1) * 16 + swz / 64; C = (st & 1) * 32 + (swz % 64) / 2; }
__host__ __device__ __forceinline__ int perm32(int rho) { const int n = rho >> 4, i = rho & 15; return 8 * (i >> 2) + 4 * n + (i & 3); }

struct Unit { int pm, pn, pb, lbase, nvalid; };
struct Gemm { const bf16_t* A; const bf16_t* Bt; int K; const int* list; };

struct StaticOrder {
    int nM, nN, nwg, G, c, pnoff, skip0, skipn;
    __device__ void init(int M, int N, int G_, int c_, int pnoff_ = 0, int skip0_ = 1 << 30, int skipn_ = 0) { nM = M / BM; nN = N / BM; nwg = nM * nN; G = G_; c = c_; pnoff = pnoff_; skip0 = skip0_; skipn = skipn_; }
    __device__ bool next(int i, Unit& u) const {
        const long L = (long)i * G + c; if (L >= nwg) return false;
        int wgid = (int)L; { const int q = nwg / NXCD, r = nwg % NXCD, xcd = wgid % NXCD, off = wgid / NXCD; wgid = (xcd < r ? xcd * (q + 1) : r * (q + 1) + (xcd - r) * q) + off; }
        const int nig = WGM * nN, gid = wgid / nig, fm = gid * WGM, gsz = (nM - fm) < WGM ? (nM - fm) : WGM;
        u.pm = fm + ((wgid % nig) % gsz); u.pb = (wgid % nig) / gsz; u.pn = u.pb + pnoff + (u.pb >= skip0 ? skipn : 0); u.lbase = 0; u.nvalid = 0; return true;
    }
};
struct RowOrder {
    int nM, nN, G, c;
    __device__ bool next(int i, Unit& u) const { const int rt = c + (i / nN) * G; if (rt >= nM) return false; u.pm = rt; u.pb = i % nN; u.pn = u.pb; u.lbase = 0; u.nvalid = 0; return true; }
};
struct GroupedOrder {
    const LAS3 int* tb; const LAS3 int* cnt; int G, c;
    __device__ bool next(int i, Unit& u) const {
        const int L = i * G + c; const int T = tb[32]; if (L >= T * 4) return false;
        const int t = L >> 2; int e = 0;
#pragma unroll 1
        while (tb[e + 1] <= t) ++e;
        const int ti = t - tb[e];
        u.pm = t; u.pn = e * 4 + (L & 3); u.pb = u.pn; u.lbase = e * 65536 + ti * 256; u.nvalid = cnt[e] - ti * 256; return true;
    }
};

typedef int v8i_t __attribute__((ext_vector_type(8)));
typedef int v4i_t __attribute__((ext_vector_type(4)));
template <bool F8> struct Frag;
template <> struct Frag<false> { bf16x8 v[2]; };
template <> struct Frag<true>  { v8i_t v; };
__device__ __forceinline__ void frag_load(Frag<false>& f, const LAS3 unsigned char* p) { f.v[0] = *(const LAS3 bf16x8*)p; f.v[1] = *(const LAS3 bf16x8*)(p + 1024); }
__device__ __forceinline__ void frag_load(Frag<true>& f, const LAS3 unsigned char* p) { f.v.lo = *(const LAS3 v4i_t*)p; f.v.hi = *(const LAS3 v4i_t*)(p + 1024); }
__device__ __forceinline__ f32x4 frag_mma(const Frag<false>& b, const Frag<false>& a, f32x4 c) { c = __builtin_amdgcn_mfma_f32_16x16x32_bf16(b.v[0], a.v[0], c, 0, 0, 0); return __builtin_amdgcn_mfma_f32_16x16x32_bf16(b.v[1], a.v[1], c, 0, 0, 0); }
__device__ __forceinline__ f32x4 frag_mma(const Frag<true>& b, const Frag<true>& a, f32x4 c) {
    asm volatile("v_mfma_scale_f32_16x16x128_f8f6f4 %0, %1, %2, %0, %3, %3 op_sel_hi:[0,0,0]" : "+v"(c) : "v"(b.v), "v"(a.v), "v"(0x7F7F7F7F));
    return c;
}

template <class Epi, class Sched, bool GATHER, bool F8 = false, int TSPLIT = 0>
__device__ __forceinline__ void gemm_phase(LAS3 unsigned char* lds, const Gemm g, const Sched& S, const Epi& E) {
    const int tid = opaque_tid(), wid = __builtin_amdgcn_readfirstlane(tid >> 6), lane = tid & 63, wr = wid >> 2, wc = wid & 3, fr = lane & 15, fq = lane >> 4;
    const int K = F8 ? g.K : g.K * 2, nt = K / (BK * 2);
    unsigned voffA[2], voffB[2]; int Rr[2], Cc[2];
#pragma unroll
    for (int i = 0; i < 2; ++i) { int R, C; stage_rc(tid * 16 + i * 8192, R, C); const int Rb = Epi::PERM ? ((R & ~31) + perm32(R & 31)) : R; Rr[i] = R; Cc[i] = C;
        voffA[i] = (unsigned)(R * K + C * 2); voffB[i] = (unsigned)(Rb * K + C * 2); }
    const size_t kstep = (size_t)(BK * 2);
    const size_t hstep = (size_t)HALF * K;
    const size_t tstep = 2 * hstep;
    const unsigned ldsw = (unsigned)wid * 1024u;
    const int aoff = lds_byte(wr * 64 + fr, fq * 8), boff = lds_byte(wc * 32 + fr, fq * 8);
#define PG_SA(b, h) (((b) * 2 + (h)) * HTB)
#define PG_SB(b, h) ((4 + (b) * 2 + (h)) * HTB)
#define PG_STAGE(bufoff, gbase, voff) do { _Pragma("unroll") for (int _i = 0; _i < 2; ++_i) \
        __builtin_amdgcn_global_load_lds((const unsigned*)((const char*)(gbase) + (voff)[_i]), (LAS3 unsigned*)(lds + (bufoff) + ldsw + _i * 8192), 16, 0, 0); } while (0)
#define PG_STAGE2(bufoff, gbase, o0, o1) do { \
        __builtin_amdgcn_global_load_lds((const unsigned*)((const char*)(gbase) + (o0)), (LAS3 unsigned*)(lds + (bufoff) + ldsw), 16, 0, 0); \
        __builtin_amdgcn_global_load_lds((const unsigned*)((const char*)(gbase) + (o1)), (LAS3 unsigned*)(lds + (bufoff) + ldsw + 8192), 16, 0, 0); } while (0)
#define PG_LDA(dst, b, h) do { _Pragma("unroll") for (int m = 0; m < 4; ++m) frag_load(dst[m], lds + PG_SA(b, h) + aoff + m * 2048); } while (0)
#define PG_LDB(dst, b, h) do { _Pragma("unroll") for (int n = 0; n < 2; ++n) frag_load(dst[n], lds + PG_SB(b, h) + boff + n * 2048); } while (0)
#define PG_MMA(ai, bj, At, Bt) do { __builtin_amdgcn_s_setprio(1); _Pragma("unroll") for (int m = 0; m < 4; ++m) _Pragma("unroll") for (int n = 0; n < 2; ++n) \
        acc[ai][bj][m][n] = frag_mma(Bt[n], At[m], acc[ai][bj][m][n]); __builtin_amdgcn_s_setprio(0); } while (0)
#define PG_WAIT_V(n) asm volatile("s_waitcnt vmcnt(" #n ")" ::: "memory")
#define PG_WAIT_L(n) asm volatile("s_waitcnt lgkmcnt(" #n ")" ::: "memory")
#define PG_BAR __builtin_amdgcn_s_barrier()
#define PG_SCHED __builtin_amdgcn_sched_barrier(0)
    Unit cur, nxt; int ui = 0;
    if (!S.next(0, cur)) return;
    f32x4 acc[2][2][4][2];
#pragma unroll
    for (int a = 0; a < 2; ++a)
#pragma unroll
        for (int b = 0; b < 2; ++b)
#pragma unroll
            for (int m = 0; m < 4; ++m)
#pragma unroll
                for (int n = 0; n < 2; ++n) acc[a][b][m][n] = (f32x4){0.f, 0.f, 0.f, 0.f};
    Frag<F8> At[4], B0[2], B1[2];
    unsigned gc[2][2] = {{0u, 0u}, {0u, 0u}}, gn[2][2] = {{0u, 0u}, {0u, 0u}};
    auto load_go = [&](const Unit& u, unsigned (&go)[2][2]) {
#pragma unroll
        for (int h = 0; h < 2; ++h)
#pragma unroll
            for (int i = 0; i < 2; ++i) { int r = h * HALF + Rr[i]; r = r < u.nvalid ? r : u.nvalid - 1; const int tok = g.list[u.lbase + r]; go[h][i] = (unsigned)tok * (unsigned)K + (unsigned)(Cc[i] * 2); }
    };
    const char* cA = GATHER ? (const char*)g.A : (const char*)g.A + (size_t)cur.pm * tstep; const char* cB = (const char*)g.Bt + (size_t)cur.pb * tstep;
    if (GATHER) {
        load_go(cur, gc);
#pragma unroll
        for (int h = 0; h < 2; ++h)
#pragma unroll
            for (int i = 0; i < 2; ++i) gn[h][i] = gc[h][i];
        PG_STAGE(PG_SB(0, 0), cB, voffB); PG_STAGE2(PG_SA(0, 0), cA, gc[0][0], gc[0][1]); PG_STAGE(PG_SB(0, 1), cB + hstep, voffB); PG_STAGE2(PG_SA(0, 1), cA, gc[1][0], gc[1][1]);
        if (wr == 1) PG_BAR;
        PG_WAIT_V(4); PG_BAR;
        PG_STAGE(PG_SB(1, 0), cB + kstep, voffB); PG_STAGE2(PG_SA(1, 0), cA + kstep, gc[0][0], gc[0][1]); PG_STAGE(PG_SB(1, 1), cB + hstep + kstep, voffB);
        PG_WAIT_V(6); PG_BAR;
    } else {
        PG_STAGE(PG_SB(0, 0), cB, voffB); PG_STAGE(PG_SA(0, 0), cA, voffA); PG_STAGE(PG_SB(0, 1), cB + hstep, voffB); PG_STAGE(PG_SA(0, 1), cA + hstep, voffA);
        if (wr == 1) PG_BAR;
        PG_WAIT_V(4); PG_BAR;
        PG_STAGE(PG_SB(1, 0), cB + kstep, voffB); PG_STAGE(PG_SA(1, 0), cA + kstep, voffA); PG_STAGE(PG_SB(1, 1), cB + hstep + kstep, voffB);
        PG_WAIT_V(6); PG_BAR;
    }
    for (;;) {
        const bool has_next = S.next(ui + 1, nxt);
        const char* nA = GATHER ? cA : (has_next ? (const char*)g.A + (size_t)nxt.pm * tstep : cA); const char* nB = has_next ? (const char*)g.Bt + (size_t)nxt.pb * tstep : cB;
#pragma unroll 1
        for (int t = 0; t < nt; t += 2) {
            const bool last = (t == nt - 2);
            if (GATHER) { if (last && has_next) load_go(nxt, gn); }
            const char* a1 = cA + (size_t)(t + 1) * kstep;
            const char* a2 = last ? nA : cA + (size_t)(t + 2) * kstep; const char* b2 = last ? nB : cB + (size_t)(t + 2) * kstep;
            const char* a3 = a2 + kstep; const char* b3 = b2 + kstep;
            const bool sel0 = t < TSPLIT;
            PG_LDB(B0, 0, 0); PG_SCHED; PG_LDA(At, 0, 0);
            if (GATHER) PG_STAGE2(PG_SA(1, 1), a1, gc[1][0], gc[1][1]); else PG_STAGE(PG_SA(1, 1), a1 + hstep, voffA);
            PG_WAIT_L(8); PG_BAR; PG_WAIT_L(0); if (!TSPLIT || sel0) PG_MMA(0, 0, At, B0); PG_BAR; PG_SCHED;
            PG_LDB(B1, 0, 1); PG_STAGE(PG_SB(0, 0), b2, voffB);
            PG_BAR; PG_WAIT_L(0); if (!TSPLIT || !sel0) PG_MMA(0, 1, At, B1); PG_BAR;
            PG_LDA(At, 0, 1);
            if (GATHER) PG_STAGE2(PG_SA(0, 0), a2, last ? gn[0][0] : gc[0][0], last ? gn[0][1] : gc[0][1]); else PG_STAGE(PG_SA(0, 0), a2, voffA);
            PG_BAR; PG_WAIT_L(0); if (!TSPLIT || sel0) PG_MMA(1, 0, At, B0); PG_BAR; PG_SCHED;
            PG_STAGE(PG_SB(0, 1), b2 + hstep, voffB);
            PG_WAIT_V(6); PG_BAR; if (!TSPLIT || !sel0) PG_MMA(1, 1, At, B1); PG_BAR;
            PG_LDB(B0, 1, 0); PG_SCHED; PG_LDA(At, 1, 0);
            if (GATHER) PG_STAGE2(PG_SA(0, 1), a2, last ? gn[1][0] : gc[1][0], last ? gn[1][1] : gc[1][1]); else PG_STAGE(PG_SA(0, 1), a2 + hstep, voffA);
            PG_WAIT_L(8); PG_BAR; PG_WAIT_L(0); if (!TSPLIT || sel0) PG_MMA(0, 0, At, B0); PG_BAR; PG_SCHED;
            PG_LDB(B1, 1, 1); PG_STAGE(PG_SB(1, 0), b3, voffB);
            PG_BAR; PG_WAIT_L(0); if (!TSPLIT || !sel0) PG_MMA(0, 1, At, B1); PG_BAR;
            PG_LDA(At, 1, 1);
            if (GATHER) PG_STAGE2(PG_SA(1, 0), a3, last ? gn[0][0] : gc[0][0], last ? gn[0][1] : gc[0][1]); else PG_STAGE(PG_SA(1, 0), a3, voffA);
            PG_BAR; PG_WAIT_L(0); if (!TSPLIT || sel0) PG_MMA(1, 0, At, B0); PG_BAR; PG_SCHED;
            PG_STAGE(PG_SB(1, 1), b3 + hstep, voffB);
            PG_WAIT_V(6); PG_BAR; if (!TSPLIT || !sel0) PG_MMA(1, 1, At, B1); PG_BAR;
        }
        if constexpr (F8) asm volatile("s_nop 15\n\ts_nop 15" ::: "memory");
        E(acc, cur, wr, wc, fr, fq);
        if (!has_next) break;
#pragma unroll
        for (int a = 0; a < 2; ++a)
#pragma unroll
            for (int b = 0; b < 2; ++b)
#pragma unroll
                for (int m = 0; m < 4; ++m)
#pragma unroll
                    for (int n = 0; n < 2; ++n) acc[a][b][m][n] = (f32x4){0.f, 0.f, 0.f, 0.f};
        cur = nxt; cA = nA; cB = nB; ++ui;
        if (GATHER) {
#pragma unroll
            for (int h = 0; h < 2; ++h)
#pragma unroll
                for (int i = 0; i < 2; ++i) gc[h][i] = gn[h][i];
        }
    }
    PG_WAIT_V(0);
    if (wr == 0) PG_BAR;
    PG_BAR;
#undef PG_SA
#undef PG_SB
#undef PG_STAGE
#undef PG_STAGE2
#undef PG_LDA
#undef PG_LDB
#undef PG_MMA
#undef PG_WAIT_V
#undef PG_WAIT_L
#undef PG_BAR
#undef PG_SCHED
}
}

template <class F> __device__ __forceinline__ void epi_rows(int row0, F f) {
#pragma unroll
    for (int ai = 0; ai < 2; ++ai)
#pragma unroll
        for (int m = 0; m < 4; ++m) f(ai, m, row0 + ai * 128 + m * 16);
}
struct EpiProj {
    static constexpr bool PERM = true; char* ws;
    __device__ __forceinline__ void operator()(const f32x4 (&acc)[2][2][4][2], const pg::Unit& u, int wr, int wc, int fr, int fq) const {
        const int row0 = u.pm * 256 + wr * 64 + fr, pn = u.pn, cw = wc * 32 + 8 * fq;
        if (pn < 2) {
            unsigned char* QA = (unsigned char*)(ws + OFF_QA);
            epi_rows(row0, [&](int ai, int m, int tok) { const int b = tok >> 11, s = tok & 2047;
#pragma unroll
                for (int bj = 0; bj < 2; ++bj) { const int col = pn * 256 + bj * 128 + cw, h = col >> 6, d = col & 63;
                    const f32x4 a = acc[ai][bj][m][0] * (QSCALE * W8_INV * D8_SCALE), c = acc[ai][bj][m][1] * (QSCALE * W8_INV * D8_SCALE); u32x2 w; w.x = pk4_fp8(a[0], a[1], a[2], a[3]); w.y = pk4_fp8(c[0], c[1], c[2], c[3]);
                    *(u32x2*)(QA + ((size_t)(b * 8 + h) * SEQ + s) * 64 + d) = w; } });
        } else if (pn == 2) {
            bf16_t* CR = (bf16_t*)(ws + OFF_CR); float* SSQ = (float*)(ws + OFF_SSQ);
            epi_rows(row0, [&](int ai, int m, int tok) { float ss = 0.f;
#pragma unroll
                for (int bj = 0; bj < 2; ++bj) { const f32x4 a = acc[ai][bj][m][0] * W8_INV, b = acc[ai][bj][m][1] * W8_INV;
                    ss += a[0] * a[0] + a[1] * a[1] + a[2] * a[2] + a[3] * a[3] + b[0] * b[0] + b[1] * b[1] + b[2] * b[2] + b[3] * b[3];
                    *(u32x4*)(CR + (size_t)tok * 256 + bj * 128 + cw) = pack8(a, b); }
                ss += __shfl_xor(ss, 16); ss += __shfl_xor(ss, 32);
                if (fq == 0) SSQ[(size_t)tok * 4 + wc] = ss; });
        } else if (pn == 3) {
            bf16_t* QI = (bf16_t*)(ws + OFF_QI);
            epi_rows(row0, [&](int ai, int m, int tok) {
#pragma unroll
                for (int bj = 0; bj < 2; ++bj) *(u32x4*)(QI + (size_t)tok * 256 + bj * 128 + cw) = pack8(acc[ai][bj][m][0] * W8_INV, acc[ai][bj][m][1] * W8_INV); });
        } else if (pn == 4) {
            bf16_t* KI = (bf16_t*)(ws + OFF_KI); float* WI = (float*)(ws + OFF_WI);
            epi_rows(row0, [&](int ai, int m, int tok) { if (cw < 64) *(u32x4*)(KI + (size_t)tok * 64 + cw) = pack8(acc[ai][0][m][0] * W8_INV, acc[ai][0][m][1] * W8_INV);
                       else if (cw == 64) *(f32x4*)(WI + (size_t)tok * 4) = acc[ai][0][m][0] * W8_INV; });
        } else if (pn < 14) {
            const int t9 = pn - 5, qkv = t9 / 3, g = t9 % 3, r = dil_r(g), ls = SEQ / r;
            unsigned char* base = (unsigned char*)(ws + OFF_DIL) + (size_t)qkv * DIL_SZ; const float sc = (qkv == 0 ? QSCALE : 1.0f) * W8_INV * D8_SCALE;
            epi_rows(row0, [&](int ai, int m, int tok) { const int b = tok >> 11, s = tok & 2047, pp = (s % r) * ls + s / r;
#pragma unroll
                for (int bj = 0; bj < 2; ++bj) { const int col = bj * 128 + cw, j = col >> 6, d = col & 63;
                    const f32x4 a = acc[ai][bj][m][0] * sc, c = acc[ai][bj][m][1] * sc; u32x2 w; w.x = pk4_fp8(a[0], a[1], a[2], a[3]); w.y = pk4_fp8(c[0], c[1], c[2], c[3]);
                    *(u32x2*)(base + (((size_t)(g * 4 + j) * BATCH + b) * SEQ + pp) * 64 + d) = w; } });
        } else {
            unsigned char* G = (unsigned char*)(ws + OFF_G);
            epi_rows(row0, [&](int ai, int m, int tok) {
#pragma unroll
                for (int bj = 0; bj < 2; ++bj) { f32x4 a = acc[ai][bj][m][0], b = acc[ai][bj][m][1];
#pragma unroll
                    for (int q = 0; q < 4; ++q) { a[q] = fast_sigmoid(a[q] * W8_INV) * 255.0f; b[q] = fast_sigmoid(b[q] * W8_INV) * 255.0f; }
                    u32x2 w; w.x = pk4_u8(a[0], a[1], a[2], a[3]); w.y = pk4_u8(b[0], b[1], b[2], b[3]);
                    *(u32x2*)(G + (size_t)tok * 2048 + (pn - 14) * 256 + bj * 128 + cw) = w; } });
        }
    }
};
struct EpiKV {
    static constexpr bool PERM = true; char* ws;
    __device__ __forceinline__ void operator()(const f32x4 (&acc)[2][2][4][2], const pg::Unit& u, int wr, int wc, int fr, int fq) const {
        const int row0 = u.pm * 256 + wr * 64 + fr, pn = u.pn, cw = wc * 32 + 8 * fq;
        unsigned char* O = (unsigned char*)(ws + OFF_R1) + (size_t)(pn >> 1) * NTOK * 512; const float* SSQ = (const float*)(ws + OFF_SSQ);
        f32x4 sqv[2][4];
        epi_rows(row0, [&](int ai, int m, int tok) { sqv[ai][m] = *(const f32x4*)(SSQ + (size_t)tok * 4); });
        epi_rows(row0, [&](int ai, int m, int tok) { const int b = tok >> 11, s = tok & 2047; const f32x4 sq = sqv[ai][m]; const float rinv = rsqrtf(((sq[0] + sq[1]) + (sq[2] + sq[3])) * (1.0f / 256.0f) + RMS_EPS);
#pragma unroll
            for (int bj = 0; bj < 2; ++bj) { const int col = (pn & 1) * 256 + bj * 128 + cw, h = col >> 6, d = col & 63;
                const f32x4 a = acc[ai][bj][m][0] * (rinv * D8_SCALE), c = acc[ai][bj][m][1] * (rinv * D8_SCALE); u32x2 w; w.x = pk4_fp8(a[0], a[1], a[2], a[3]); w.y = pk4_fp8(c[0], c[1], c[2], c[3]);
                *(u32x2*)(O + ((size_t)(b * 8 + h) * SEQ + s) * 64 + d) = w; } });
    }
};
struct EpiMix2 {
    static constexpr bool PERM = true; char* ws;
    __device__ __forceinline__ void operator()(const f32x4 (&acc)[2][2][4][2], const pg::Unit& u, int wr, int wc, int fr, int fq) const {
        const int row0 = u.pm * 256 + wr * 64 + fr, col = u.pn * 128 + wc * 32 + 8 * fq;
        unsigned char* MIX = (unsigned char*)(ws + OFF_MIX); const unsigned char* G = (const unsigned char*)(ws + OFF_G); constexpr float I255 = 1.0f / 255.0f;
        u32x2 gav[2][4], gbv[2][4];
        epi_rows(row0, [&](int ai, int m, int tok) { gav[ai][m] = *(const u32x2*)(G + (size_t)tok * 2048 + col); gbv[ai][m] = *(const u32x2*)(G + (size_t)tok * 2048 + 1024 + col); });
        epi_rows(row0, [&](int ai, int m, int tok) {
            const u32x2 ga = gav[ai][m], gb = gbv[ai][m];
            f32x4 a = acc[ai][0][m][0], b = acc[ai][0][m][1]; const f32x4 c = acc[ai][1][m][0], d = acc[ai][1][m][1];
            a[0] = a[0] * (float)(ga.x & 255u) + c[0] * (float)(gb.x & 255u); a[1] = a[1] * (float)((ga.x >> 8) & 255u) + c[1] * (float)((gb.x >> 8) & 255u);
            a[2] = a[2] * (float)((ga.x >> 16) & 255u) + c[2] * (float)((gb.x >> 16) & 255u); a[3] = a[3] * (float)(ga.x >> 24) + c[3] * (float)(gb.x >> 24);
            b[0] = b[0] * (float)(ga.y & 255u) + d[0] * (float)(gb.y & 255u); b[1] = b[1] * (float)((ga.y >> 8) & 255u) + d[1] * (float)((gb.y >> 8) & 255u);
            b[2] = b[2] * (float)((ga.y >> 16) & 255u) + d[2] * (float)((gb.y >> 16) & 255u); b[3] = b[3] * (float)(ga.y >> 24) + d[3] * (float)(gb.y >> 24);
            a = a * (I255 * W8_INV / 16.0f); b = b * (I255 * W8_INV / 16.0f);
            u32x2 w; w.x = pk4_fp8(a[0], a[1], a[2], a[3]); w.y = pk4_fp8(b[0], b[1], b[2], b[3]);
            *(u32x2*)(MIX + (size_t)tok * 1024 + col) = w; });
    }
};
struct EpiOut {
    static constexpr bool PERM = true; char* ws; const float* x;
    __device__ __forceinline__ void operator()(const f32x4 (&acc)[2][2][4][2], const pg::Unit& u, int wr, int wc, int fr, int fq) const {
        const int row0 = u.pm * 256 + wr * 64 + fr, cw = wc * 32 + 8 * fq; bf16_t* D = (bf16_t*)(ws + OFF_H);
        epi_rows(row0, [&](int ai, int m, int tok) {
#pragma unroll
            for (int bj = 0; bj < 2; ++bj) *(u32x4*)(D + (size_t)tok * 1024 + u.pn * 256 + bj * 128 + cw) = pack8(acc[ai][bj][m][0] * W8_INV, acc[ai][bj][m][1] * W8_INV); });
    }
};
struct EpiGU {
    static constexpr bool PERM = true; char* ws;
    __device__ __forceinline__ void operator()(const f32x4 (&acc)[2][2][4][2], const pg::Unit& u, int wr, int wc, int fr, int fq) const {
        const int row0 = u.pm * 256 + wr * 64 + fr, cw = wc * 32 + 8 * fq; unsigned char* HID = (unsigned char*)(ws + OFF_HID);
        epi_rows(row0, [&](int ai, int m, int tok) { f32x4 a = acc[ai][0][m][0] * W8_INV, b = acc[ai][0][m][1] * W8_INV; const f32x4 ua = acc[ai][1][m][0] * W8_INV, ub = acc[ai][1][m][1] * W8_INV;
#pragma unroll
            for (int q = 0; q < 4; ++q) { a[q] = a[q] * fast_sigmoid(a[q]) * ua[q]; b[q] = b[q] * fast_sigmoid(b[q]) * ub[q]; }
            u32x2 w; w.x = pk4_fp8(a[0], a[1], a[2], a[3]); w.y = pk4_fp8(b[0], b[1], b[2], b[3]);
            *(u32x2*)(HID + (size_t)tok * 512 + (u.pn & 3) * 128 + cw) = w; });
    }
};
struct EpiDown {
    static constexpr bool PERM = true; char* ws;
    __device__ __forceinline__ void operator()(const f32x4 (&acc)[2][2][4][2], const pg::Unit& u, int wr, int wc, int fr, int fq) const {
        const int row0 = u.pm * 256 + wr * 64 + fr, cw = wc * 32 + 8 * fq; unsigned char* EO = (unsigned char*)(ws + OFF_EO);
        epi_rows(row0, [&](int ai, int m, int tok) {
#pragma unroll
            for (int bj = 0; bj < 2; ++bj) { const f32x4 a = acc[ai][bj][m][0] * W8_INV, b = acc[ai][bj][m][1] * W8_INV; u32x2 w; w.x = pk4_fp8(a[0], a[1], a[2], a[3]); w.y = pk4_fp8(b[0], b[1], b[2], b[3]);
                *(u32x2*)(EO + (size_t)tok * 1024 + (u.pn & 3) * 256 + bj * 128 + cw) = w; } });
    }
};

DEVI void phase_proj(const Params& p, LAS3 unsigned char* lds) {
    pg::StaticOrder S; S.init(NTOK, 5632, gridDim.x, blockIdx.x);
    pg::gemm_phase<EpiProj, pg::StaticOrder, false, true>(lds, pg::Gemm{(const bf16_t*)(p.ws + OFF_U8), (const bf16_t*)(p.ws + OFF_WT8), 1024, nullptr}, S, EpiProj{p.ws});
}
DEVI void phase_kv(const Params& p, LAS3 unsigned char* lds) {
    pg::StaticOrder S; S.init(NTOK, 1024, gridDim.x, blockIdx.x);
    pg::gemm_phase<EpiKV, pg::StaticOrder, false>(lds, pg::Gemm{(const bf16_t*)(p.ws + OFF_CR), (const bf16_t*)(p.ws + OFF_WKV), 256, nullptr}, S, EpiKV{p.ws});
}
DEVI void phase_mix(const Params& p, LAS3 unsigned char* lds) {
    pg::RowOrder S{NTOK / 256, 8, (int)gridDim.x, (int)blockIdx.x};
    pg::gemm_phase<EpiMix2, pg::RowOrder, false, true, 4>(lds, pg::Gemm{(const bf16_t*)(p.ws + OFF_YA), (const bf16_t*)(p.ws + OFF_WAB), YAB_LD, nullptr}, S, EpiMix2{p.ws});
}
DEVI void phase_out(const Params& p, LAS3 unsigned char* lds) {
    pg::RowOrder S{NTOK / 256, 4, (int)gridDim.x, (int)blockIdx.x};
    pg::gemm_phase<EpiOut, pg::RowOrder, false, true>(lds, pg::Gemm{(const bf16_t*)(p.ws + OFF_MIX), (const bf16_t*)(p.ws + OFF_WOT), 1024, nullptr}, S, EpiOut{p.ws, p.x});
}

DEVI void build_expert_tables(const Params& p, LAS3 unsigned char* lds) {
    LAS3 int* tb = (LAS3 int*)(lds + LDS_TAB); LAS3 int* cnt = tb + 64;
    if (opaque_tid() < 64) {
        const int lane = opaque_tid(); const int c = lane < 32 ? __hip_atomic_load((const int*)(p.ws + OFF_ECNT) + lane, __ATOMIC_RELAXED, __HIP_MEMORY_SCOPE_AGENT) : 0;
        int t = (c + 255) >> 8, incl = t;
#pragma unroll
        for (int o = 1; o < 32; o <<= 1) { const int v = __shfl_up(incl, o); if (lane >= o) incl += v; }
        if (lane < 32) { cnt[lane] = c; tb[lane + 1] = incl; }
        if (lane == 0) tb[0] = 0;
    }
    __syncthreads();
}
DEVI void phase_gu(const Params& p, LAS3 unsigned char* lds) {
    pg::GroupedOrder S; S.tb = (const LAS3 int*)(lds + LDS_TAB); S.cnt = S.tb + 64; S.G = gridDim.x; S.c = blockIdx.x;
    pg::gemm_phase<EpiGU, pg::GroupedOrder, true, true>(lds, pg::Gemm{(const bf16_t*)(p.ws + OFF_TT), (const bf16_t*)(p.ws + OFF_WEXP), 1024, (const int*)(p.ws + OFF_LIST)}, S, EpiGU{p.ws});
}
DEVI void phase_down(const Params& p, LAS3 unsigned char* lds) {
    pg::GroupedOrder S; S.tb = (const LAS3 int*)(lds + LDS_TAB); S.cnt = S.tb + 64; S.G = gridDim.x; S.c = blockIdx.x;
    pg::gemm_phase<EpiDown, pg::GroupedOrder, false, true>(lds, pg::Gemm{(const bf16_t*)(p.ws + OFF_HID), (const bf16_t*)(p.ws + OFF_WDN), 512, nullptr}, S, EpiDown{p.ws});
}

constexpr int LDS_RW   = 0;
constexpr int LDS_LG   = 147456;
constexpr int LDS_LC   = LDS_LG + 8 * 8 * 37 * 4;
constexpr int LDS_RTK  = LDS_LC + 256;
static_assert(LDS_RTK + 256 * 6 * 4 <= LDS_XB, "route phase LDS overflow");
DEVI void phase_route(const Params& p, LAS3 unsigned char* lds) {
    const int tid = opaque_tid(), lane = tid & 63, wv = tid >> 6, G = gridDim.x;
    LAS3 float* rw = (LAS3 float*)(lds + LDS_RW); LAS3 float* lg = (LAS3 float*)(lds + LDS_LG) + wv * 8 * 37;
    LAS3 int* lcnt = (LAS3 int*)(lds + LDS_LC); LAS3 int* gbase = lcnt + 32; LAS3 unsigned* rtk = (LAS3 unsigned*)(lds + LDS_RTK);
    for (int k = tid; k < 1024; k += 512) { const f32x4 v = *(const f32x4*)(p.w_rg + (size_t)k * 4); rw[k] = v[0]; rw[1024 + k] = v[1]; rw[2048 + k] = v[2]; rw[3072 + k] = v[3]; }
#pragma unroll 1
    for (int base = 0; base < 8192; base += 4096) {
        f32x4 t[8];
#pragma unroll
        for (int j = 0; j < 8; ++j) t[j] = *(const f32x4*)(p.w_re + (size_t)(base + j * 512 + tid) * 4);
#pragma unroll
        for (int j = 0; j < 8; ++j) { const int idx = base + j * 512 + tid, row = idx >> 1, g = row >> 10, k = row & 1023, o0 = 4 + g * 8 + (idx & 1) * 4;
#pragma unroll
            for (int e = 0; e < 4; ++e) rw[(o0 + e) * 1024 + k] = t[j][e]; }
    }
    if (tid < 32) lcnt[tid] = 0;
    f32x4 gn[4];
#pragma unroll
    for (int q = 0; q < 4; ++q) gn[q] = *(const f32x4*)(p.ffn_norm + q * 256 + 4 * lane);
    __syncthreads();
    const bf16_t* H = (const bf16_t*)(p.ws + OFF_H); bf16_t* Hw = (bf16_t*)(p.ws + OFF_H); unsigned char* TT = (unsigned char*)(p.ws + OFF_TT);
    for (int chunk = blockIdx.x; chunk < NTOK / 256; chunk += G) {
        const int tokw = chunk * 256 + wv * 32;
        f32x4 nxv[4]; u32x2 ndv[4];
#pragma unroll
        for (int q = 0; q < 4; ++q) { nxv[q] = *(const f32x4*)(p.x + (size_t)tokw * 1024 + q * 256 + 4 * lane); ndv[q] = *(const u32x2*)(H + (size_t)tokw * 1024 + q * 256 + 4 * lane); }
#pragma unroll 1
        for (int sub = 0; sub < 4; ++sub) {
#pragma unroll 1
            for (int tk = 0; tk < 8; ++tk) {
                const int tok = tokw + sub * 8 + tk;
                f32x4 v[4]; float ss = 0.f; u32x2 dcur[4];
#pragma unroll
                for (int q = 0; q < 4; ++q) { v[q] = nxv[q]; dcur[q] = ndv[q]; }
                if (sub * 8 + tk < 31) {
#pragma unroll
                    for (int q = 0; q < 4; ++q) { nxv[q] = *(const f32x4*)(p.x + (size_t)(tok + 1) * 1024 + q * 256 + 4 * lane); ndv[q] = *(const u32x2*)(H + (size_t)(tok + 1) * 1024 + q * 256 + 4 * lane); }
                }
#pragma unroll
                for (int q = 0; q < 4; ++q) { const u32x2 dd = dcur[q];
                    v[q][0] += bflo(dd.x); v[q][1] += bfhi(dd.x); v[q][2] += bflo(dd.y); v[q][3] += bfhi(dd.y); ss += v[q][0] * v[q][0] + v[q][1] * v[q][1] + v[q][2] * v[q][2] + v[q][3] * v[q][3];
                    u32x2 hh; hh.x = cvt_pk_bf16(v[q][0], v[q][1]); hh.y = cvt_pk_bf16(v[q][2], v[q][3]); *(u32x2*)(Hw + (size_t)tok * 1024 + q * 256 + 4 * lane) = hh; }
#pragma unroll
                for (int o = 32; o > 0; o >>= 1) ss += __shfl_xor(ss, o);
                const float rinv = rsqrtf(ss * (1.0f / 1024.0f) + RMS_EPS);
#pragma unroll
                for (int q = 0; q < 4; ++q) { v[q] = v[q] * rinv * gn[q]; *(unsigned*)(TT + (size_t)tok * 1024 + q * 256 + 4 * lane) = pk4_fp8(v[q][0], v[q][1], v[q][2], v[q][3]); }
                float a[36];
#pragma unroll
                for (int o = 0; o < 36; ++o) { float s = 0.f;
#pragma unroll
                    for (int q = 0; q < 4; ++q) { const f32x4 w = *(const LAS3 f32x4*)(rw + o * 1024 + q * 256 + 4 * lane); s += v[q][0] * w[0] + v[q][1] * w[1] + v[q][2] * w[2] + v[q][3] * w[3]; }
                    a[o] = s; }
#pragma unroll
                for (int st = 0; st < 5; ++st) { const int msk = 32 >> st, half = 16 >> st; const bool up = (lane & msk) != 0;
#pragma unroll
                    for (int i = 0; i < half; ++i) { const float lo = a[i], hi = a[i + half]; const float send = up ? lo : hi, keep = up ? hi : lo; a[i] = keep + __shfl_xor(send, msk); } }
                a[0] += __shfl_xor(a[0], 1);
#pragma unroll
                for (int e = 32; e < 36; ++e) {
#pragma unroll
                    for (int o = 32; o > 0; o >>= 1) a[e] += __shfl_xor(a[e], o); }
                if ((lane & 1) == 0) lg[tk * 37 + (lane >> 1)] = a[0];
                if (lane < 4) lg[tk * 37 + 32 + lane] = lane == 0 ? a[32] : (lane == 1 ? a[33] : (lane == 2 ? a[34] : a[35]));
            }
            asm volatile("s_waitcnt lgkmcnt(0)" ::: "memory");
            if (lane < 8) {
                const LAS3 float* l = lg + lane * 37; float gl[4];
#pragma unroll
                for (int g = 0; g < 4; ++g) gl[g] = l[g] + p.b_rg[g];
                int gs = 0;
#pragma unroll
                for (int g = 1; g < 4; ++g) if (gl[g] > gl[gs]) gs = g;
                float den = 0.f;
#pragma unroll
                for (int g = 0; g < 4; ++g) den += expf(gl[g] - gl[gs]);
                const float pg_ = 1.0f / den; float el[8];
#pragma unroll
                for (int e = 0; e < 8; ++e) el[e] = l[4 + gs * 8 + e] + p.b_re[gs * 8 + e];
                int i0 = 0;
#pragma unroll
                for (int e = 1; e < 8; ++e) if (el[e] > el[i0]) i0 = e;
                int i1 = i0 == 0 ? 1 : 0;
#pragma unroll
                for (int e = 0; e < 8; ++e) if (e != i0 && el[e] > el[i1]) i1 = e;
                const float e1 = expf(el[i1] - el[i0]), w0 = pg_ / (1.0f + e1), w1 = pg_ * e1 / (1.0f + e1);
                const int E0 = gs * 8 + i0, E1 = gs * 8 + i1;
                const int s0 = __hip_atomic_fetch_add(lcnt + E0, 1, __ATOMIC_RELAXED, __HIP_MEMORY_SCOPE_WORKGROUP), s1 = __hip_atomic_fetch_add(lcnt + E1, 1, __ATOMIC_RELAXED, __HIP_MEMORY_SCOPE_WORKGROUP);
                LAS3 unsigned* r = rtk + (wv * 32 + sub * 8 + lane) * 6;
                r[0] = (unsigned)E0; r[1] = (unsigned)s0; r[2] = __float_as_uint(w0); r[3] = (unsigned)E1; r[4] = (unsigned)s1; r[5] = __float_as_uint(w1);
            }
        }
        __syncthreads();
        if (tid < 32) { const int n = lcnt[tid]; gbase[tid] = n ? atomicAdd((int*)(p.ws + OFF_ECNT) + tid, n) : 0; lcnt[tid] = 0; }
        __syncthreads();
        if (tid < 256) {
            const int tok = chunk * 256 + tid; const LAS3 unsigned* r = rtk + tid * 6;
            const int E0 = (int)r[0], E1 = (int)r[3], s0 = gbase[E0] + (int)r[1], s1 = gbase[E1] + (int)r[4];
            u32x4 w0; w0.x = (unsigned)E0; w0.y = (unsigned)s0; w0.z = r[2]; w0.w = 0u; u32x4 w1; w1.x = (unsigned)E1; w1.y = (unsigned)s1; w1.z = r[5]; w1.w = 0u;
            unsigned* RT = (unsigned*)(p.ws + OFF_RT) + (size_t)tok * 8; *(u32x4*)RT = w0; *(u32x4*)(RT + 4) = w1;
            int* LIST = (int*)(p.ws + OFF_LIST); LIST[(size_t)E0 * 65536 + s0] = tok; LIST[(size_t)E1 * 65536 + s1] = tok;
        }
        __syncthreads();
    }
}

DEVI void phase_final(const Params& p, LAS3 unsigned char* lds) {
    const LAS3 int* tb = (const LAS3 int*)(lds + LDS_TAB);
    const int lane = opaque_tid() & 63, wv = opaque_tid() >> 6, G = gridDim.x;
    f32x4 gn[4];
#pragma unroll
    for (int q = 0; q < 4; ++q) gn[q] = *(const f32x4*)(p.final_norm + q * 256 + 4 * lane);
    const bf16_t* H = (const bf16_t*)(p.ws + OFF_H); const unsigned char* EO = (const unsigned char*)(p.ws + OFF_EO); const unsigned* RT = (const unsigned*)(p.ws + OFF_RT);
    const int st = G * 8; int tok = blockIdx.x * 8 + wv;
    u32x4 ra[2], rb[2], na[2], nb[2]; u32x2 dv[2][4]; unsigned ea[2][4], eb[2][4];
#pragma unroll
    for (int k = 0; k < 2; ++k) { ra[k] = (u32x4){0, 0, 0, 0}; rb[k] = ra[k]; na[k] = ra[k]; nb[k] = ra[k]; }
#define FIN_LOADR(t_, a_, b_) do { a_ = *(const u32x4*)(RT + (size_t)(t_) * 8); b_ = *(const u32x4*)(RT + (size_t)(t_) * 8 + 4); } while (0)
#define FIN_LOADD(k_, t_, a_, b_) do { const size_t r0_ = (size_t)tb[a_.x] * 256 + a_.y, r1_ = (size_t)tb[b_.x] * 256 + b_.y; \
        _Pragma("unroll") for (int q = 0; q < 4; ++q) { dv[k_][q] = *(const u32x2*)(H + (size_t)(t_) * 1024 + q * 256 + 4 * lane); \
            ea[k_][q] = *(const unsigned*)(EO + r0_ * 1024 + q * 256 + 4 * lane); eb[k_][q] = *(const unsigned*)(EO + r1_ * 1024 + q * 256 + 4 * lane); } } while (0)
#pragma unroll
    for (int k = 0; k < 2; ++k) if (tok + k * st < NTOK) FIN_LOADR(tok + k * st, ra[k], rb[k]);
#pragma unroll
    for (int k = 0; k < 2; ++k) if (tok + k * st < NTOK) { FIN_LOADD(k, tok + k * st, ra[k], rb[k]); if (tok + (2 + k) * st < NTOK) FIN_LOADR(tok + (2 + k) * st, na[k], nb[k]); }
#pragma unroll 1
    for (; tok < NTOK; tok += 2 * st) {
        f32x4 v[2][4]; float ss[2];
#pragma unroll
        for (int k = 0; k < 2; ++k) {
            const float w0 = __uint_as_float(ra[k].z), w1 = __uint_as_float(rb[k].z); ss[k] = 0.f;
#pragma unroll
            for (int q = 0; q < 4; ++q) {
                const f32x2 a01 = __builtin_amdgcn_cvt_pk_f32_fp8(ea[k][q], false), a23 = __builtin_amdgcn_cvt_pk_f32_fp8(ea[k][q], true), b01 = __builtin_amdgcn_cvt_pk_f32_fp8(eb[k][q], false), b23 = __builtin_amdgcn_cvt_pk_f32_fp8(eb[k][q], true);
                v[k][q][0] = bflo(dv[k][q].x) + w0 * a01[0] + w1 * b01[0]; v[k][q][1] = bfhi(dv[k][q].x) + w0 * a01[1] + w1 * b01[1];
                v[k][q][2] = bflo(dv[k][q].y) + w0 * a23[0] + w1 * b23[0]; v[k][q][3] = bfhi(dv[k][q].y) + w0 * a23[1] + w1 * b23[1];
                ss[k] += v[k][q][0] * v[k][q][0] + v[k][q][1] * v[k][q][1] + v[k][q][2] * v[k][q][2] + v[k][q][3] * v[k][q][3];
            }
        }
#pragma unroll
        for (int k = 0; k < 2; ++k) if (tok + (2 + k) * st < NTOK) { ra[k] = na[k]; rb[k] = nb[k]; FIN_LOADD(k, tok + (2 + k) * st, ra[k], rb[k]); if (tok + (4 + k) * st < NTOK) FIN_LOADR(tok + (4 + k) * st, na[k], nb[k]); }
#pragma unroll
        for (int k = 0; k < 2; ++k) if (tok + k * st < NTOK) {
            float s1 = ss[k];
#pragma unroll
            for (int o = 32; o > 0; o >>= 1) s1 += __shfl_xor(s1, o);
            const float rinv = rsqrtf(s1 * (1.0f / 1024.0f) + RMS_EPS);
#pragma unroll
            for (int q = 0; q < 4; ++q) *(f32x4*)(p.out + (size_t)(tok + k * st) * 1024 + q * 256 + 4 * lane) = v[k][q] * rinv * gn[q];
        }
    }
#undef FIN_LOADR
#undef FIN_LOADD
}


typedef float f32x16 __attribute__((ext_vector_type(16)));
typedef short s16x4 __attribute__((ext_vector_type(4)));
#define MFMA32(a, b, c) __builtin_amdgcn_mfma_f32_32x32x16_bf16(a, b, c, 0, 0, 0)
#define MFMA16(a, b, c) __builtin_amdgcn_mfma_f32_16x16x32_bf16(a, b, c, 0, 0, 0)
constexpr float NEGB = -1e30f;
DEVI s16x4 vtr(const LAS3 unsigned char* p) { return __builtin_bit_cast(s16x4, __builtin_amdgcn_ds_read_tr16_b64_v4i16((LAS3 s16x4*)p)); }
DEVI float max3f(float a, float b, float c) { return __builtin_fmaxf(__builtin_fmaxf(a, b), c); }

constexpr int TK_STRIDE = 2052;
DEVI unsigned fkey(float f) { const unsigned u = __float_as_uint(f); return u ^ ((u >> 31) ? 0xFFFFFFFFu : 0x80000000u); }
DEVI int wave_sum_pair(int a, int b, int& sumb) {
    int v = a | (b << 16);
    v += __builtin_amdgcn_update_dpp(0, v, 0xB1, 0xF, 0xF, true);
    v += __builtin_amdgcn_update_dpp(0, v, 0x4E, 0xF, 0xF, true);
    v += __builtin_amdgcn_update_dpp(0, v, 0x141, 0xF, 0xF, true);
    v += __builtin_amdgcn_update_dpp(0, v, 0x140, 0xF, 0xF, true);
    const int t = __builtin_amdgcn_readlane(v, 0) + __builtin_amdgcn_readlane(v, 16) + __builtin_amdgcn_readlane(v, 32) + __builtin_amdgcn_readlane(v, 48);
    sumb = (int)((unsigned)t >> 16); return t & 0xFFFF;
}
DEVI void phase_topk(const Params& p, LAS3 unsigned char* lds) {
    LAS3 float* sc = (LAS3 float*)lds;
    const int tid = opaque_tid(), lane = tid & 63, wv = __builtin_amdgcn_readfirstlane(tid >> 6), r16 = lane & 15, g4 = lane >> 4;
    const bf16_t* QI = (const bf16_t*)(p.ws + OFF_QI); const bf16_t* KI = (const bf16_t*)(p.ws + OFF_KI); const float* WI = (const float*)(p.ws + OFF_WI);
    unsigned* SEL = (unsigned*)(p.ws + OFF_SEL);
#define TK_UNIT(u_, b_, t0_) do { b_ = (u_) >> 7; t0_ = ((((u_) & 127) + 8 * ((u_) >> 8)) & 127) * 16; } while (0)
#define TK_LOADQ(b_, t0_) do { const bf16_t* qrow = QI + (size_t)((b_) * SEQ + (t0_) + r16) * 256 + 8 * g4; \
        _Pragma("unroll") for (int h = 0; h < 4; ++h) { qf[h][0] = *(const bf16x8*)(qrow + h * 64); qf[h][1] = *(const bf16x8*)(qrow + h * 64 + 32); } \
        w4 = *(const f32x4*)(WI + (size_t)((b_) * SEQ + (t0_) + r16) * 4); } while (0)
#define TK_LOADK(dst, kb_, gi_) do { const bf16_t* kp_ = (kb_) + (size_t)(gi_) * 4096; \
        _Pragma("unroll") for (int j = 0; j < 4; ++j) { dst[j][0] = *(const bf16x8*)(kp_ + j * 1024); dst[j][1] = *(const bf16x8*)(kp_ + j * 1024 + 32); } } while (0)
    bf16x8 qf[4][2]; f32x4 w4; bf16x8 kf[4][2];
    int u = blockIdx.x, b = 0, t0 = 0;
    if (u < NTOK / 16) { TK_UNIT(u, b, t0); TK_LOADQ(b, t0); if (wv * 64 < t0 + 16) TK_LOADK(kf, KI + (size_t)(b * SEQ + r16) * 64 + 8 * g4, wv); }
    for (; u < NTOK / 16; u += gridDim.x) {
        const int tokb = b * SEQ, nkey = t0 + 16;
        const bf16_t* kbase = KI + (size_t)(tokb + r16) * 64 + 8 * g4;
        const float wq[4] = {w4[0], w4[1], w4[2], w4[3]};
#pragma unroll 1
        for (int gi = wv; gi * 64 < nkey; gi += 8) {
            bf16x8 cf[4][2];
#pragma unroll
            for (int j = 0; j < 4; ++j) { cf[j][0] = kf[j][0]; cf[j][1] = kf[j][1]; }
            if ((gi + 8) * 64 < nkey) TK_LOADK(kf, kbase, gi + 8);
#pragma unroll
            for (int j = 0; j < 4; ++j) {
                f32x4 s = (f32x4){0.f, 0.f, 0.f, 0.f};
#pragma unroll
                for (int h = 0; h < 4; ++h) { f32x4 a = (f32x4){0.f, 0.f, 0.f, 0.f}; a = MFMA16(cf[j][0], qf[h][0], a); a = MFMA16(cf[j][1], qf[h][1], a);
#pragma unroll
                    for (int e = 0; e < 4; ++e) s[e] += wq[h] * __builtin_fmaxf(a[e], 0.f); }
#pragma unroll
                for (int e = 0; e < 4; ++e) s[e] = (s[e] == 0.f) ? 0.f : s[e];
                *(LAS3 f32x4*)(sc + r16 * TK_STRIDE + gi * 64 + j * 16 + 4 * g4) = s;
            }
        }
        const int un = u + gridDim.x; int bn = 0, t0n = 0;
        if (un < NTOK / 16) { TK_UNIT(un, bn, t0n); TK_LOADQ(bn, t0n); if (wv * 64 < t0n + 16) TK_LOADK(kf, KI + (size_t)(bn * SEQ + r16) * 64 + 8 * g4, wv); }
        __syncthreads();
#pragma unroll 1
        for (int qq = 0; qq < 2; ++qq) {
            const int q = 2 * wv + qq, t = t0 + q, n = t + 1; const LAS3 float* row = sc + q * TK_STRIDE;
            const int nv = (n - lane + 63) >> 6; const unsigned valid = nv >= 32 ? 0xFFFFFFFFu : (nv <= 0 ? 0u : ((1u << nv) - 1u));
            unsigned sel = valid;
            if (n > 256) {
                unsigned a[32];
#pragma unroll
                for (int i = 0; i < 32; ++i) a[i] = __float_as_uint(row[i * 64 + lane]);
#pragma unroll
                for (int k = 0; k < 16; ++k) { const unsigned x = a[k], y = a[k + 16]; a[k] = __builtin_amdgcn_perm(y, x, 0x05040100u); a[k + 16] = __builtin_amdgcn_perm(y, x, 0x07060302u); }
#pragma unroll
                for (int k = 0; k < 32; ++k) if (!(k & 8)) { const unsigned x = a[k], y = a[k + 8]; a[k] = __builtin_amdgcn_perm(y, x, 0x06020400u); a[k + 8] = __builtin_amdgcn_perm(y, x, 0x07030501u); }
#pragma unroll
                for (int k = 0; k < 32; ++k) if (!(k & 4)) { const unsigned x = a[k], y = a[k + 4]; a[k] = (x & 0x0F0F0F0Fu) | ((y << 4) & 0xF0F0F0F0u); a[k + 4] = ((x >> 4) & 0x0F0F0F0Fu) | (y & 0xF0F0F0F0u); }
#pragma unroll
                for (int k = 0; k < 32; ++k) if (!(k & 2)) { const unsigned x = a[k], y = a[k + 2]; a[k] = (x & 0x33333333u) | ((y << 2) & 0xCCCCCCCCu); a[k + 2] = ((x >> 2) & 0x33333333u) | (y & 0xCCCCCCCCu); }
#pragma unroll
                for (int k = 0; k < 32; ++k) if (!(k & 1)) { const unsigned x = a[k], y = a[k + 1]; a[k] = (x & 0x55555555u) | ((y << 1) & 0xAAAAAAAAu); a[k + 1] = ((x >> 1) & 0x55555555u) | (y & 0xAAAAAAAAu); }
                { const unsigned sg = a[31];
#pragma unroll
                  for (int bb = 0; bb < 31; ++bb) a[bb] ^= sg;
                  a[31] = ~sg; }
                unsigned alive = valid, gt = 0u; int above = 0; bool exact = false;
#pragma unroll
                for (int bb = 31; bb >= 0; --bb) {
                    if (!exact) {
                        const unsigned ones = alive & a[bb];
                        int dummy; const int c = wave_sum_pair(__builtin_popcount(ones), 0, dummy);
                        if (above + c >= 256) { alive = ones; if (above + c == 256) exact = true; }
                        else { above += c; gt |= ones; alive &= ~a[bb]; }
                    }
                }
                sel = gt | alive;
                if (!exact) {
                    int need = 256 - above; unsigned tsel = 0u;
#pragma unroll 1
                    for (int i = 0; i < 32 && need > 0; ++i) {
                        unsigned long long m = __ballot((alive >> i) & 1u); const int c = __builtin_popcountll(m);
                        if (c <= need) { need -= c; }
                        else { unsigned long long keep = 0ull; for (int k2 = 0; k2 < need; ++k2) { const unsigned long long low = m & (~m + 1ull); keep |= low; m ^= low; } m = keep; need = 0; }
                        if ((m >> lane) & 1ull) tsel |= 1u << i;
                    }
                    sel = gt | tsel;
                }
            }
            unsigned long long mine = 0ull;
#pragma unroll
            for (int i = 0; i < 32; ++i) { const unsigned long long m = __ballot((sel >> i) & 1u); mine = (lane == i) ? m : mine; }
            if (lane < 32) *(unsigned long long*)(SEL + (size_t)(tokb + t) * 64 + 2 * lane) = mine;
        }
        __syncthreads();
        b = bn; t0 = t0n;
    }
#undef TK_UNIT
#undef TK_LOADQ
#undef TK_LOADK
}

struct AttnState { f32x16 o0, o1; float m, l, mx; };
struct AttnState8 { f32x16 o0, o1, ol; float m, mx, l; };
DEVI int crow16(int r) { return (r & 3) + 8 * (r >> 2); }
typedef __bf16 bf16x2v __attribute__((ext_vector_type(2)));
#define BFE1(w_, P_) ({ unsigned r_; asm("v_bfe_i32 %0, %1, " #P_ ", 1" : "=v"(r_) : "v"(w_)); r_; })
template <bool TAB4>
DEVI void attn_tile(AttnState& st, bool& zref, const bf16x8 (&qr)[4], const LAS3 unsigned char* kp  , const LAS3 unsigned char* vp  ,
                    const LAS3 float* tq, unsigned w0, unsigned w1  ) {
    f32x16 s0, s1;
    if constexpr (TAB4) {
#pragma unroll
        for (int g = 0; g < 4; ++g) { const f32x4 a = *(const LAS3 f32x4*)(tq + 8 * g), b = *(const LAS3 f32x4*)(tq + 32 + 8 * g);
#pragma unroll
            for (int e = 0; e < 4; ++e) { s0[4 * g + e] = a[e]; s1[4 * g + e] = b[e]; } }
    } else {
#pragma unroll
        for (int r = 0; r < 16; ++r) { s0[r] = tq[63 - crow16(r)]; s1[r] = tq[31 - crow16(r)]; }
    }
    bf16x8 kf[8];
#pragma unroll
    for (int d0 = 0; d0 < 4; ++d0) { kf[2 * d0] = *(const LAS3 bf16x8*)(kp + d0 * 2048); kf[2 * d0 + 1] = *(const LAS3 bf16x8*)(kp + d0 * 2048 + 512); }
#pragma unroll
    for (int d0 = 0; d0 < 4; ++d0) { s0 = MFMA32(kf[2 * d0], qr[d0], s0); s1 = MFMA32(kf[2 * d0 + 1], qr[d0], s1); }
    s16x4 vq[16];
#pragma unroll
    for (int s = 0; s < 4; ++s) { vq[4 * s] = vtr(vp + s * 1024); vq[4 * s + 1] = vtr(vp + s * 1024 + 512); vq[4 * s + 2] = vtr(vp + 4096 + s * 1024); vq[4 * s + 3] = vtr(vp + 4096 + s * 1024 + 512); }
    float mx = max3f(s0[0], s0[1], s1[0]);
#pragma unroll
    for (int r = 1; r < 16; r += 2) mx = max3f(mx, s0[r], r + 1 < 16 ? s0[r + 1] : s0[r]);
#pragma unroll
    for (int r = 1; r < 16; r += 2) mx = max3f(mx, s1[r], r + 1 < 16 ? s1[r + 1] : s1[r]);
    { auto rr = __builtin_amdgcn_permlane32_swap(__float_as_uint(mx), __float_as_uint(mx), false, false); mx = __builtin_fmaxf(__uint_as_float(rr[0]), __uint_as_float(rr[1])); }
    const float runmx = __builtin_fmaxf(st.mx, mx), refm = st.m, dlt = runmx - refm; st.mx = runmx;
    float mref = refm;
    if (__any(dlt > 40.f || (dlt < -80.f && runmx > -1e29f))) {
        const bool mv = dlt > 40.f || (dlt < -80.f && runmx > -1e29f); const float alpha = mv ? __builtin_amdgcn_exp2f(refm - runmx) : 1.0f;
        mref = mv ? runmx : refm; st.m = mref; st.l *= alpha; zref = false;
#pragma unroll
        for (int r = 0; r < 16; ++r) { st.o0[r] *= alpha; st.o1[r] *= alpha; }
    }
    if (zref) {
#pragma unroll
        for (int r = 0; r < 16; ++r) { s0[r] = __builtin_amdgcn_exp2f(s0[r]); s1[r] = __builtin_amdgcn_exp2f(s1[r]); }
    } else {
#pragma unroll
        for (int r = 0; r < 16; ++r) { s0[r] = __builtin_amdgcn_exp2f(s0[r] - mref); s1[r] = __builtin_amdgcn_exp2f(s1[r] - mref); }
    }
#define MSK1(S_, r_, w_, P_) S_[r_] = __uint_as_float(__float_as_uint(S_[r_]) & BFE1(w_, P_))
    MSK1(s0, 0, w0, 0); MSK1(s0, 1, w0, 1); MSK1(s0, 2, w0, 2); MSK1(s0, 3, w0, 3); MSK1(s0, 4, w0, 8); MSK1(s0, 5, w0, 9); MSK1(s0, 6, w0, 10); MSK1(s0, 7, w0, 11); MSK1(s0, 8, w0, 16); MSK1(s0, 9, w0, 17); MSK1(s0, 10, w0, 18); MSK1(s0, 11, w0, 19); MSK1(s0, 12, w0, 24); MSK1(s0, 13, w0, 25); MSK1(s0, 14, w0, 26); MSK1(s0, 15, w0, 27);
    MSK1(s1, 0, w1, 0); MSK1(s1, 1, w1, 1); MSK1(s1, 2, w1, 2); MSK1(s1, 3, w1, 3); MSK1(s1, 4, w1, 8); MSK1(s1, 5, w1, 9); MSK1(s1, 6, w1, 10); MSK1(s1, 7, w1, 11); MSK1(s1, 8, w1, 16); MSK1(s1, 9, w1, 17); MSK1(s1, 10, w1, 18); MSK1(s1, 11, w1, 19); MSK1(s1, 12, w1, 24); MSK1(s1, 13, w1, 25); MSK1(s1, 14, w1, 26); MSK1(s1, 15, w1, 27);
#undef MSK1
    u32x4 pw[4];
#pragma unroll
    for (int q = 0; q < 4; ++q) { pw[0][q] = cvt_pk_bf16(s0[2 * q], s0[2 * q + 1]); pw[1][q] = cvt_pk_bf16(s0[8 + 2 * q], s0[8 + 2 * q + 1]);
                                  pw[2][q] = cvt_pk_bf16(s1[2 * q], s1[2 * q + 1]); pw[3][q] = cvt_pk_bf16(s1[8 + 2 * q], s1[8 + 2 * q + 1]); }
    { float l0 = st.l, l1 = 0.f, l2 = 0.f, l3 = 0.f;
#pragma unroll
      for (int r = 0; r < 16; r += 2) { l0 = fadd1(l0, s0[r]); l1 = fadd1(l1, s0[r + 1]); l2 = fadd1(l2, s1[r]); l3 = fadd1(l3, s1[r + 1]); }
      st.l = fadd1(fadd1(l0, l1), fadd1(l2, l3)); }
#pragma unroll
    for (int s = 0; s < 4; ++s) {
        const s16x4 a0 = vq[4 * s], a1 = vq[4 * s + 1], c0 = vq[4 * s + 2], c1 = vq[4 * s + 3];
        const bf16x8 v0 = (bf16x8){a0[0], a0[1], a0[2], a0[3], a1[0], a1[1], a1[2], a1[3]}, v1 = (bf16x8){c0[0], c0[1], c0[2], c0[3], c1[0], c1[1], c1[2], c1[3]};
        const bf16x8 pf = __builtin_bit_cast(bf16x8, pw[s]);
        st.o0 = MFMA32(v0, pf, st.o0); st.o1 = MFMA32(v1, pf, st.o1);
    }
}
template <bool TAB4, int MASK = 2, bool OLM = true>
DEVI void attn_tile8(AttnState8& st, bool& zref, const pg::v8i_t& q8, const LAS3 unsigned char* kp  , const LAS3 unsigned char* vp  ,
                    const LAS3 float* tq, unsigned w0, unsigned w1  , const LAS3 unsigned char* lut = nullptr) {
    f32x16 s0, s1;
    if constexpr (TAB4) {
#pragma unroll
        for (int g = 0; g < 4; ++g) { const f32x4 a = *(const LAS3 f32x4*)(tq + 8 * g), b = *(const LAS3 f32x4*)(tq + 32 + 8 * g);
#pragma unroll
            for (int e = 0; e < 4; ++e) { s0[4 * g + e] = a[e]; s1[4 * g + e] = b[e]; } }
    } else {
#pragma unroll
        for (int r = 0; r < 16; ++r) { s0[r] = tq[63 - crow16(r)]; s1[r] = tq[31 - crow16(r)]; }
    }
    pg::v8i_t kA, kB;
    kA.lo = *(const LAS3 pg::v4i_t*)kp; kA.hi = *(const LAS3 pg::v4i_t*)(kp + 1024); kB.lo = *(const LAS3 pg::v4i_t*)(kp + 512); kB.hi = *(const LAS3 pg::v4i_t*)(kp + 1024 + 512);
    s0 = __builtin_amdgcn_mfma_scale_f32_32x32x64_f8f6f4(kA, q8, s0, 0, 0, 0, 0x7C7C7C7C, 0, 0x7C7C7C7C);
    s1 = __builtin_amdgcn_mfma_scale_f32_32x32x64_f8f6f4(kB, q8, s1, 0, 0, 0, 0x7C7C7C7C, 0, 0x7C7C7C7C);
    s16x4 vq[16];
#pragma unroll
    for (int s = 0; s < 4; ++s) { vq[4 * s] = vtr(vp + s * 1024); vq[4 * s + 1] = vtr(vp + s * 1024 + 512); vq[4 * s + 2] = vtr(vp + 4096 + s * 1024); vq[4 * s + 3] = vtr(vp + 4096 + s * 1024 + 512); }
    u32x2 pm[8];
    if constexpr (MASK == 2) {
#pragma unroll
        for (int j = 0; j < 4; ++j) { pm[j] = *(const LAS3 u32x2*)(lut + ((w0 >> (8 * j)) & 0xFFu) * 8); pm[4 + j] = *(const LAS3 u32x2*)(lut + ((w1 >> (8 * j)) & 0xFFu) * 8); }
    }
    float mx = max3f(s0[0], s0[1], s1[0]);
#pragma unroll
    for (int r = 1; r < 16; r += 2) mx = max3f(mx, s0[r], r + 1 < 16 ? s0[r + 1] : s0[r]);
#pragma unroll
    for (int r = 1; r < 16; r += 2) mx = max3f(mx, s1[r], r + 1 < 16 ? s1[r + 1] : s1[r]);
    { auto rr = __builtin_amdgcn_permlane32_swap(__float_as_uint(mx), __float_as_uint(mx), false, false); mx = __builtin_fmaxf(__uint_as_float(rr[0]), __uint_as_float(rr[1])); }
    const float runmx = __builtin_fmaxf(st.mx, mx), refm = st.m, dlt = runmx - refm; st.mx = runmx;
    float mref = refm;
    if (__any(dlt > 40.f || (dlt < -80.f && runmx > -1e29f))) {
        const bool mv = dlt > 40.f || (dlt < -80.f && runmx > -1e29f); const float alpha = mv ? __builtin_amdgcn_exp2f(refm - runmx) : 1.0f;
        mref = mv ? runmx : refm; st.m = mref; zref = false;
#pragma unroll
        for (int r = 0; r < 16; ++r) { st.o0[r] *= alpha; st.o1[r] *= alpha; if constexpr (OLM) st.ol[r] *= alpha; }
        if constexpr (!OLM) st.l *= alpha;
    }
    if (zref) {
#pragma unroll
        for (int r = 0; r < 16; ++r) { s0[r] = __builtin_amdgcn_exp2f(s0[r]); s1[r] = __builtin_amdgcn_exp2f(s1[r]); }
    } else {
#pragma unroll
        for (int r = 0; r < 16; ++r) { s0[r] = __builtin_amdgcn_exp2f(s0[r] - mref); s1[r] = __builtin_amdgcn_exp2f(s1[r] - mref); }
    }
#define MSK1(S_, r_, w_, P_) S_[r_] = __uint_as_float(__float_as_uint(S_[r_]) & BFE1(w_, P_))
    if constexpr (MASK == 1) {
    MSK1(s0, 0, w0, 0); MSK1(s0, 1, w0, 1); MSK1(s0, 2, w0, 2); MSK1(s0, 3, w0, 3); MSK1(s0, 4, w0, 8); MSK1(s0, 5, w0, 9); MSK1(s0, 6, w0, 10); MSK1(s0, 7, w0, 11); MSK1(s0, 8, w0, 16); MSK1(s0, 9, w0, 17); MSK1(s0, 10, w0, 18); MSK1(s0, 11, w0, 19); MSK1(s0, 12, w0, 24); MSK1(s0, 13, w0, 25); MSK1(s0, 14, w0, 26); MSK1(s0, 15, w0, 27);
    MSK1(s1, 0, w1, 0); MSK1(s1, 1, w1, 1); MSK1(s1, 2, w1, 2); MSK1(s1, 3, w1, 3); MSK1(s1, 4, w1, 8); MSK1(s1, 5, w1, 9); MSK1(s1, 6, w1, 10); MSK1(s1, 7, w1, 11); MSK1(s1, 8, w1, 16); MSK1(s1, 9, w1, 17); MSK1(s1, 10, w1, 18); MSK1(s1, 11, w1, 19); MSK1(s1, 12, w1, 24); MSK1(s1, 13, w1, 25); MSK1(s1, 14, w1, 26); MSK1(s1, 15, w1, 27);
    }
#undef MSK1
    u32x4 pw[4];
#pragma unroll
    for (int q = 0; q < 4; ++q) { pw[0][q] = cvt_pk_bf16(s0[2 * q], s0[2 * q + 1]); pw[1][q] = cvt_pk_bf16(s0[8 + 2 * q], s0[8 + 2 * q + 1]);
                                  pw[2][q] = cvt_pk_bf16(s1[2 * q], s1[2 * q + 1]); pw[3][q] = cvt_pk_bf16(s1[8 + 2 * q], s1[8 + 2 * q + 1]); }
    if constexpr (MASK == 2) {
#pragma unroll
        for (int t = 0; t < 4; ++t) { pw[t][0] &= pm[2 * t].x; pw[t][1] &= pm[2 * t].y; pw[t][2] &= pm[2 * t + 1].x; pw[t][3] &= pm[2 * t + 1].y; }
    }
    if constexpr (!OLM) { float l0 = st.l, l1 = 0.f, l2 = 0.f, l3 = 0.f;
#pragma unroll
      for (int r = 0; r < 16; r += 2) { l0 = fadd1(l0, s0[r]); l1 = fadd1(l1, s0[r + 1]); l2 = fadd1(l2, s1[r]); l3 = fadd1(l3, s1[r + 1]); }
      st.l = fadd1(fadd1(l0, l1), fadd1(l2, l3)); }
    const bf16x8 ones = (bf16x8){(short)0x3F80, (short)0x3F80, (short)0x3F80, (short)0x3F80, (short)0x3F80, (short)0x3F80, (short)0x3F80, (short)0x3F80};
#pragma unroll
    for (int s = 0; s < 4; ++s) {
        const s16x4 a0 = vq[4 * s], a1 = vq[4 * s + 1], c0 = vq[4 * s + 2], c1 = vq[4 * s + 3];
        const bf16x8 v0 = (bf16x8){a0[0], a0[1], a0[2], a0[3], a1[0], a1[1], a1[2], a1[3]}, v1 = (bf16x8){c0[0], c0[1], c0[2], c0[3], c1[0], c1[1], c1[2], c1[3]};
        const bf16x8 pf = __builtin_bit_cast(bf16x8, pw[s]);
        st.o0 = MFMA32(v0, pf, st.o0); st.o1 = MFMA32(v1, pf, st.o1); if constexpr (OLM) st.ol = MFMA32(ones, pf, st.ol);
    }
}
DEVI float attn_finish8l(AttnState8& st, float& lse2) {
    auto rr = __builtin_amdgcn_permlane32_swap(__float_as_uint(st.l), __float_as_uint(st.l), false, false);
    const float l = __uint_as_float(rr[0]) + __uint_as_float(rr[1]); lse2 = st.m + __builtin_amdgcn_logf(l);
    return __builtin_amdgcn_rcpf(l);
}
DEVI float attn_finish8(AttnState8& st, float& lse2) {
    const float l = st.ol[0]; lse2 = st.m + __builtin_amdgcn_logf(l);
    return __builtin_amdgcn_rcpf(l);
}
DEVI float attn_finish(AttnState& st, float& lse2) {
    auto rr = __builtin_amdgcn_permlane32_swap(__float_as_uint(st.l), __float_as_uint(st.l), false, false);
    const float l = __uint_as_float(rr[0]) + __uint_as_float(rr[1]); lse2 = st.m + __builtin_amdgcn_logf(l);
    return __builtin_amdgcn_rcpf(l);
}
template <class ST> DEVI void attn_store(const ST& st, float rl, bf16_t* rowp, int hi) {
#pragma unroll
    for (int g = 0; g < 4; ++g) {
        u32x2 a, b; a.x = cvt_pk_bf16(st.o0[4 * g] * rl, st.o0[4 * g + 1] * rl); a.y = cvt_pk_bf16(st.o0[4 * g + 2] * rl, st.o0[4 * g + 3] * rl);
        b.x = cvt_pk_bf16(st.o1[4 * g] * rl, st.o1[4 * g + 1] * rl); b.y = cvt_pk_bf16(st.o1[4 * g + 2] * rl, st.o1[4 * g + 3] * rl);
        *(u32x2*)(rowp + 8 * g + 4 * hi) = a; *(u32x2*)(rowp + 32 + 8 * g + 4 * hi) = b;
    }
}

constexpr float Y8_SCALE = 16.0f;
template <class ST> DEVI void attn_store8(const ST& st, float rl, unsigned char* rowp, int hi) {
    const float f = rl * Y8_SCALE;
#pragma unroll
    for (int g = 0; g < 4; ++g) {
        *(unsigned*)(rowp + 8 * g + 4 * hi) = pk4_fp8(st.o0[4 * g] * f, st.o0[4 * g + 1] * f, st.o0[4 * g + 2] * f, st.o0[4 * g + 3] * f);
        *(unsigned*)(rowp + 32 + 8 * g + 4 * hi) = pk4_fp8(st.o1[4 * g] * f, st.o1[4 * g + 1] * f, st.o1[4 * g + 2] * f, st.o1[4 * g + 3] * f);
    }
}

constexpr int DS_K = 0, DS_V = 32768, DS_TAB = 65536, DS_CS = 2128, DS_LUT = 100352;
DEVI void dsa_unit(const Params& p, LAS3 unsigned char* lds, int b, int h, int qb, bool build_tab) {
    const int tid = opaque_tid(), lane = tid & 63, wv = __builtin_amdgcn_readfirstlane(tid >> 6), r32 = lane & 31, hi = lane >> 5;
    const unsigned char* QA = (const unsigned char*)(p.ws + OFF_QA); const unsigned char* KA = (const unsigned char*)(p.ws + OFF_R1); const unsigned char* VA = KA + (size_t)NTOK * 512;
    const unsigned* SEL = (const unsigned*)(p.ws + OFF_SEL);
    LAS3 float* tab = (LAS3 float*)(lds + DS_TAB);
    __syncthreads();
    if (build_tab && tid < 256) { u32x2 e; e.x = ((tid & 1) ? 0xFFFFu : 0u) | ((tid & 2) ? 0xFFFF0000u : 0u); e.y = ((tid & 4) ? 0xFFFFu : 0u) | ((tid & 8) ? 0xFFFF0000u : 0u); *(LAS3 u32x2*)(lds + DS_LUT + tid * 8) = e; }
    if (build_tab)
    {   const float bb = p.rel_bias[(lane & 31) * 20 + h] * LOG2E;
        for (int i = tid; i < 4 * 2112 + 511; i += 512) { const int ii = i < 4 * 2112 ? i : 0, c = ii / 2112, j = ii % 2112, dist = (2111 - j) - 64; const float v = __shfl(bb, rel_bucket(dist < 0 ? 0 : dist));
            if (i < 4 * 2112) tab[c * DS_CS + j + c] = dist < 0 ? 0.f : v; } }
    const size_t hb = (size_t)(b * 8 + h) * SEQ; const int q0 = qb * 256, qw = q0 + 32 * wv, NT2 = 2 * qb + 2, mylast = 4 * qb + (wv >> 1);
    pg::v8i_t q8;
    q8.lo = *(const pg::v4i_t*)(QA + (hb + qw + r32) * 64 + 32 * hi); q8.hi = *(const pg::v4i_t*)(QA + (hb + qw + r32) * 64 + 32 * hi + 16);
    AttnState8 st; st.m = 0.f; st.mx = NEGB; bool zref = true;
#pragma unroll
    for (int r = 0; r < 16; ++r) { st.o0[r] = 0.f; st.o1[r] = 0.f; st.ol[r] = 0.f; }
    const unsigned char* ksrc = KA + (hb + (wv >> 2) * 64 + lane) * 64 + (wv & 3) * 16; const unsigned char* vsrc = VA + (hb + 16 * (wv & 3) + (lane >> 2)) * 64 + (wv >> 2) * 32 + (lane & 3) * 8;
    const int kdst = DS_K + (wv >> 2) * 4096 + (wv & 3) * 1024 + lane * 16, vdst = DS_V + (wv >> 2) * 4096 + (wv & 3) * 1024 + lane * 16;
    const LAS3 unsigned char* kp0 = lds + DS_K + 2 * hi * 1024 + r32 * 16;
    const LAS3 unsigned char* vp0 = lds + DS_V + ((lane >> 4) & 1) * 32 + (lane & 3) * 8 + (4 * hi + ((lane & 15) >> 2)) * 64;
    const unsigned* selrow = SEL + (size_t)(b * SEQ + qw + r32) * 64;
    const int jb = 2111 - (64 + qw + r32 - 4 * hi), cc = (4 - (jb & 3)) & 3;
    const LAS3 float* tqb = tab + cc * DS_CS + jb + cc;
    u32x4 kreg = *(const u32x4*)ksrc; u32x2 vreg0 = *(const u32x2*)vsrc, vreg1 = *(const u32x2*)(vsrc + 4096); u32x4 mwn = *(const u32x4*)selrow;
    *(LAS3 u32x4*)(lds + kdst) = kreg; *(LAS3 u32x4*)(lds + vdst) = fp8x8_to_bf16(vreg0); *(LAS3 u32x4*)(lds + vdst + 8192) = fp8x8_to_bf16(vreg1);
    __syncthreads();
#pragma unroll 1
    for (int t2 = 0; t2 < NT2; ++t2) {
        const int cur = (t2 & 1) * 16384, nxt = 16384 - cur, cur8 = (t2 & 1) * 8192, nxt8 = 8192 - cur8; const u32x4 mw = mwn;
        if (t2 + 1 < NT2) { const size_t o = (size_t)(t2 + 1) * 8192; kreg = *(const u32x4*)(ksrc + o); vreg0 = *(const u32x2*)(vsrc + o); vreg1 = *(const u32x2*)(vsrc + o + 4096);
            mwn = *(const u32x4*)(selrow + 4 * (t2 + 1)); }
        if (2 * t2 <= mylast)
            attn_tile8<true>(st, zref, q8, kp0 + cur8, vp0 + cur, tqb + 128 * t2, mw.x >> (4 * hi), mw.y >> (4 * hi), lds + DS_LUT);
        if (2 * t2 + 1 <= mylast)
            attn_tile8<true>(st, zref, q8, kp0 + cur8 + 4096, vp0 + cur + 8192, tqb + 128 * t2 + 64, mw.z >> (4 * hi), mw.w >> (4 * hi), lds + DS_LUT);
        if (t2 + 1 < NT2) { *(LAS3 u32x4*)(lds + kdst + nxt8) = kreg; *(LAS3 u32x4*)(lds + vdst + nxt) = fp8x8_to_bf16(vreg0); *(LAS3 u32x4*)(lds + vdst + nxt + 8192) = fp8x8_to_bf16(vreg1); }
        __syncthreads();
    }
    float lse2; const float rl = attn_finish8(st, lse2);
    attn_store8(st, rl * (1.0f / D8_SCALE), (unsigned char*)(p.ws + OFF_YA) + (size_t)(b * SEQ + qw + r32) * YAB_LD + h * 64, hi);
}
DEVI void phase_dil_merge(const Params& p) {
    const bf16_t* OG = (const bf16_t*)(p.ws + OFF_OG); const float* LSE = (const float*)(p.ws + OFF_LSE); unsigned char* YB = (unsigned char*)(p.ws + OFF_YA) + 512;
    const size_t stride = (size_t)gridDim.x * 512;
    for (size_t i0 = (size_t)blockIdx.x * 512 + opaque_tid(); i0 < (size_t)NTOK * 32; i0 += 2 * stride) {
        float l[2][3]; u32x4 x[2][3];
#pragma unroll
        for (int k = 0; k < 2; ++k) { const size_t i = i0 + k * stride < (size_t)NTOK * 32 ? i0 + k * stride : i0; const size_t tok = i >> 5; const int c8 = (int)(i & 31) * 8, j = c8 >> 6;
#pragma unroll
            for (int g = 0; g < 3; ++g) { l[k][g] = LSE[(size_t)NTOK * 4 * g + tok * 4 + j]; x[k][g] = *(const u32x4*)(OG + (size_t)NTOK * 256 * g + tok * 256 + c8); } }
#pragma unroll
        for (int k = 0; k < 2; ++k) { const size_t i = i0 + k * stride; if (i < (size_t)NTOK * 32) { const size_t tok = i >> 5; const int c8 = (int)(i & 31) * 8;
            const float mx = max3f(l[k][0], l[k][1], l[k][2]); float a0 = __builtin_amdgcn_exp2f(l[k][0] - mx), a1 = __builtin_amdgcn_exp2f(l[k][1] - mx), a2 = __builtin_amdgcn_exp2f(l[k][2] - mx);
            const float inv = 1.0f / (a0 + a1 + a2); a0 *= inv; a1 *= inv; a2 *= inv;
            float v[8];
#pragma unroll
            for (int q = 0; q < 4; ++q) { v[2 * q] = (a0 * bflo(x[k][0][q]) + a1 * bflo(x[k][1][q]) + a2 * bflo(x[k][2][q])) * Y8_SCALE; v[2 * q + 1] = (a0 * bfhi(x[k][0][q]) + a1 * bfhi(x[k][1][q]) + a2 * bfhi(x[k][2][q])) * Y8_SCALE; }
            u32x2 o; o.x = pk4_fp8(v[0], v[1], v[2], v[3]); o.y = pk4_fp8(v[4], v[5], v[6], v[7]);
            *(u32x2*)(YB + tok * YAB_LD + c8) = o; } }
    }
}
DEVI void phase_dsa(const Params& p, LAS3 unsigned char* lds) {
    int hprev = -1;
    for (int u = blockIdx.x; u < BATCH * 8 * 4; u += gridDim.x) {
        const int b = u >> 5, h = (u >> 2) & 7, j = u & 3;
        dsa_unit(p, lds, b, h, j, h != hprev); dsa_unit(p, lds, b, h, 7 - j, false); hprev = h;
    }
}

constexpr int DL_SET = 73728, DL_VOFF = 24576, DL_TAB = 2 * DL_SET;
static_assert(DL_TAB + 12 * 224 * 4 <= LDS_XB, "dilated phase LDS overflow");
struct DilU { bool tB; int b, gj, r, ls, res0, res1, i0, sg0, nst; size_t hb; };
DEVI DilU dil_decode(int u) {
    DilU d; d.tB = (u % 3) == 2; const int ix = d.tB ? u / 3 : (u / 3) * 2 + (u % 3);
    if (!d.tB) { const int e8 = ix & 7; d.gj = (ix >> 3) & 7; d.b = ix >> 6; d.r = (d.gj >> 2) ? 4 : 1; d.ls = SEQ / d.r; const int nb = d.ls >> 8; d.res0 = d.res1 = e8 / nb; d.i0 = (e8 % nb) * 256; d.sg0 = d.i0 == 0 ? 1 : 0; d.nst = 3; }
    else { const int e8 = ix & 7; d.gj = 8 + ((ix >> 3) & 3); d.b = ix >> 5; d.r = 16; d.ls = 128; d.res0 = 2 * e8; d.res1 = 2 * e8 + 1; d.i0 = 0; d.sg0 = 0; d.nst = 2; }
    d.hb = ((size_t)d.gj * BATCH + d.b) * SEQ; return d;
}
DEVI void phase_dil(const Params& p, LAS3 unsigned char* lds) {
    const int tid = opaque_tid(), lane = tid & 63, wv = __builtin_amdgcn_readfirstlane(tid >> 6), r32 = lane & 31, hi = lane >> 5;
    LAS3 float* tabs = (LAS3 float*)(lds + DL_TAB);
    LAS3 float* rb = (LAS3 float*)lds;
    { const float b0 = p.rel_bias[tid], b1 = tid < 128 ? p.rel_bias[512 + tid] : 0.f; rb[tid] = b0; if (tid < 128) rb[512 + tid] = b1; }
    __syncthreads();
    for (int i = tid; i < 12 * 224; i += 512) { const int gj = i / 224, dist = i % 224 - 64, g = gj >> 2;
        tabs[i] = (dist < 0 || dist > 128) ? NEGB : rb[rel_bucket(dist * dil_r(g)) * 20 + 8 + gj] * LOG2E; }
    __syncthreads();
    const unsigned char* DQ = (const unsigned char*)(p.ws + OFF_DIL); const unsigned char* DK = DQ + DIL_SZ; const unsigned char* DV = DK + DIL_SZ;
    bf16_t* OG = (bf16_t*)(p.ws + OFF_OG); float* LSE = (float*)(p.ws + OFF_LSE);
    u32x4 kreg[3]; u32x2 vreg[3][2]; pg::v8i_t q8n;
#define DLU_TS(d_, sg_, s_) ((d_).tB ? 64 * (sg_) : (d_).i0 - 128 + 64 * (2 * (sg_) + (s_)))
#define DLU_LOAD(d_) do { _Pragma("unroll") for (int j_ = 0; j_ < 3; ++j_) { const int sg_ = (d_).sg0 + j_; if (sg_ < (d_).nst) { \
        { const int sl_ = wv >> 2, ts_ = DLU_TS(d_, sg_, sl_); int kk = ts_ + lane; kk = kk < 0 ? 0 : (kk > (d_).ls - 1 ? (d_).ls - 1 : kk); \
          kreg[j_] = *(const u32x4*)(DK + ((d_).hb + (size_t)(sl_ ? (d_).res1 : (d_).res0) * (d_).ls + kk) * 64 + (wv & 3) * 16); } \
        _Pragma("unroll") for (int s_ = 0; s_ < 2; ++s_) { const int ts_ = DLU_TS(d_, sg_, s_); int vk = ts_ + 16 * (wv & 3) + (lane >> 2); vk = vk < 0 ? 0 : (vk > (d_).ls - 1 ? (d_).ls - 1 : vk); \
          vreg[j_][s_] = *(const u32x2*)(DV + ((d_).hb + (size_t)(s_ ? (d_).res1 : (d_).res0) * (d_).ls + vk) * 64 + (wv >> 2) * 32 + (lane & 3) * 8); } } } \
        { const int wres_ = (d_).tB ? ((wv >> 2) ? (d_).res1 : (d_).res0) : (d_).res0, qpos_ = (d_).i0 + ((d_).tB ? 32 * (wv & 3) : 32 * wv) + r32; \
          const unsigned char* qp_ = DQ + ((d_).hb + (size_t)wres_ * (d_).ls + qpos_) * 64 + 32 * hi; q8n.lo = *(const pg::v4i_t*)qp_; q8n.hi = *(const pg::v4i_t*)(qp_ + 16); } } while (0)
#define DLU_WRITE(d_, set_) do { _Pragma("unroll") for (int j_ = 0; j_ < 3; ++j_) { const int sg_ = (d_).sg0 + j_; if (sg_ < (d_).nst) { \
        *(LAS3 u32x4*)(lds + (set_) + (2 * sg_ + (wv >> 2)) * 4096 + (wv & 3) * 1024 + lane * 16) = kreg[j_]; \
        _Pragma("unroll") for (int s_ = 0; s_ < 2; ++s_) *(LAS3 u32x4*)(lds + (set_) + DL_VOFF + (2 * sg_ + s_) * 8192 + (wv >> 2) * 4096 + (wv & 3) * 1024 + lane * 16) = fp8x8_to_bf16(vreg[j_][s_]); } } } while (0)
    int u = blockIdx.x; DilU d = dil_decode(u < 3072 ? u : 0); pg::v8i_t q8;
    if (u < 3072) { DLU_LOAD(d); DLU_WRITE(d, 0); }
    q8 = q8n;
#pragma unroll 1
    for (int it = 0; u < 3072; u += gridDim.x, ++it) {
        const int set = (it & 1) * DL_SET; const int un = u + gridDim.x; const bool has_next = un < 3072;
        DilU dn = dil_decode(has_next ? un : u);
        if (has_next) DLU_LOAD(dn);
        __syncthreads();
        const int g = d.gj >> 2, j = d.gj & 3;
        const int wres = d.tB ? ((wv >> 2) ? d.res1 : d.res0) : d.res0, wq = d.tB ? 32 * (wv & 3) : 32 * wv, qpos = d.i0 + wq + r32;
        const int tlo = wq >> 6, thi = (wq + 159) >> 6;
        AttnState8 st; st.m = 0.f; st.mx = NEGB; st.l = 0.f; bool zref = true;
#pragma unroll
        for (int q = 0; q < 16; ++q) { st.o0[q] = 0.f; st.o1[q] = 0.f; }
        const LAS3 float* tb = (const LAS3 float*)(lds + DL_TAB) + d.gj * 224;
        const LAS3 unsigned char* kp0 = lds + set + 2 * hi * 1024 + r32 * 16;
        const LAS3 unsigned char* vp0 = lds + set + DL_VOFF + ((lane >> 4) & 1) * 32 + (lane & 3) * 8 + (4 * hi + ((lane & 15) >> 2)) * 64;
#pragma unroll 1
        for (int sg = d.sg0; sg < d.nst; ++sg) {
#pragma unroll
            for (int s_ = 0; s_ < 2; ++s_) {
                const int tau = d.tB ? 2 + sg : 2 * sg + s_, ts = DLU_TS(d, sg, s_), T = 2 * sg + s_;
                const bool mine = tau >= tlo && tau <= thi && (!d.tB || s_ == (wv >> 2)) && ts + 63 >= 0;
                if (mine) {
                    if (ts >= 0) attn_tile8<false, 0, false>(st, zref, q8, kp0 + T * 4096, vp0 + T * 8192, tb + 64 + qpos - ts - 4 * hi - 63, 0u, 0u);
                    else { const unsigned long long vm = ~0ull << (-ts);
                        attn_tile8<false, 1, false>(st, zref, q8, kp0 + T * 4096, vp0 + T * 8192, tb + 64 + qpos - ts - 4 * hi - 63, (unsigned)vm >> (4 * hi), (unsigned)(vm >> 32) >> (4 * hi)); }
                }
            }
        }
        float lse2; const float rl = attn_finish8l(st, lse2);
        const int stok = qpos * d.r + wres; const size_t tok = (size_t)d.b * SEQ + stok;
        attn_store(st, rl * (1.0f / D8_SCALE), OG + ((size_t)g * NTOK + tok) * 256 + j * 64, hi);
        if (hi == 0) LSE[((size_t)g * NTOK + tok) * 4 + j] = lse2;
        if (has_next) DLU_WRITE(dn, DL_SET - set);
        d = dn; q8 = q8n;
    }
#undef DLU_TS
#undef DLU_LOAD
#undef DLU_WRITE
}


#define XB_TMO      128
#define XB_XCNT(j)  (256  + 64 * (j))
#define XB_XSUB(j)  (1280 + 64 * (j))
#define XB_XGEN(j)  (2304 + 64 * (j))
#define XB_TOP      3328
#define XB_TOPGEN   3392
#define XCD_BAR_WORDS 3456
#define XB_SPIN_CAP (1u << 18)
#define LAS __attribute__((address_space(3)))

__device__ __forceinline__ unsigned xb_ld(unsigned* p)              { return __hip_atomic_load(p, __ATOMIC_RELAXED, __HIP_MEMORY_SCOPE_AGENT); }
__device__ __forceinline__ unsigned xb_add(unsigned* p, unsigned v) { return __hip_atomic_fetch_add(p, v, __ATOMIC_RELAXED, __HIP_MEMORY_SCOPE_AGENT); }
__device__ __forceinline__ unsigned xb_xcc_id() { return (unsigned)__builtin_amdgcn_s_getreg((3 << 11) | 20) & 0xFu; }
#define XB_SPIN(cond, bar) do { unsigned _sp = 0; while (cond) { __builtin_amdgcn_s_sleep(1); \
    if ((++_sp & 255u) == 0u) { if (xb_ld(&(bar)[XB_TMO])) break; if (_sp > XB_SPIN_CAP) { atomicAdd(&(bar)[XB_TMO], 1u); break; } } } } while (0)

struct XcdBarrier {
    unsigned* bar; unsigned x;
    volatile LAS unsigned* st;
};

__device__ __forceinline__ XcdBarrier xcd_barrier_post(unsigned* bar, volatile LAS unsigned* st) {
    XcdBarrier b; b.bar = bar; b.x = xb_xcc_id(); b.st = st;
    if (threadIdx.x == 0) (void)xb_add(&bar[XB_XCNT(b.x)], 1u);
    return b;
}
__device__ __forceinline__ void xcd_barrier_complete(unsigned* bar, unsigned x, unsigned& nloc, unsigned& nx) {
    const unsigned G = gridDim.x * gridDim.y * gridDim.z;
    unsigned sum, cnt, mine, sp = 0u;
    for (;;) {
        sum = 0u; cnt = 0u; mine = 0u;
#pragma unroll
        for (unsigned j = 0; j < 16; ++j) { const unsigned c = xb_ld(&bar[XB_XCNT(j)]); sum += c; cnt += (c > 0u) ? 1u : 0u; mine = (j == x) ? c : mine; }
        if (sum == G) break;
        __builtin_amdgcn_s_sleep(1);
        if ((++sp & 255u) == 0u) { if (xb_ld(&bar[XB_TMO])) break; if (sp > XB_SPIN_CAP) { atomicAdd(&bar[XB_TMO], 1u); break; } }
    }
    nloc = mine > 0u ? mine : 1u; nx = cnt > 0u ? cnt : 1u;
}

__device__ __forceinline__ void xcd_barrier(const XcdBarrier& b) {
    asm volatile("s_waitcnt vmcnt(0)" ::: "memory");
    __syncthreads();
    if (threadIdx.x == 0) {
        unsigned* bar = b.bar;
        __builtin_amdgcn_s_waitcnt(0);
        unsigned nloc = b.st[0], nx = b.st[1];
        if (nloc == 0u) { xcd_barrier_complete(bar, b.x, nloc, nx); b.st[0] = nloc; b.st[1] = nx; }
        const unsigned old = xb_add(&bar[XB_XSUB(b.x)], 1u);
        const unsigned gen = old / nloc;
        if (old + 1u == (gen + 1u) * nloc) {
            __builtin_amdgcn_fence(__ATOMIC_RELEASE, "agent");
            asm volatile("s_waitcnt vmcnt(0)" ::: "memory");
            const unsigned og = xb_add(&bar[XB_TOP], 1u);
            const unsigned tg = og / nx;
            if (og + 1u == (tg + 1u) * nx) xb_add(&bar[XB_TOPGEN], 1u);
            else XB_SPIN(xb_ld(&bar[XB_TOPGEN]) == tg, bar);
            __builtin_amdgcn_fence(__ATOMIC_ACQUIRE, "agent");
            xb_add(&bar[XB_XGEN(b.x)], 1u);
            asm volatile("s_waitcnt vmcnt(0)" ::: "memory");
        } else {
            XB_SPIN(xb_ld(&bar[XB_XGEN(b.x)]) == gen, bar);
            __builtin_amdgcn_fence(__ATOMIC_ACQUIRE, "agent");
            asm volatile("s_waitcnt vmcnt(0)" ::: "memory");
        }
    }
    __syncthreads();
}


__global__ void __launch_bounds__(512, 2) fwd(Params p) {
    extern __shared__ __attribute__((aligned(16))) unsigned char smem[];
    LAS3 unsigned char* lds = (LAS3 unsigned char*)smem;
    if (threadIdx.x < 4) ((LAS3 unsigned*)(lds + LDS_XB))[threadIdx.x] = 0u;
    __syncthreads();
    XcdBarrier bar = xcd_barrier_post((unsigned*)(p.ws + OFF_BAR), (volatile LAS unsigned*)(lds + LDS_XB));
    phase_prologue(p, lds);
#if PROBE_DUP == 1
    phase_prologue(p, lds);
#endif
    xcd_barrier(bar);
    phase_proj(p, lds);
    xcd_barrier(bar);
    phase_kv(p, lds);
#if PROBE_DUP == 2
    phase_kv(p, lds);
#endif
    phase_topk(p, lds);
#if PROBE_DUP == 3
    phase_topk(p, lds);
#endif
    __syncthreads();
    phase_dil(p, lds);
#if PROBE_DUP == 4
    __syncthreads(); phase_dil(p, lds);
#endif
    xcd_barrier(bar);
    phase_dil_merge(p);
    phase_dsa(p, lds);
#if PROBE_DUP == 5
    phase_dsa(p, lds);
#endif
    xcd_barrier(bar);
    phase_mix(p, lds);
#if PROBE_DUP == 6
    phase_mix(p, lds);
#endif
    __builtin_amdgcn_fence(__ATOMIC_SEQ_CST, "workgroup"); __syncthreads();
    phase_out(p, lds);
#if PROBE_DUP == 7
    phase_out(p, lds);
#endif
    __builtin_amdgcn_fence(__ATOMIC_SEQ_CST, "workgroup"); __syncthreads();
    phase_route(p, lds);
    phase_expert_weights(p, lds);
#if PROBE_DUP == 11
    phase_expert_weights(p, lds);
#endif
    xcd_barrier(bar);
    build_expert_tables(p, lds);
    phase_gu(p, lds);
#if PROBE_DUP == 8
    phase_gu(p, lds);
#endif
    xcd_barrier(bar);
    phase_down(p, lds);
#if PROBE_DUP == 9
    phase_down(p, lds);
#endif
    xcd_barrier(bar);
    phase_final(p, lds);
#if PROBE_DUP == 10
    phase_final(p, lds);
#endif
}
extern "C" void kernel_launch(void* const* d_in, const int* in_sizes, int n_in, void* d_out, int out_size, void* d_ws, size_t ws_size, hipStream_t stream) {
    Params p{};
    p.x = (const float*)d_in[0]; p.attn_norm = (const float*)d_in[1]; p.w_in = (const float*)d_in[2]; p.kv_norm = (const float*)d_in[3];
    p.w_uk = (const float*)d_in[4]; p.w_uv = (const float*)d_in[5]; p.rel_bias = (const float*)d_in[6]; p.w_a = (const float*)d_in[7]; p.w_b = (const float*)d_in[8];
    p.w_out = (const float*)d_in[9]; p.ffn_norm = (const float*)d_in[10]; p.w_rg = (const float*)d_in[11]; p.b_rg = (const float*)d_in[12]; p.w_re = (const float*)d_in[13];
    p.b_re = (const float*)d_in[14]; p.w_gate = (const float*)d_in[15]; p.w_up = (const float*)d_in[16]; p.w_down = (const float*)d_in[17]; p.final_norm = (const float*)d_in[18];
    p.out = (float*)d_out; p.ws = (char*)d_ws;
    static int grid = 0;
    if (!grid) {
        (void)hipFuncSetAttribute((const void*)fwd, hipFuncAttributeMaxDynamicSharedMemorySize, LDS_TOTAL);
        int dev = 0, cus = 0, per_cu = 0; (void)hipGetDevice(&dev); (void)hipDeviceGetAttribute(&cus, hipDeviceAttributeMultiprocessorCount, dev);
        (void)hipOccupancyMaxActiveBlocksPerMultiprocessor(&per_cu, (const void*)fwd, 512, LDS_TOTAL);
        grid = (cus > 0 ? cus : 256) * (per_cu >= 1 ? 1 : 0);
        if (grid <= 0) { fprintf(stderr, "kernel_launch: fwd does not fit a CU (occupancy query %d)\n", per_cu); grid = -1; }
    }
    if (grid < 0) return;
    (void)hipMemsetAsync((char*)d_ws + OFF_BAR, 0, XCD_BAR_WORDS * sizeof(unsigned), stream);
    (void)hipMemsetAsync((char*)d_ws + OFF_ECNT, 0, 1024, stream);
    fwd<<<grid, 512, LDS_TOTAL, stream>>>(p);
}
```

```cpp
#include <hip/hip_runtime.h>
#include <stdint.h>
#include <stdio.h>
#define PROBE_DUP 0
#define TK_REP_SEL 1
#define TK_REP_TIE 1

typedef unsigned short bf16_t;
#define DEVI __device__ __forceinline__

constexpr int BATCH = 32, SEQ = 2048, DM = 1024, NTOK = BATCH * SEQ;
constexpr int IN_COLS = 5444;
constexpr int NEXP = 32, EFF = 512;
constexpr float RMS_EPS = 1e-6f;
constexpr float LOG2E = 1.4426950408889634f;
constexpr float QSCALE = 0.125f * LOG2E;

constexpr size_t MiB = 1ull << 20;
constexpr size_t OFF_BAR   = 0;
constexpr size_t OFF_SSQ   = 1 * MiB;
constexpr size_t OFF_WI    = 2 * MiB;
constexpr size_t OFF_ECNT  = 3 * MiB;
constexpr size_t OFF_LSE   = 4 * MiB;
constexpr size_t OFF_WTIN  = 8 * MiB;
constexpr size_t OFF_WSM   = 20 * MiB;
constexpr size_t OFF_OG    = 24 * MiB;
constexpr size_t OFF_R1    = 120 * MiB;
constexpr size_t OFF_QA    = 248 * MiB;
constexpr size_t OFF_CR    = 312 * MiB;
constexpr size_t OFF_QI    = 344 * MiB;
constexpr size_t OFF_YA    = 312 * MiB;
constexpr int    YAB_LD    = 768;
constexpr size_t OFF_KI    = 376 * MiB;
constexpr size_t OFF_DIL   = 384 * MiB;
constexpr size_t DIL_SZ    = (size_t)12 * NTOK * 64;
constexpr size_t OFF_YB    = 944 * MiB;
constexpr size_t OFF_MIX   = 416 * MiB;
constexpr size_t OFF_G     = 672 * MiB;
constexpr size_t OFF_H     = 672 * MiB;
constexpr size_t OFF_SEL   = 928 * MiB;

DEVI float bf2f(bf16_t v) { return __uint_as_float(((unsigned)v) << 16); }
DEVI bf16_t f2bf(float f) { unsigned u = __float_as_uint(f); u += 0x7FFFu + ((u >> 16) & 1u); return (bf16_t)(u >> 16); }

DEVI int rel_bucket(int n) {
    if (n < 16) return n < 0 ? 0 : n;
    int b = 16;
    b += (n >= 22) + (n >= 30) + (n >= 40) + (n >= 54) + (n >= 73) + (n >= 99) + (n >= 134) + (n >= 182);
    b += (n >= 246) + (n >= 332) + (n >= 450) + (n >= 609) + (n >= 825) + (n >= 1117) + (n >= 1513);
    return b;
}
DEVI int dil_r(int g) { return g == 0 ? 1 : (g == 1 ? 4 : 16); }


#define LAS3 __attribute__((address_space(3)))
DEVI int opaque_tid() { int t = threadIdx.x; asm volatile("" : "+v"(t)); return t; }
typedef short bf16x8 __attribute__((ext_vector_type(8)));
typedef float f32x4 __attribute__((ext_vector_type(4)));
typedef float f32x2 __attribute__((ext_vector_type(2)));
typedef unsigned u32x4 __attribute__((ext_vector_type(4)));
typedef unsigned u32x2 __attribute__((ext_vector_type(2)));

constexpr int LDS_TOTAL = 163840;
constexpr int LDS_TAB   = 131072;
constexpr int LDS_XB    = LDS_TOTAL - 16;

constexpr size_t OFF_LIST  = 8 * MiB;
constexpr size_t OFF_WEXP  = 16 * MiB;
constexpr size_t OFF_WDN   = OFF_WEXP + 64 * MiB;
constexpr size_t OFF_TT    = OFF_R1;
constexpr size_t OFF_HID   = 248 * MiB;
constexpr size_t OFF_EO    = 384 * MiB;
constexpr size_t OFF_RT    = 5 * MiB;
constexpr size_t OFF_U     = OFF_R1;
constexpr size_t OFF_WKV   = OFF_WSM;
constexpr size_t OFF_WAT   = OFF_WSM + 512 * 1024;
constexpr size_t OFF_WBT   = OFF_WSM + 1536 * 1024;
constexpr size_t OFF_WOT   = 984 * MiB;
constexpr size_t OFF_U8    = OFF_OG;
constexpr size_t OFF_WT8   = 976 * MiB;
constexpr size_t OFF_WAB   = 982 * MiB;
constexpr int NPAD = 5632;

typedef __bf16 bf16x2_t __attribute__((ext_vector_type(2)));
DEVI float fadd1(float a, float b) { float d; asm("v_add_f32 %0, %1, %2" : "=v"(d) : "v"(a), "v"(b)); return d; }
DEVI unsigned cvt_pk_bf16(float lo, float hi) { f32x2 v = {lo, hi}; bf16x2_t r = __builtin_convertvector(v, bf16x2_t); return __builtin_bit_cast(unsigned, r); }
DEVI u32x4 pack8(const f32x4& a, const f32x4& b) { u32x4 w; w.x = cvt_pk_bf16(a[0], a[1]); w.y = cvt_pk_bf16(a[2], a[3]); w.z = cvt_pk_bf16(b[0], b[1]); w.w = cvt_pk_bf16(b[2], b[3]); return w; }
DEVI unsigned pk4_fp8(float a, float b, float c, float d) { unsigned w = 0u; w = __builtin_amdgcn_cvt_pk_fp8_f32(a, b, w, false); w = __builtin_amdgcn_cvt_pk_fp8_f32(c, d, w, true); return w; }
constexpr float D8_SCALE = 8.0f;
constexpr float W8_SCALE = 32.0f, W8_INV = 1.0f / 32.0f;
DEVI u32x4 fp8x8_to_bf16(u32x2 w, float scale) {
    const f32x2 a = __builtin_amdgcn_cvt_pk_f32_fp8(w.x, false), b = __builtin_amdgcn_cvt_pk_f32_fp8(w.x, true), c = __builtin_amdgcn_cvt_pk_f32_fp8(w.y, false), d = __builtin_amdgcn_cvt_pk_f32_fp8(w.y, true);
    u32x4 r; r.x = cvt_pk_bf16(a[0] * scale, a[1] * scale); r.y = cvt_pk_bf16(b[0] * scale, b[1] * scale); r.z = cvt_pk_bf16(c[0] * scale, c[1] * scale); r.w = cvt_pk_bf16(d[0] * scale, d[1] * scale); return r;
}
DEVI u32x4 fp8x8_to_bf16(u32x2 w) {
    const f32x2 a = __builtin_amdgcn_cvt_pk_f32_fp8(w.x, false), b = __builtin_amdgcn_cvt_pk_f32_fp8(w.x, true), c = __builtin_amdgcn_cvt_pk_f32_fp8(w.y, false), d = __builtin_amdgcn_cvt_pk_f32_fp8(w.y, true);
    u32x4 r; r.x = cvt_pk_bf16(a[0], a[1]); r.y = cvt_pk_bf16(b[0], b[1]); r.z = cvt_pk_bf16(c[0], c[1]); r.w = cvt_pk_bf16(d[0], d[1]); return r;
}
DEVI unsigned pk4_u8(float a, float b, float c, float d) { unsigned w = 0u; w = __builtin_amdgcn_cvt_pk_u8_f32(a, 0, w); w = __builtin_amdgcn_cvt_pk_u8_f32(b, 1, w); w = __builtin_amdgcn_cvt_pk_u8_f32(c, 2, w); return __builtin_amdgcn_cvt_pk_u8_f32(d, 3, w); }
DEVI float bflo(unsigned w) { return __uint_as_float(w << 16); }
DEVI float bfhi(unsigned w) { return __uint_as_float(w & 0xFFFF0000u); }
DEVI float fast_sigmoid(float v) { return __builtin_amdgcn_rcpf(1.0f + __expf(-v)); }

struct Params {
    const float *x, *attn_norm, *w_in, *kv_norm, *w_uk, *w_uv, *rel_bias, *w_a, *w_b, *w_out, *ffn_norm, *w_rg, *b_rg, *w_re, *b_re, *w_gate, *w_up, *w_down, *final_norm;
    float* out; char* ws;
};

DEVI void tr_tile(const float* src, int lds_, int ncols_valid, bf16_t* dst, int ldd, const float* rs, LAS3 float* tile) {
    const int tid = opaque_tid();
    { const int c = tid & 63, cs = c < ncols_valid ? c : 0; float v[8], sc[8];
#pragma unroll
      for (int i = 0; i < 8; ++i) { const int r = (tid >> 6) + 8 * i; v[i] = src[(size_t)r * lds_ + cs]; sc[i] = rs ? rs[r] : 1.0f; }
#pragma unroll
      for (int i = 0; i < 8; ++i) tile[((tid >> 6) + 8 * i) * 65 + c] = c < ncols_valid ? v[i] * sc[i] : 0.f; }
    __syncthreads();
    { const int c = tid >> 3, r0 = (tid & 7) * 8;
      u32x4 w;
#pragma unroll
      for (int q = 0; q < 4; ++q) w[q] = cvt_pk_bf16(tile[(r0 + 2 * q) * 65 + c], tile[(r0 + 2 * q + 1) * 65 + c]);
      *(u32x4*)(dst + (size_t)c * ldd + r0) = w; }
    __syncthreads();
}

DEVI void tr_tile8(const float* src, int lds_, unsigned char* dst, int ldd, float scale, LAS3 float* tile, int ncols_valid = 64) {
    const int tid = opaque_tid();
    { const int c = tid & 63, cs = c < ncols_valid ? c : 0; float v[8];
#pragma unroll
      for (int i = 0; i < 8; ++i) v[i] = src[(size_t)((tid >> 6) + 8 * i) * lds_ + cs];
#pragma unroll
      for (int i = 0; i < 8; ++i) tile[((tid >> 6) + 8 * i) * 65 + c] = c < ncols_valid ? v[i] * scale : 0.f; }
    __syncthreads();
    { const int c = tid >> 3, r0 = (tid & 7) * 8; u32x2 w;
      w.x = pk4_fp8(tile[(r0 + 0) * 65 + c], tile[(r0 + 1) * 65 + c], tile[(r0 + 2) * 65 + c], tile[(r0 + 3) * 65 + c]);
      w.y = pk4_fp8(tile[(r0 + 4) * 65 + c], tile[(r0 + 5) * 65 + c], tile[(r0 + 6) * 65 + c], tile[(r0 + 7) * 65 + c]);
      *(u32x2*)(dst + (size_t)c * ldd + r0) = w; }
    __syncthreads();
}

DEVI void phase_prologue(const Params& p, LAS3 unsigned char* lds) {
    LAS3 float* tile = (LAS3 float*)lds;
    const int G = gridDim.x, c = blockIdx.x;
    for (int t = c; t < 88 * 16; t += G) {
        const int nt = t >> 4, kt = t & 15, n0 = nt * 64;
        int sc, nv;
        if (n0 < 1088) { sc = n0; nv = 64; } else if (n0 == 1088) { sc = 1088; nv = 4; } else if (n0 < 1280) { sc = 0; nv = 0; }
        else if (n0 < 3584) { sc = 1092 + (n0 - 1280); nv = 64; } else { sc = 3396 + (n0 - 3584); nv = 64; }
        tr_tile8(p.w_in + (size_t)kt * 64 * IN_COLS + sc, IN_COLS, (unsigned char*)(p.ws + OFF_WT8) + (size_t)n0 * 1024 + kt * 64, 1024, W8_SCALE, tile, nv);
    }
    for (int t = c; t < 16 * 4; t += G) {
        const int which = t >> 5, h = (t >> 2) & 7, kt = t & 3; const float* W = which ? p.w_uv : p.w_uk;
        tr_tile(W + ((size_t)h * 256 + kt * 64) * 64, 64, 64, (bf16_t*)(p.ws + OFF_WKV) + (size_t)(which * 512 + h * 64) * 256 + kt * 64, 256, p.kv_norm + kt * 64, tile);
    }
    for (int t = c; t < 16 * 12 * 2; t += G) {
        const int half = t / 192, r = t % 192, nt = r / 12, kt = r % 12; const bool real = half == 0 ? kt < 8 : kt >= 8;
        const float* src = half == 0 ? p.w_a + (size_t)kt * 64 * 1024 + nt * 64 : p.w_b + (size_t)(kt - 8) * 64 * 1024 + nt * 64;
        tr_tile8(real ? src : p.w_a, 1024, (unsigned char*)(p.ws + OFF_WAB) + (size_t)((nt >> 1) * 256 + half * 128 + (nt & 1) * 64) * YAB_LD + kt * 64, YAB_LD, W8_SCALE, tile, real ? 64 : 0);
    }
    for (int t = c; t < 16 * 16; t += G) { const int nt = t >> 4, kt = t & 15; tr_tile8(p.w_out + (size_t)kt * 64 * 1024 + nt * 64, 1024, (unsigned char*)(p.ws + OFF_WOT) + (size_t)nt * 64 * 1024 + kt * 64, 1024, W8_SCALE, tile); }
    const int lane = opaque_tid() & 63, wv = opaque_tid() >> 6;
    f32x4 gn[4];
#pragma unroll
    for (int q = 0; q < 4; ++q) gn[q] = *(const f32x4*)(p.attn_norm + q * 256 + 4 * lane);
    {
        const int st = G * 8; int tok = c * 8 + wv; f32x4 nx[2][4];
#pragma unroll
        for (int k = 0; k < 2; ++k) if (tok + k * st < NTOK) {
#pragma unroll
            for (int q = 0; q < 4; ++q) nx[k][q] = *(const f32x4*)(p.x + (size_t)(tok + k * st) * 1024 + q * 256 + 4 * lane);
        }
#pragma unroll 1
        for (; tok < NTOK; tok += 2 * st) {
            f32x4 v[2][4];
#pragma unroll
            for (int k = 0; k < 2; ++k)
#pragma unroll
                for (int q = 0; q < 4; ++q) v[k][q] = nx[k][q];
#pragma unroll
            for (int k = 0; k < 2; ++k) if (tok + (2 + k) * st < NTOK) {
#pragma unroll
                for (int q = 0; q < 4; ++q) nx[k][q] = *(const f32x4*)(p.x + (size_t)(tok + (2 + k) * st) * 1024 + q * 256 + 4 * lane);
            }
#pragma unroll
            for (int k = 0; k < 2; ++k) if (tok + k * st < NTOK) {
                float ss = 0.f;
#pragma unroll
                for (int q = 0; q < 4; ++q) ss += v[k][q][0] * v[k][q][0] + v[k][q][1] * v[k][q][1] + v[k][q][2] * v[k][q][2] + v[k][q][3] * v[k][q][3];
#pragma unroll
                for (int o = 32; o > 0; o >>= 1) ss += __shfl_xor(ss, o);
                const float rinv = rsqrtf(ss * (1.0f / 1024.0f) + RMS_EPS);
#pragma unroll
                for (int q = 0; q < 4; ++q)
                    *(unsigned*)((unsigned char*)(p.ws + OFF_U8) + (size_t)(tok + k * st) * 1024 + q * 256 + 4 * lane) = pk4_fp8(v[k][q][0] * rinv * gn[q][0], v[k][q][1] * rinv * gn[q][1], v[k][q][2] * rinv * gn[q][2], v[k][q][3] * rinv * gn[q][3]);
            }
        }
    }
}

DEVI void phase_expert_weights(const Params& p, LAS3 unsigned char* lds) {
    LAS3 float* tile = (LAS3 float*)lds;
    const int G = gridDim.x, c = blockIdx.x, tid = opaque_tid();
    constexpr int NT = NEXP * 256 + NEXP * 128, TB = 4, TSZ = 64 * 65;
#pragma unroll 1
    for (int t0 = c * TB; t0 < NT; t0 += G * TB) {
        const float* src[TB]; int ld[TB]; unsigned char* dst[TB]; int ldd[TB]; float rg[TB][8];
#pragma unroll
        for (int q = 0; q < TB; ++q) {
            const int t = t0 + q;
            if (t < NEXP * 256) { const int e = t >> 8, r = t & 255, half = r >> 7, ft = (r >> 4) & 7, kt = r & 15, pnl = ft >> 1, n = pnl * 256 + half * 128 + (ft & 1) * 64;
                src[q] = (half ? p.w_up : p.w_gate) + (size_t)e * 1024 * 512 + (size_t)kt * 64 * 512 + ft * 64; ld[q] = 512;
                dst[q] = (unsigned char*)(p.ws + OFF_WEXP) + ((size_t)e * 1024 + n) * 1024 + kt * 64; ldd[q] = 1024; }
            else { const int t2 = t - NEXP * 256, e = t2 >> 7, nt = (t2 >> 3) & 15, kt = t2 & 7;
                src[q] = p.w_down + (size_t)e * 512 * 1024 + (size_t)kt * 64 * 1024 + nt * 64; ld[q] = 1024;
                dst[q] = (unsigned char*)(p.ws + OFF_WDN) + ((size_t)e * 1024 + nt * 64) * 512 + kt * 64; ldd[q] = 512; }
#pragma unroll
            for (int i = 0; i < 8; ++i) rg[q][i] = src[q][(size_t)((tid >> 6) + 8 * i) * ld[q] + (tid & 63)];
        }
#pragma unroll
        for (int q = 0; q < TB; ++q)
#pragma unroll
            for (int i = 0; i < 8; ++i) tile[q * TSZ + ((tid >> 6) + 8 * i) * 65 + (tid & 63)] = rg[q][i] * W8_SCALE;
        __syncthreads();
#pragma unroll
        for (int q = 0; q < TB; ++q) { const int cc = tid >> 3, r0 = (tid & 7) * 8; const LAS3 float* tq = tile + q * TSZ; u32x2 w;
            w.x = pk4_fp8(tq[(r0 + 0) * 65 + cc], tq[(r0 + 1) * 65 + cc], tq[(r0 + 2) * 65 + cc], tq[(r0 + 3) * 65 + cc]);
            w.y = pk4_fp8(tq[(r0 + 4) * 65 + cc], tq[(r0 + 5) * 65 + cc], tq[(r0 + 6) * 65 + cc], tq[(r0 + 7) * 65 + cc]);
            *(u32x2*)(dst[q] + (size_t)cc * ldd[q] + r0) = w; }
        __syncthreads();
    }
}

namespace pg {
constexpr int BM = 256, BK = 64, HALF = 128, HTB = HALF * BK * 2, STAGE_BYTES = 8 * HTB, NXCD = 8, WGM = 8;
__host__ __device__ __forceinline__ int lds_byte(int r, int c) { const int st = (r >> 4) * 2 + (c >> 5), rr = r & 15, cc = c & 31, ob = rr * 64 + cc * 2; return st * 1024 + (ob ^ (((ob >> 9) & 1) << 5)); }
__host__ __device__ __forceinline__ void stage_rc(int b, int& R, int& C) { const int st = b / 1024, sb = b % 1024, swz = sb ^ (((sb >> 9) & 1) << 5); R = (st >> 1) * 16 + swz / 64; C = (st & 1) * 32 + (swz % 64) / 2; }
__host__ __device__ __forceinline__ int perm32(int rho) { const int n = rho >> 4, i = rho & 15; return 8 * (i >> 2) + 4 * n + (i & 3); }

struct Unit { int pm, pn, pb, lbase, nvalid; };
struct Gemm { const bf16_t* A; const bf16_t* Bt; int K; const int* list; };

struct StaticOrder {
    int nM, nN, nwg, G, c, pnoff, skip0, skipn;
    __device__ void init(int M, int N, int G_, int c_, int pnoff_ = 0, int skip0_ = 1 << 30, int skipn_ = 0) { nM = M / BM; nN = N / BM; nwg = nM * nN; G = G_; c = c_; pnoff = pnoff_; skip0 = skip0_; skipn = skipn_; }
    __device__ bool next(int i, Unit& u) const {
        const long L = (long)i * G + c; if (L >= nwg) return false;
        int wgid = (int)L; { const int q = nwg / NXCD, r = nwg % NXCD, xcd = wgid % NXCD, off = wgid / NXCD; wgid = (xcd < r ? xcd * (q + 1) : r * (q + 1) + (xcd - r) * q) + off; }
        const int nig = WGM * nN, gid = wgid / nig, fm = gid * WGM, gsz = (nM - fm) < WGM ? (nM - fm) : WGM;
        u.pm = fm + ((wgid % nig) % gsz); u.pb = (wgid % nig) / gsz; u.pn = u.pb + pnoff + (u.pb >= skip0 ? skipn : 0); u.lbase = 0; u.nvalid = 0; return true;
    }
};
struct RowOrder {
    int nM, nN, G, c;
    __device__ bool next(int i, Unit& u) const { const int rt = c + (i / nN) * G; if (rt >= nM) return false; u.pm = rt; u.pb = i % nN; u.pn = u.pb; u.lbase = 0; u.nvalid = 0; return true; }
};
struct GroupedOrder {
    const LAS3 int* tb; const LAS3 int* cnt; int G, c;
    __device__ bool next(int i, Unit& u) const {
        const int L = i * G + c; const int T = tb[32]; if (L >= T * 4) return false;
        const int t = L >> 2; int e = 0;
#pragma unroll 1
        while (tb[e + 1] <= t) ++e;
        const int ti = t - tb[e];
        u.pm = t; u.pn = e * 4 + (L & 3); u.pb = u.pn; u.lbase = e * 65536 + ti * 256; u.nvalid = cnt[e] - ti * 256; return true;
    }
};

typedef int v8i_t __attribute__((ext_vector_type(8)));
typedef int v4i_t __attribute__((ext_vector_type(4)));
template <bool F8> struct Frag;
template <> struct Frag<false> { bf16x8 v[2]; };
template <> struct Frag<true>  { v8i_t v; };
__device__ __forceinline__ void frag_load(Frag<false>& f, const LAS3 unsigned char* p) { f.v[0] = *(const LAS3 bf16x8*)p; f.v[1] = *(const LAS3 bf16x8*)(p + 1024); }
__device__ __forceinline__ void frag_load(Frag<true>& f, const LAS3 unsigned char* p) { f.v.lo = *(const LAS3 v4i_t*)p; f.v.hi = *(const LAS3 v4i_t*)(p + 1024); }
__device__ __forceinline__ f32x4 frag_mma(const Frag<false>& b, const Frag<false>& a, f32x4 c) { c = __builtin_amdgcn_mfma_f32_16x16x32_bf16(b.v[0], a.v[0], c, 0, 0, 0); return __builtin_amdgcn_mfma_f32_16x16x32_bf16(b.v[1], a.v[1], c, 0, 0, 0); }
__device__ __forceinline__ f32x4 frag_mma(const Frag<true>& b, const Frag<true>& a, f32x4 c) {
    asm volatile("v_mfma_scale_f32_16x16x128_f8f6f4 %0, %1, %2, %0, %3, %3 op_sel_hi:[0,0,0]" : "+v"(c) : "v"(b.v), "v"(a.v), "v"(0x7F7F7F7F));
    return c;
}

template <class Epi, class Sched, bool GATHER, bool F8 = false, int TSPLIT = 0>
__device__ __forceinline__ void gemm_phase(LAS3 unsigned char* lds, const Gemm g, const Sched& S, const Epi& E) {
    const int tid = opaque_tid(), wid = __builtin_amdgcn_readfirstlane(tid >> 6), lane = tid & 63, wr = wid >> 2, wc = wid & 3, fr = lane & 15, fq = lane >> 4;
    const int K = F8 ? g.K : g.K * 2, nt = K / (BK * 2);
    unsigned voffA[2], voffB[2]; int Rr[2], Cc[2];
#pragma unroll
    for (int i = 0; i < 2; ++i) { int R, C; stage_rc(tid * 16 + i * 8192, R, C); const int Rb = Epi::PERM ? ((R & ~31) + perm32(R & 31)) : R; Rr[i] = R; Cc[i] = C;
        voffA[i] = (unsigned)(R * K + C * 2); voffB[i] = (unsigned)(Rb * K + C * 2); }
    const size_t kstep = (size_t)(BK * 2);
    const size_t hstep = (size_t)HALF * K;
    const size_t tstep = 2 * hstep;
    const unsigned ldsw = (unsigned)wid * 1024u;
    const int aoff = lds_byte(wr * 64 + fr, fq * 8), boff = lds_byte(wc * 32 + fr, fq * 8);
#define PG_SA(b, h) (((b) * 2 + (h)) * HTB)
#define PG_SB(b, h) ((4 + (b) * 2 + (h)) * HTB)
#define PG_STAGE(bufoff, gbase, voff) do { _Pragma("unroll") for (int _i = 0; _i < 2; ++_i) \
        __builtin_amdgcn_global_load_lds((const unsigned*)((const char*)(gbase) + (voff)[_i]), (LAS3 unsigned*)(lds + (bufoff) + ldsw + _i * 8192), 16, 0, 0); } while (0)
#define PG_STAGE2(bufoff, gbase, o0, o1) do { \
        __builtin_amdgcn_global_load_lds((const unsigned*)((const char*)(gbase) + (o0)), (LAS3 unsigned*)(lds + (bufoff) + ldsw), 16, 0, 0); \
        __builtin_amdgcn_global_load_lds((const unsigned*)((const char*)(gbase) + (o1)), (LAS3 unsigned*)(lds + (bufoff) + ldsw + 8192), 16, 0, 0); } while (0)
#define PG_LDA(dst, b, h) do { _Pragma("unroll") for (int m = 0; m < 4; ++m) frag_load(dst[m], lds + PG_SA(b, h) + aoff + m * 2048); } while (0)
#define PG_LDB(dst, b, h) do { _Pragma("unroll") for (int n = 0; n < 2; ++n) frag_load(dst[n], lds + PG_SB(b, h) + boff + n * 2048); } while (0)
#define PG_MMA(ai, bj, At, Bt) do { __builtin_amdgcn_s_setprio(1); _Pragma("unroll") for (int m = 0; m < 4; ++m) _Pragma("unroll") for (int n = 0; n < 2; ++n) \
        acc[ai][bj][m][n] = frag_mma(Bt[n], At[m], acc[ai][bj][m][n]); __builtin_amdgcn_s_setprio(0); } while (0)
#define PG_WAIT_V(n) asm volatile("s_waitcnt vmcnt(" #n ")" ::: "memory")
#define PG_WAIT_L(n) asm volatile("s_waitcnt lgkmcnt(" #n ")" ::: "memory")
#define PG_BAR __builtin_amdgcn_s_barrier()
#define PG_SCHED __builtin_amdgcn_sched_barrier(0)
    Unit cur, nxt; int ui = 0;
    if (!S.next(0, cur)) return;
    f32x4 acc[2][2][4][2];
#pragma unroll
    for (int a = 0; a < 2; ++a)
#pragma unroll
        for (int b = 0; b < 2; ++b)
#pragma unroll
            for (int m = 0; m < 4; ++m)
#pragma unroll
                for (int n = 0; n < 2; ++n) acc[a][b][m][n] = (f32x4){0.f, 0.f, 0.f, 0.f};
    Frag<F8> At[4], B0[2], B1[2];
    unsigned gc[2][2] = {{0u, 0u}, {0u, 0u}}, gn[2][2] = {{0u, 0u}, {0u, 0u}};
    auto load_go = [&](const Unit& u, unsigned (&go)[2][2]) {
#pragma unroll
        for (int h = 0; h < 2; ++h)
#pragma unroll
            for (int i = 0; i < 2; ++i) { int r = h * HALF + Rr[i]; r = r < u.nvalid ? r : u.nvalid - 1; const int tok = g.list[u.lbase + r]; go[h][i] = (unsigned)tok * (unsigned)K + (unsigned)(Cc[i] * 2); }
    };
    const char* cA = GATHER ? (const char*)g.A : (const char*)g.A + (size_t)cur.pm * tstep; const char* cB = (const char*)g.Bt + (size_t)cur.pb * tstep;
    if (GATHER) {
        load_go(cur, gc);
#pragma unroll
        for (int h = 0; h < 2; ++h)
#pragma unroll
            for (int i = 0; i < 2; ++i) gn[h][i] = gc[h][i];
        PG_STAGE(PG_SB(0, 0), cB, voffB); PG_STAGE2(PG_SA(0, 0), cA, gc[0][0], gc[0][1]); PG_STAGE(PG_SB(0, 1), cB + hstep, voffB); PG_STAGE2(PG_SA(0, 1), cA, gc[1][0], gc[1][1]);
        if (wr == 1) PG_BAR;
        PG_WAIT_V(4); PG_BAR;
        PG_STAGE(PG_SB(1, 0), cB + kstep, voffB); PG_STAGE2(PG_SA(1, 0), cA + kstep, gc[0][0], gc[0][1]); PG_STAGE(PG_SB(1, 1), cB + hstep + kstep, voffB);
        PG_WAIT_V(6); PG_BAR;
    } else {
        PG_STAGE(PG_SB(0, 0), cB, voffB); PG_STAGE(PG_SA(0, 0), cA, voffA); PG_STAGE(PG_SB(0, 1), cB + hstep, voffB); PG_STAGE(PG_SA(0, 1), cA + hstep, voffA);
        if (wr == 1) PG_BAR;
        PG_WAIT_V(4); PG_BAR;
        PG_STAGE(PG_SB(1, 0), cB + kstep, voffB); PG_STAGE(PG_SA(1, 0), cA + kstep, voffA); PG_STAGE(PG_SB(1, 1), cB + hstep + kstep, voffB);
        PG_WAIT_V(6); PG_BAR;
    }
    for (;;) {
        const bool has_next = S.next(ui + 1, nxt);
        const char* nA = GATHER ? cA : (has_next ? (const char*)g.A + (size_t)nxt.pm * tstep : cA); const char* nB = has_next ? (const char*)g.Bt + (size_t)nxt.pb * tstep : cB;
#pragma unroll 1
        for (int t = 0; t < nt; t += 2) {
            const bool last = (t == nt - 2);
            if (GATHER) { if (last && has_next) load_go(nxt, gn); }
            const char* a1 = cA + (size_t)(t + 1) * kstep;
            const char* a2 = last ? nA : cA + (size_t)(t + 2) * kstep; const char* b2 = last ? nB : cB + (size_t)(t + 2) * kstep;
            const char* a3 = a2 + kstep; const char* b3 = b2 + kstep;
            const bool sel0 = t < TSPLIT;
            PG_LDB(B0, 0, 0); PG_SCHED; PG_LDA(At, 0, 0);
            if (GATHER) PG_STAGE2(PG_SA(1, 1), a1, gc[1][0], gc[1][1]); else PG_STAGE(PG_SA(1, 1), a1 + hstep, voffA);
            PG_WAIT_L(8); PG_BAR; PG_WAIT_L(0); if (!TSPLIT || sel0) PG_MMA(0, 0, At, B0); PG_BAR; PG_SCHED;
            PG_LDB(B1, 0, 1); PG_STAGE(PG_SB(0, 0), b2, voffB);
            PG_BAR; PG_WAIT_L(0); if (!TSPLIT || !sel0) PG_MMA(0, 1, At, B1); PG_BAR;
            PG_LDA(At, 0, 1);
            if (GATHER) PG_STAGE2(PG_SA(0, 0), a2, last ? gn[0][0] : gc[0][0], last ? gn[0][1] : gc[0][1]); else PG_STAGE(PG_SA(0, 0), a2, voffA);
            PG_BAR; PG_WAIT_L(0); if (!TSPLIT || sel0) PG_MMA(1, 0, At, B0); PG_BAR; PG_SCHED;
            PG_STAGE(PG_SB(0, 1), b2 + hstep, voffB);
            PG_WAIT_V(6); PG_BAR; if (!TSPLIT || !sel0) PG_MMA(1, 1, At, B1); PG_BAR;
            PG_LDB(B0, 1, 0); PG_SCHED; PG_LDA(At, 1, 0);
            if (GATHER) PG_STAGE2(PG_SA(0, 1), a2, last ? gn[1][0] : gc[1][0], last ? gn[1][1] : gc[1][1]); else PG_STAGE(PG_SA(0, 1), a2 + hstep, voffA);
            PG_WAIT_L(8); PG_BAR; PG_WAIT_L(0); if (!TSPLIT || sel0) PG_MMA(0, 0, At, B0); PG_BAR; PG_SCHED;
            PG_LDB(B1, 1, 1); PG_STAGE(PG_SB(1, 0), b3, voffB);
            PG_BAR; PG_WAIT_L(0); if (!TSPLIT || !sel0) PG_MMA(0, 1, At, B1); PG_BAR;
            PG_LDA(At, 1, 1);
            if (GATHER) PG_STAGE2(PG_SA(1, 0), a3, last ? gn[0][0] : gc[0][0], last ? gn[0][1] : gc[0][1]); else PG_STAGE(PG_SA(1, 0), a3, voffA);
            PG_BAR; PG_WAIT_L(0); if (!TSPLIT || sel0) PG_MMA(1, 0, At, B0); PG_BAR; PG_SCHED;
            PG_STAGE(PG_SB(1, 1), b3 + hstep, voffB);
            PG_WAIT_V(6); PG_BAR; if (!TSPLIT || !sel0) PG_MMA(1, 1, At, B1); PG_BAR;
        }
        if constexpr (F8) asm volatile("s_nop 15\n\ts_nop 15" ::: "memory");
        E(acc, cur, wr, wc, fr, fq);
        if (!has_next) break;
#pragma unroll
        for (int a = 0; a < 2; ++a)
#pragma unroll
            for (int b = 0; b < 2; ++b)
#pragma unroll
                for (int m = 0; m < 4; ++m)
#pragma unroll
                    for (int n = 0; n < 2; ++n) acc[a][b][m][n] = (f32x4){0.f, 0.f, 0.f, 0.f};
        cur = nxt; cA = nA; cB = nB; ++ui;
        if (GATHER) {
#pragma unroll
            for (int h = 0; h < 2; ++h)
#pragma unroll
                for (int i = 0; i < 2; ++i) gc[h][i] = gn[h][i];
        }
    }
    PG_WAIT_V(0);
    if (wr == 0) PG_BAR;
    PG_BAR;
#undef PG_SA
#undef PG_SB
#undef PG_STAGE
#undef PG_STAGE2
#undef PG_LDA
#undef PG_LDB
#undef PG_MMA
#undef PG_WAIT_V
#undef PG_WAIT_L
#undef PG_BAR
#undef PG_SCHED
}
}

template <class F> __device__ __forceinline__ void epi_rows(int row0, F f) {
#pragma unroll
    for (int ai = 0; ai < 2; ++ai)
#pragma unroll
        for (int m = 0; m < 4; ++m) f(ai, m, row0 + ai * 128 + m * 16);
}
struct EpiProj {
    static constexpr bool PERM = true; char* ws;
    __device__ __forceinline__ void operator()(const f32x4 (&acc)[2][2][4][2], const pg::Unit& u, int wr, int wc, int fr, int fq) const {
        const int row0 = u.pm * 256 + wr * 64 + fr, pn = u.pn, cw = wc * 32 + 8 * fq;
        if (pn < 2) {
            unsigned char* QA = (unsigned char*)(ws + OFF_QA);
            epi_rows(row0, [&](int ai, int m, int tok) { const int b = tok >> 11, s = tok & 2047;
#pragma unroll
                for (int bj = 0; bj < 2; ++bj) { const int col = pn * 256 + bj * 128 + cw, h = col >> 6, d = col & 63;
                    const f32x4 a = acc[ai][bj][m][0] * (QSCALE * W8_INV * D8_SCALE), c = acc[ai][bj][m][1] * (QSCALE * W8_INV * D8_SCALE); u32x2 w; w.x = pk4_fp8(a[0], a[1], a[2], a[3]); w.y = pk4_fp8(c[0], c[1], c[2], c[3]);
                    *(u32x2*)(QA + ((size_t)(b * 8 + h) * SEQ + s) * 64 + d) = w; } });
        } else if (pn == 2) {
            bf16_t* CR = (bf16_t*)(ws + OFF_CR); float* SSQ = (float*)(ws + OFF_SSQ);
            epi_rows(row0, [&](int ai, int m, int tok) { float ss = 0.f;
#pragma unroll
                for (int bj = 0; bj < 2; ++bj) { const f32x4 a = acc[ai][bj][m][0] * W8_INV, b = acc[ai][bj][m][1] * W8_INV;
                    ss += a[0] * a[0] + a[1] * a[1] + a[2] * a[2] + a[3] * a[3] + b[0] * b[0] + b[1] * b[1] + b[2] * b[2] + b[3] * b[3];
                    *(u32x4*)(CR + (size_t)tok * 256 + bj * 128 + cw) = pack8(a, b); }
                ss += __shfl_xor(ss, 16); ss += __shfl_xor(ss, 32);
                if (fq == 0) SSQ[(size_t)tok * 4 + wc] = ss; });
        } else if (pn == 3) {
            bf16_t* QI = (bf16_t*)(ws + OFF_QI);
            epi_rows(row0, [&](int ai, int m, int tok) {
#pragma unroll
                for (int bj = 0; bj < 2; ++bj) *(u32x4*)(QI + (size_t)tok * 256 + bj * 128 + cw) = pack8(acc[ai][bj][m][0] * W8_INV, acc[ai][bj][m][1] * W8_INV); });
        } else if (pn == 4) {
            bf16_t* KI = (bf16_t*)(ws + OFF_KI); float* WI = (float*)(ws + OFF_WI);
            epi_rows(row0, [&](int ai, int m, int tok) { if (cw < 64) *(u32x4*)(KI + (size_t)tok * 64 + cw) = pack8(acc[ai][0][m][0] * W8_INV, acc[ai][0][m][1] * W8_INV);
                       else if (cw == 64) *(f32x4*)(WI + (size_t)tok * 4) = acc[ai][0][m][0] * W8_INV; });
        } else if (pn < 14) {
            const int t9 = pn - 5, qkv = t9 / 3, g = t9 % 3, r = dil_r(g), ls = SEQ / r;
            unsigned char* base = (unsigned char*)(ws + OFF_DIL) + (size_t)qkv * DIL_SZ; const float sc = (qkv == 0 ? QSCALE : 1.0f) * W8_INV * D8_SCALE;
            epi_rows(row0, [&](int ai, int m, int tok) { const int b = tok >> 11, s = tok & 2047, pp = (s % r) * ls + s / r;
#pragma unroll
                for (int bj = 0; bj < 2; ++bj) { const int col = bj * 128 + cw, j = col >> 6, d = col & 63;
                    const f32x4 a = acc[ai][bj][m][0] * sc, c = acc[ai][bj][m][1] * sc; u32x2 w; w.x = pk4_fp8(a[0], a[1], a[2], a[3]); w.y = pk4_fp8(c[0], c[1], c[2], c[3]);
                    *(u32x2*)(base + (((size_t)(g * 4 + j) * BATCH + b) * SEQ + pp) * 64 + d) = w; } });
        } else {
            unsigned char* G = (unsigned char*)(ws + OFF_G);
            epi_rows(row0, [&](int ai, int m, int tok) {
#pragma unroll
                for (int bj = 0; bj < 2; ++bj) { f32x4 a = acc[ai][bj][m][0], b = acc[ai][bj][m][1];
#pragma unroll
                    for (int q = 0; q < 4; ++q) { a[q] = fast_sigmoid(a[q] * W8_INV) * 255.0f; b[q] = fast_sigmoid(b[q] * W8_INV) * 255.0f; }
                    u32x2 w; w.x = pk4_u8(a[0], a[1], a[2], a[3]); w.y = pk4_u8(b[0], b[1], b[2], b[3]);
                    *(u32x2*)(G + (size_t)tok * 2048 + (pn - 14) * 256 + bj * 128 + cw) = w; } });
        }
    }
};
struct EpiKV {
    static constexpr bool PERM = true; char* ws;
    __device__ __forceinline__ void operator()(const f32x4 (&acc)[2][2][4][2], const pg::Unit& u, int wr, int wc, int fr, int fq) const {
        const int row0 = u.pm * 256 + wr * 64 + fr, pn = u.pn, cw = wc * 32 + 8 * fq;
        unsigned char* O = (unsigned char*)(ws + OFF_R1) + (size_t)(pn >> 1) * NTOK * 512; const float* SSQ = (const float*)(ws + OFF_SSQ);
        f32x4 sqv[2][4];
        epi_rows(row0, [&](int ai, int m, int tok) { sqv[ai][m] = *(const f32x4*)(SSQ + (size_t)tok * 4); });
        epi_rows(row0, [&](int ai, int m, int tok) { const int b = tok >> 11, s = tok & 2047; const f32x4 sq = sqv[ai][m]; const float rinv = rsqrtf(((sq[0] + sq[1]) + (sq[2] + sq[3])) * (1.0f / 256.0f) + RMS_EPS);
#pragma unroll
            for (int bj = 0; bj < 2; ++bj) { const int col = (pn & 1) * 256 + bj * 128 + cw, h = col >> 6, d = col & 63;
                const f32x4 a = acc[ai][bj][m][0] * (rinv * D8_SCALE), c = acc[ai][bj][m][1] * (rinv * D8_SCALE); u32x2 w; w.x = pk4_fp8(a[0], a[1], a[2], a[3]); w.y = pk4_fp8(c[0], c[1], c[2], c[3]);
                *(u32x2*)(O + ((size_t)(b * 8 + h) * SEQ + s) * 64 + d) = w; } });
    }
};
struct EpiMix2 {
    static constexpr bool PERM = true; char* ws;
    __device__ __forceinline__ void operator()(const f32x4 (&acc)[2][2][4][2], const pg::Unit& u, int wr, int wc, int fr, int fq) const {
        const int row0 = u.pm * 256 + wr * 64 + fr, col = u.pn * 128 + wc * 32 + 8 * fq;
        unsigned char* MIX = (unsigned char*)(ws + OFF_MIX); const unsigned char* G = (const unsigned char*)(ws + OFF_G); constexpr float I255 = 1.0f / 255.0f;
        u32x2 gav[2][4], gbv[2][4];
        epi_rows(row0, [&](int ai, int m, int tok) { gav[ai][m] = *(const u32x2*)(G + (size_t)tok * 2048 + col); gbv[ai][m] = *(const u32x2*)(G + (size_t)tok * 2048 + 1024 + col); });
        epi_rows(row0, [&](int ai, int m, int tok) {
            const u32x2 ga = gav[ai][m], gb = gbv[ai][m];
            f32x4 a = acc[ai][0][m][0], b = acc[ai][0][m][1]; const f32x4 c = acc[ai][1][m][0], d = acc[ai][1][m][1];
            a[0] = a[0] * (float)(ga.x & 255u) + c[0] * (float)(gb.x & 255u); a[1] = a[1] * (float)((ga.x >> 8) & 255u) + c[1] * (float)((gb.x >> 8) & 255u);
            a[2] = a[2] * (float)((ga.x >> 16) & 255u) + c[2] * (float)((gb.x >> 16) & 255u); a[3] = a[3] * (float)(ga.x >> 24) + c[3] * (float)(gb.x >> 24);
            b[0] = b[0] * (float)(ga.y & 255u) + d[0] * (float)(gb.y & 255u); b[1] = b[1] * (float)((ga.y >> 8) & 255u) + d[1] * (float)((gb.y >> 8) & 255u);
            b[2] = b[2] * (float)((ga.y >> 16) & 255u) + d[2] * (float)((gb.y >> 16) & 255u); b[3] = b[3] * (float)(ga.y >> 24) + d[3] * (float)(gb.y >> 24);
            a = a * (I255 * W8_INV / 16.0f); b = b * (I255 * W8_INV / 16.0f);
            u32x2 w; w.x = pk4_fp8(a[0], a[1], a[2], a[3]); w.y = pk4_fp8(b[0], b[1], b[2], b[3]);
            *(u32x2*)(MIX + (size_t)tok * 1024 + col) = w; });
    }
};
struct EpiOut {
    static constexpr bool PERM = true; char* ws; const float* x;
    __device__ __forceinline__ void operator()(const f32x4 (&acc)[2][2][4][2], const pg::Unit& u, int wr, int wc, int fr, int fq) const {
        const int row0 = u.pm * 256 + wr * 64 + fr, cw = wc * 32 + 8 * fq; bf16_t* D = (bf16_t*)(ws + OFF_H);
        epi_rows(row0, [&](int ai, int m, int tok) {
#pragma unroll
            for (int bj = 0; bj < 2; ++bj) *(u32x4*)(D + (size_t)tok * 1024 + u.pn * 256 + bj * 128 + cw) = pack8(acc[ai][bj][m][0] * W8_INV, acc[ai][bj][m][1] * W8_INV); });
    }
};
struct EpiGU {
    static constexpr bool PERM = true; char* ws;
    __device__ __forceinline__ void operator()(const f32x4 (&acc)[2][2][4][2], const pg::Unit& u, int wr, int wc, int fr, int fq) const {
        const int row0 = u.pm * 256 + wr * 64 + fr, cw = wc * 32 + 8 * fq; unsigned char* HID = (unsigned char*)(ws + OFF_HID);
        epi_rows(row0, [&](int ai, int m, int tok) { f32x4 a = acc[ai][0][m][0] * W8_INV, b = acc[ai][0][m][1] * W8_INV; const f32x4 ua = acc[ai][1][m][0] * W8_INV, ub = acc[ai][1][m][1] * W8_INV;
#pragma unroll
            for (int q = 0; q < 4; ++q) { a[q] = a[q] * fast_sigmoid(a[q]) * ua[q]; b[q] = b[q] * fast_sigmoid(b[q]) * ub[q]; }
            u32x2 w; w.x = pk4_fp8(a[0], a[1], a[2], a[3]); w.y = pk4_fp8(b[0], b[1], b[2], b[3]);
            *(u32x2*)(HID + (size_t)tok * 512 + (u.pn & 3) * 128 + cw) = w; });
    }
};
struct EpiDown {
    static constexpr bool PERM = true; char* ws;
    __device__ __forceinline__ void operator()(const f32x4 (&acc)[2][2][4][2], const pg::Unit& u, int wr, int wc, int fr, int fq) const {
        const int row0 = u.pm * 256 + wr * 64 + fr, cw = wc * 32 + 8 * fq; unsigned char* EO = (unsigned char*)(ws + OFF_EO);
        epi_rows(row0, [&](int ai, int m, int tok) {
#pragma unroll
            for (int bj = 0; bj < 2; ++bj) { const f32x4 a = acc[ai][bj][m][0] * W8_INV, b = acc[ai][bj][m][1] * W8_INV; u32x2 w; w.x = pk4_fp8(a[0], a[1], a[2], a[3]); w.y = pk4_fp8(b[0], b[1], b[2], b[3]);
                *(u32x2*)(EO + (size_t)tok * 1024 + (u.pn & 3) * 256 + bj * 128 + cw) = w; } });
    }
};

DEVI void phase_proj(const Params& p, LAS3 unsigned char* lds) {
    pg::StaticOrder S; S.init(NTOK, 5632, gridDim.x, blockIdx.x);
    pg::gemm_phase<EpiProj, pg::StaticOrder, false, true>(lds, pg::Gemm{(const bf16_t*)(p.ws + OFF_U8), (const bf16_t*)(p.ws + OFF_WT8), 1024, nullptr}, S, EpiProj{p.ws});
}
DEVI void phase_kv(const Params& p, LAS3 unsigned char* lds) {
    pg::StaticOrder S; S.init(NTOK, 1024, gridDim.x, blockIdx.x);
    pg::gemm_phase<EpiKV, pg::StaticOrder, false>(lds, pg::Gemm{(const bf16_t*)(p.ws + OFF_CR), (const bf16_t*)(p.ws + OFF_WKV), 256, nullptr}, S, EpiKV{p.ws});
}
DEVI void phase_mix(const Params& p, LAS3 unsigned char* lds) {
    pg::RowOrder S{NTOK / 256, 8, (int)gridDim.x, (int)blockIdx.x};
    pg::gemm_phase<EpiMix2, pg::RowOrder, false, true, 4>(lds, pg::Gemm{(const bf16_t*)(p.ws + OFF_YA), (const bf16_t*)(p.ws + OFF_WAB), YAB_LD, nullptr}, S, EpiMix2{p.ws});
}
DEVI void phase_out(const Params& p, LAS3 unsigned char* lds) {
    pg::RowOrder S{NTOK / 256, 4, (int)gridDim.x, (int)blockIdx.x};
    pg::gemm_phase<EpiOut, pg::RowOrder, false, true>(lds, pg::Gemm{(const bf16_t*)(p.ws + OFF_MIX), (const bf16_t*)(p.ws + OFF_WOT), 1024, nullptr}, S, EpiOut{p.ws, p.x});
}

DEVI void build_expert_tables(const Params& p, LAS3 unsigned char* lds) {
    LAS3 int* tb = (LAS3 int*)(lds + LDS_TAB); LAS3 int* cnt = tb + 64;
    if (opaque_tid() < 64) {
        const int lane = opaque_tid(); const int c = lane < 32 ? __hip_atomic_load((const int*)(p.ws + OFF_ECNT) + lane, __ATOMIC_RELAXED, __HIP_MEMORY_SCOPE_AGENT) : 0;
        int t = (c + 255) >> 8, incl = t;
#pragma unroll
        for (int o = 1; o < 32; o <<= 1) { const int v = __shfl_up(incl, o); if (lane >= o) incl += v; }
        if (lane < 32) { cnt[lane] = c; tb[lane + 1] = incl; }
        if (lane == 0) tb[0] = 0;
    }
    __syncthreads();
}
DEVI void phase_gu(const Params& p, LAS3 unsigned char* lds) {
    pg::GroupedOrder S; S.tb = (const LAS3 int*)(lds + LDS_TAB); S.cnt = S.tb + 64; S.G = gridDim.x; S.c = blockIdx.x;
    pg::gemm_phase<EpiGU, pg::GroupedOrder, true, true>(lds, pg::Gemm{(const bf16_t*)(p.ws + OFF_TT), (const bf16_t*)(p.ws + OFF_WEXP), 1024, (const int*)(p.ws + OFF_LIST)}, S, EpiGU{p.ws});
}
DEVI void phase_down(const Params& p, LAS3 unsigned char* lds) {
    pg::GroupedOrder S; S.tb = (const LAS3 int*)(lds + LDS_TAB); S.cnt = S.tb + 64; S.G = gridDim.x; S.c = blockIdx.x;
    pg::gemm_phase<EpiDown, pg::GroupedOrder, false, true>(lds, pg::Gemm{(const bf16_t*)(p.ws + OFF_HID), (const bf16_t*)(p.ws + OFF_WDN), 512, nullptr}, S, EpiDown{p.ws});
}

constexpr int LDS_RW   = 0;
constexpr int LDS_LG   = 147456;
constexpr int LDS_LC   = LDS_LG + 8 * 8 * 37 * 4;
constexpr int LDS_RTK  = LDS_LC + 256;
static_assert(LDS_RTK + 256 * 6 * 4 <= LDS_XB, "route phase LDS overflow");
DEVI void phase_route(const Params& p, LAS3 unsigned char* lds) {
    const int tid = opaque_tid(), lane = tid & 63, wv = tid >> 6, G = gridDim.x;
    LAS3 float* rw = (LAS3 float*)(lds + LDS_RW); LAS3 float* lg = (LAS3 float*)(lds + LDS_LG) + wv * 8 * 37;
    LAS3 int* lcnt = (LAS3 int*)(lds + LDS_LC); LAS3 int* gbase = lcnt + 32; LAS3 unsigned* rtk = (LAS3 unsigned*)(lds + LDS_RTK);
    for (int k = tid; k < 1024; k += 512) { const f32x4 v = *(const f32x4*)(p.w_rg + (size_t)k * 4); rw[k] = v[0]; rw[1024 + k] = v[1]; rw[2048 + k] = v[2]; rw[3072 + k] = v[3]; }
#pragma unroll 1
    for (int base = 0; base < 8192; base += 4096) {
        f32x4 t[8];
#pragma unroll
        for (int j = 0; j < 8; ++j) t[j] = *(const f32x4*)(p.w_re + (size_t)(base + j * 512 + tid) * 4);
#pragma unroll
        for (int j = 0; j < 8; ++j) { const int idx = base + j * 512 + tid, row = idx >> 1, g = row >> 10, k = row & 1023, o0 = 4 + g * 8 + (idx & 1) * 4;
#pragma unroll
            for (int e = 0; e < 4; ++e) rw[(o0 + e) * 1024 + k] = t[j][e]; }
    }
    if (tid < 32) lcnt[tid] = 0;
    f32x4 gn[4];
#pragma unroll
    for (int q = 0; q < 4; ++q) gn[q] = *(const f32x4*)(p.ffn_norm + q * 256 + 4 * lane);
    __syncthreads();
    const bf16_t* H = (const bf16_t*)(p.ws + OFF_H); bf16_t* Hw = (bf16_t*)(p.ws + OFF_H); unsigned char* TT = (unsigned char*)(p.ws + OFF_TT);
    for (int chunk = blockIdx.x; chunk < NTOK / 256; chunk += G) {
        const int tokw = chunk * 256 + wv * 32;
        f32x4 nxv[4]; u32x2 ndv[4];
#pragma unroll
        for (int q = 0; q < 4; ++q) { nxv[q] = *(const f32x4*)(p.x + (size_t)tokw * 1024 + q * 256 + 4 * lane); ndv[q] = *(const u32x2*)(H + (size_t)tokw * 1024 + q * 256 + 4 * lane); }
#pragma unroll 1
        for (int sub = 0; sub < 4; ++sub) {
#pragma unroll 1
            for (int tk = 0; tk < 8; ++tk) {
                const int tok = tokw + sub * 8 + tk;
                f32x4 v[4]; float ss = 0.f; u32x2 dcur[4];
#pragma unroll
                for (int q = 0; q < 4; ++q) { v[q] = nxv[q]; dcur[q] = ndv[q]; }
                if (sub * 8 + tk < 31) {
#pragma unroll
                    for (int q = 0; q < 4; ++q) { nxv[q] = *(const f32x4*)(p.x + (size_t)(tok + 1) * 1024 + q * 256 + 4 * lane); ndv[q] = *(const u32x2*)(H + (size_t)(tok + 1) * 1024 + q * 256 + 4 * lane); }
                }
#pragma unroll
                for (int q = 0; q < 4; ++q) { const u32x2 dd = dcur[q];
                    v[q][0] += bflo(dd.x); v[q][1] += bfhi(dd.x); v[q][2] += bflo(dd.y); v[q][3] += bfhi(dd.y); ss += v[q][0] * v[q][0] + v[q][1] * v[q][1] + v[q][2] * v[q][2] + v[q][3] * v[q][3];
                    u32x2 hh; hh.x = cvt_pk_bf16(v[q][0], v[q][1]); hh.y = cvt_pk_bf16(v[q][2], v[q][3]); *(u32x2*)(Hw + (size_t)tok * 1024 + q * 256 + 4 * lane) = hh; }
#pragma unroll
                for (int o = 32; o > 0; o >>= 1) ss += __shfl_xor(ss, o);
                const float rinv = rsqrtf(ss * (1.0f / 1024.0f) + RMS_EPS);
#pragma unroll
                for (int q = 0; q < 4; ++q) { v[q] = v[q] * rinv * gn[q]; *(unsigned*)(TT + (size_t)tok * 1024 + q * 256 + 4 * lane) = pk4_fp8(v[q][0], v[q][1], v[q][2], v[q][3]); }
                float a[36];
#pragma unroll
                for (int o = 0; o < 36; ++o) { float s = 0.f;
#pragma unroll
                    for (int q = 0; q < 4; ++q) { const f32x4 w = *(const LAS3 f32x4*)(rw + o * 1024 + q * 256 + 4 * lane); s += v[q][0] * w[0] + v[q][1] * w[1] + v[q][2] * w[2] + v[q][3] * w[3]; }
                    a[o] = s; }
#pragma unroll
                for (int st = 0; st < 5; ++st) { const int msk = 32 >> st, half = 16 >> st; const bool up = (lane & msk) != 0;
#pragma unroll
                    for (int i = 0; i < half; ++i) { const float lo = a[i], hi = a[i + half]; const float send = up ? lo : hi, keep = up ? hi : lo; a[i] = keep + __shfl_xor(send, msk); } }
                a[0] += __shfl_xor(a[0], 1);
#pragma unroll
                for (int e = 32; e < 36; ++e) {
#pragma unroll
                    for (int o = 32; o > 0; o >>= 1) a[e] += __shfl_xor(a[e], o); }
                if ((lane & 1) == 0) lg[tk * 37 + (lane >> 1)] = a[0];
                if (lane < 4) lg[tk * 37 + 32 + lane] = lane == 0 ? a[32] : (lane == 1 ? a[33] : (lane == 2 ? a[34] : a[35]));
            }
            asm volatile("s_waitcnt lgkmcnt(0)" ::: "memory");
            if (lane < 8) {
                const LAS3 float* l = lg + lane * 37; float gl[4];
#pragma unroll
                for (int g = 0; g < 4; ++g) gl[g] = l[g] + p.b_rg[g];
                int gs = 0;
#pragma unroll
                for (int g = 1; g < 4; ++g) if (gl[g] > gl[gs]) gs = g;
                float den = 0.f;
#pragma unroll
                for (int g = 0; g < 4; ++g) den += expf(gl[g] - gl[gs]);
                const float pg_ = 1.0f / den; float el[8];
#pragma unroll
                for (int e = 0; e < 8; ++e) el[e] = l[4 + gs * 8 + e] + p.b_re[gs * 8 + e];
                int i0 = 0;
#pragma unroll
                for (int e = 1; e < 8; ++e) if (el[e] > el[i0]) i0 = e;
                int i1 = i0 == 0 ? 1 : 0;
#pragma unroll
                for (int e = 0; e < 8; ++e) if (e != i0 && el[e] > el[i1]) i1 = e;
                const float e1 = expf(el[i1] - el[i0]), w0 = pg_ / (1.0f + e1), w1 = pg_ * e1 / (1.0f + e1);
                const int E0 = gs * 8 + i0, E1 = gs * 8 + i1;
                const int s0 = __hip_atomic_fetch_add(lcnt + E0, 1, __ATOMIC_RELAXED, __HIP_MEMORY_SCOPE_WORKGROUP), s1 = __hip_atomic_fetch_add(lcnt + E1, 1, __ATOMIC_RELAXED, __HIP_MEMORY_SCOPE_WORKGROUP);
                LAS3 unsigned* r = rtk + (wv * 32 + sub * 8 + lane) * 6;
                r[0] = (unsigned)E0; r[1] = (unsigned)s0; r[2] = __float_as_uint(w0); r[3] = (unsigned)E1; r[4] = (unsigned)s1; r[5] = __float_as_uint(w1);
            }
        }
        __syncthreads();
        if (tid < 32) { const int n = lcnt[tid]; gbase[tid] = n ? atomicAdd((int*)(p.ws + OFF_ECNT) + tid, n) : 0; lcnt[tid] = 0; }
        __syncthreads();
        if (tid < 256) {
            const int tok = chunk * 256 + tid; const LAS3 unsigned* r = rtk + tid * 6;
            const int E0 = (int)r[0], E1 = (int)r[3], s0 = gbase[E0] + (int)r[1], s1 = gbase[E1] + (int)r[4];
            u32x4 w0; w0.x = (unsigned)E0; w0.y = (unsigned)s0; w0.z = r[2]; w0.w = 0u; u32x4 w1; w1.x = (unsigned)E1; w1.y = (unsigned)s1; w1.z = r[5]; w1.w = 0u;
            unsigned* RT = (unsigned*)(p.ws + OFF_RT) + (size_t)tok * 8; *(u32x4*)RT = w0; *(u32x4*)(RT + 4) = w1;
            int* LIST = (int*)(p.ws + OFF_LIST); LIST[(size_t)E0 * 65536 + s0] = tok; LIST[(size_t)E1 * 65536 + s1] = tok;
        }
        __syncthreads();
    }
}

DEVI void phase_final(const Params& p, LAS3 unsigned char* lds) {
    const LAS3 int* tb = (const LAS3 int*)(lds + LDS_TAB);
    const int lane = opaque_tid() & 63, wv = opaque_tid() >> 6, G = gridDim.x;
    f32x4 gn[4];
#pragma unroll
    for (int q = 0; q < 4; ++q) gn[q] = *(const f32x4*)(p.final_norm + q * 256 + 4 * lane);
    const bf16_t* H = (const bf16_t*)(p.ws + OFF_H); const unsigned char* EO = (const unsigned char*)(p.ws + OFF_EO); const unsigned* RT = (const unsigned*)(p.ws + OFF_RT);
    const int st = G * 8; int tok = blockIdx.x * 8 + wv;
    u32x4 ra[2], rb[2], na[2], nb[2]; u32x2 dv[2][4]; unsigned ea[2][4], eb[2][4];
#pragma unroll
    for (int k = 0; k < 2; ++k) { ra[k] = (u32x4){0, 0, 0, 0}; rb[k] = ra[k]; na[k] = ra[k]; nb[k] = ra[k]; }
#define FIN_LOADR(t_, a_, b_) do { a_ = *(const u32x4*)(RT + (size_t)(t_) * 8); b_ = *(const u32x4*)(RT + (size_t)(t_) * 8 + 4); } while (0)
#define FIN_LOADD(k_, t_, a_, b_) do { const size_t r0_ = (size_t)tb[a_.x] * 256 + a_.y, r1_ = (size_t)tb[b_.x] * 256 + b_.y; \
        _Pragma("unroll") for (int q = 0; q < 4; ++q) { dv[k_][q] = *(const u32x2*)(H + (size_t)(t_) * 1024 + q * 256 + 4 * lane); \
            ea[k_][q] = *(const unsigned*)(EO + r0_ * 1024 + q * 256 + 4 * lane); eb[k_][q] = *(const unsigned*)(EO + r1_ * 1024 + q * 256 + 4 * lane); } } while (0)
#pragma unroll
    for (int k = 0; k < 2; ++k) if (tok + k * st < NTOK) FIN_LOADR(tok + k * st, ra[k], rb[k]);
#pragma unroll
    for (int k = 0; k < 2; ++k) if (tok + k * st < NTOK) { FIN_LOADD(k, tok + k * st, ra[k], rb[k]); if (tok + (2 + k) * st < NTOK) FIN_LOADR(tok + (2 + k) * st, na[k], nb[k]); }
#pragma unroll 1
    for (; tok < NTOK; tok += 2 * st) {
        f32x4 v[2][4]; float ss[2];
#pragma unroll
        for (int k = 0; k < 2; ++k) {
            const float w0 = __uint_as_float(ra[k].z), w1 = __uint_as_float(rb[k].z); ss[k] = 0.f;
#pragma unroll
            for (int q = 0; q < 4; ++q) {
                const f32x2 a01 = __builtin_amdgcn_cvt_pk_f32_fp8(ea[k][q], false), a23 = __builtin_amdgcn_cvt_pk_f32_fp8(ea[k][q], true), b01 = __builtin_amdgcn_cvt_pk_f32_fp8(eb[k][q], false), b23 = __builtin_amdgcn_cvt_pk_f32_fp8(eb[k][q], true);
                v[k][q][0] = bflo(dv[k][q].x) + w0 * a01[0] + w1 * b01[0]; v[k][q][1] = bfhi(dv[k][q].x) + w0 * a01[1] + w1 * b01[1];
                v[k][q][2] = bflo(dv[k][q].y) + w0 * a23[0] + w1 * b23[0]; v[k][q][3] = bfhi(dv[k][q].y) + w0 * a23[1] + w1 * b23[1];
                ss[k] += v[k][q][0] * v[k][q][0] + v[k][q][1] * v[k][q][1] + v[k][q][2] * v[k][q][2] + v[k][q][3] * v[k][q][3];
            }
        }
#pragma unroll
        for (int k = 0; k < 2; ++k) if (tok + (2 + k) * st < NTOK) { ra[k] = na[k]; rb[k] = nb[k]; FIN_LOADD(k, tok + (2 + k) * st, ra[k], rb[k]); if (tok + (4 + k) * st < NTOK) FIN_LOADR(tok + (4 + k) * st, na[k], nb[k]); }
#pragma unroll
        for (int k = 0; k < 2; ++k) if (tok + k * st < NTOK) {
            float s1 = ss[k];
#pragma unroll
            for (int o = 32; o > 0; o >>= 1) s1 += __shfl_xor(s1, o);
            const float rinv = rsqrtf(s1 * (1.0f / 1024.0f) + RMS_EPS);
#pragma unroll
            for (int q = 0; q < 4; ++q) *(f32x4*)(p.out + (size_t)(tok + k * st) * 1024 + q * 256 + 4 * lane) = v[k][q] * rinv * gn[q];
        }
    }
#undef FIN_LOADR
#undef FIN_LOADD
}


typedef float f32x16 __attribute__((ext_vector_type(16)));
typedef short s16x4 __attribute__((ext_vector_type(4)));
#define MFMA32(a, b, c) __builtin_amdgcn_mfma_f32_32x32x16_bf16(a, b, c, 0, 0, 0)
#define MFMA16(a, b, c) __builtin_amdgcn_mfma_f32_16x16x32_bf16(a, b, c, 0, 0, 0)
constexpr float NEGB = -1e30f;
DEVI s16x4 vtr(const LAS3 unsigned char* p) { return __builtin_bit_cast(s16x4, __builtin_amdgcn_ds_read_tr16_b64_v4i16((LAS3 s16x4*)p)); }
DEVI float max3f(float a, float b, float c) { return __builtin_fmaxf(__builtin_fmaxf(a, b), c); }

constexpr int TK_STRIDE = 2052;
DEVI unsigned fkey(float f) { const unsigned u = __float_as_uint(f); return u ^ ((u >> 31) ? 0xFFFFFFFFu : 0x80000000u); }
DEVI int wave_sum_pair(int a, int b, int& sumb) {
    int v = a | (b << 16);
    v += __builtin_amdgcn_update_dpp(0, v, 0xB1, 0xF, 0xF, true);
    v += __builtin_amdgcn_update_dpp(0, v, 0x4E, 0xF, 0xF, true);
    v += __builtin_amdgcn_update_dpp(0, v, 0x141, 0xF, 0xF, true);
    v += __builtin_amdgcn_update_dpp(0, v, 0x140, 0xF, 0xF, true);
    const int t = __builtin_amdgcn_readlane(v, 0) + __builtin_amdgcn_readlane(v, 16) + __builtin_amdgcn_readlane(v, 32) + __builtin_amdgcn_readlane(v, 48);
    sumb = (int)((unsigned)t >> 16); return t & 0xFFFF;
}
DEVI void phase_topk(const Params& p, LAS3 unsigned char* lds) {
    LAS3 float* sc = (LAS3 float*)lds;
    const int tid = opaque_tid(), lane = tid & 63, wv = __builtin_amdgcn_readfirstlane(tid >> 6), r16 = lane & 15, g4 = lane >> 4;
    const bf16_t* QI = (const bf16_t*)(p.ws + OFF_QI); const bf16_t* KI = (const bf16_t*)(p.ws + OFF_KI); const float* WI = (const float*)(p.ws + OFF_WI);
    unsigned* SEL = (unsigned*)(p.ws + OFF_SEL);
#define TK_UNIT(u_, b_, t0_) do { b_ = (u_) >> 7; t0_ = ((((u_) & 127) + 8 * ((u_) >> 8)) & 127) * 16; } while (0)
#define TK_LOADQ(b_, t0_) do { const bf16_t* qrow = QI + (size_t)((b_) * SEQ + (t0_) + r16) * 256 + 8 * g4; \
        _Pragma("unroll") for (int h = 0; h < 4; ++h) { qf[h][0] = *(const bf16x8*)(qrow + h * 64); qf[h][1] = *(const bf16x8*)(qrow + h * 64 + 32); } \
        w4 = *(const f32x4*)(WI + (size_t)((b_) * SEQ + (t0_) + r16) * 4); } while (0)
#define TK_LOADK(dst, kb_, gi_) do { const bf16_t* kp_ = (kb_) + (size_t)(gi_) * 4096; \
        _Pragma("unroll") for (int j = 0; j < 4; ++j) { dst[j][0] = *(const bf16x8*)(kp_ + j * 1024); dst[j][1] = *(const bf16x8*)(kp_ + j * 1024 + 32); } } while (0)
    bf16x8 qf[4][2]; f32x4 w4; bf16x8 kf[4][2];
    int u = blockIdx.x, b = 0, t0 = 0;
    if (u < NTOK / 16) { TK_UNIT(u, b, t0); TK_LOADQ(b, t0); if (wv * 64 < t0 + 16) TK_LOADK(kf, KI + (size_t)(b * SEQ + r16) * 64 + 8 * g4, wv); }
    for (; u < NTOK / 16; u += gridDim.x) {
        const int tokb = b * SEQ, nkey = t0 + 16;
        const bf16_t* kbase = KI + (size_t)(tokb + r16) * 64 + 8 * g4;
        const float wq[4] = {w4[0], w4[1], w4[2], w4[3]};
#pragma unroll 1
        for (int gi = wv; gi * 64 < nkey; gi += 8) {
            bf16x8 cf[4][2];
#pragma unroll
            for (int j = 0; j < 4; ++j) { cf[j][0] = kf[j][0]; cf[j][1] = kf[j][1]; }
            if ((gi + 8) * 64 < nkey) TK_LOADK(kf, kbase, gi + 8);
#pragma unroll
            for (int j = 0; j < 4; ++j) {
                f32x4 s = (f32x4){0.f, 0.f, 0.f, 0.f};
#pragma unroll
                for (int h = 0; h < 4; ++h) { f32x4 a = (f32x4){0.f, 0.f, 0.f, 0.f}; a = MFMA16(cf[j][0], qf[h][0], a); a = MFMA16(cf[j][1], qf[h][1], a);
#pragma unroll
                    for (int e = 0; e < 4; ++e) s[e] += wq[h] * __builtin_fmaxf(a[e], 0.f); }
#pragma unroll
                for (int e = 0; e < 4; ++e) s[e] = (s[e] == 0.f) ? 0.f : s[e];
                *(LAS3 f32x4*)(sc + r16 * TK_STRIDE + gi * 64 + j * 16 + 4 * g4) = s;
            }
        }
        const int un = u + gridDim.x; int bn = 0, t0n = 0;
        if (un < NTOK / 16) { TK_UNIT(un, bn, t0n); TK_LOADQ(bn, t0n); if (wv * 64 < t0n + 16) TK_LOADK(kf, KI + (size_t)(bn * SEQ + r16) * 64 + 8 * g4, wv); }
        __syncthreads();
#pragma unroll 1
        for (int qq = 0; qq < 2; ++qq) {
            const int q = 2 * wv + qq, t = t0 + q, n = t + 1; const LAS3 float* row = sc + q * TK_STRIDE;
            const int nv = (n - lane + 63) >> 6; const unsigned valid = nv >= 32 ? 0xFFFFFFFFu : (nv <= 0 ? 0u : ((1u << nv) - 1u));
            unsigned sel = valid;
            if (n > 256) {
                unsigned a[32];
#pragma unroll
                for (int i = 0; i < 32; ++i) a[i] = __float_as_uint(row[i * 64 + lane]);
#pragma unroll
                for (int k = 0; k < 16; ++k) { const unsigned x = a[k], y = a[k + 16]; a[k] = __builtin_amdgcn_perm(y, x, 0x05040100u); a[k + 16] = __builtin_amdgcn_perm(y, x, 0x07060302u); }
#pragma unroll
                for (int k = 0; k < 32; ++k) if (!(k & 8)) { const unsigned x = a[k], y = a[k + 8]; a[k] = __builtin_amdgcn_perm(y, x, 0x06020400u); a[k + 8] = __builtin_amdgcn_perm(y, x, 0x07030501u); }
#pragma unroll
                for (int k = 0; k < 32; ++k) if (!(k & 4)) { const unsigned x = a[k], y = a[k + 4]; a[k] = (x & 0x0F0F0F0Fu) | ((y << 4) & 0xF0F0F0F0u); a[k + 4] = ((x >> 4) & 0x0F0F0F0Fu) | (y & 0xF0F0F0F0u); }
#pragma unroll
                for (int k = 0; k < 32; ++k) if (!(k & 2)) { const unsigned x = a[k], y = a[k + 2]; a[k] = (x & 0x33333333u) | ((y << 2) & 0xCCCCCCCCu); a[k + 2] = ((x >> 2) & 0x33333333u) | (y & 0xCCCCCCCCu); }
#pragma unroll
                for (int k = 0; k < 32; ++k) if (!(k & 1)) { const unsigned x = a[k], y = a[k + 1]; a[k] = (x & 0x55555555u) | ((y << 1) & 0xAAAAAAAAu); a[k + 1] = ((x >> 1) & 0x55555555u) | (y & 0xAAAAAAAAu); }
                { const unsigned sg = a[31];
#pragma unroll
                  for (int bb = 0; bb < 31; ++bb) a[bb] ^= sg;
                  a[31] = ~sg; }
                unsigned alive = valid, gt = 0u; int above = 0; bool exact = false;
#pragma unroll
                for (int bb = 31; bb >= 0; --bb) {
                    if (!exact) {
                        const unsigned ones = alive & a[bb];
                        int dummy; const int c = wave_sum_pair(__builtin_popcount(ones), 0, dummy);
                        if (above + c >= 256) { alive = ones; if (above + c == 256) exact = true; }
                        else { above += c; gt |= ones; alive &= ~a[bb]; }
                    }
                }
                sel = gt | alive;
                if (!exact) {
                    int need = 256 - above; unsigned tsel = 0u;
#pragma unroll 1
                    for (int i = 0; i < 32 && need > 0; ++i) {
                        unsigned long long m = __ballot((alive >> i) & 1u); const int c = __builtin_popcountll(m);
                        if (c <= need) { need -= c; }
                        else { unsigned long long keep = 0ull; for (int k2 = 0; k2 < need; ++k2) { const unsigned long long low = m & (~m + 1ull); keep |= low; m ^= low; } m = keep; need = 0; }
                        if ((m >> lane) & 1ull) tsel |= 1u << i;
                    }
                    sel = gt | tsel;
                }
            }
            unsigned long long mine = 0ull;
#pragma unroll
            for (int i = 0; i < 32; ++i) { const unsigned long long m = __ballot((sel >> i) & 1u); mine = (lane == i) ? m : mine; }
            if (lane < 32) *(unsigned long long*)(SEL + (size_t)(tokb + t) * 64 + 2 * lane) = mine;
        }
        __syncthreads();
        b = bn; t0 = t0n;
    }
#undef TK_UNIT
#undef TK_LOADQ
#undef TK_LOADK
}

struct AttnState { f32x16 o0, o1; float m, l, mx; };
struct AttnState8 { f32x16 o0, o1, ol; float m, mx, l; };
DEVI int crow16(int r) { return (r & 3) + 8 * (r >> 2); }
typedef __bf16 bf16x2v __attribute__((ext_vector_type(2)));
#define BFE1(w_, P_) ({ unsigned r_; asm("v_bfe_i32 %0, %1, " #P_ ", 1" : "=v"(r_) : "v"(w_)); r_; })
template <bool TAB4>
DEVI void attn_tile(AttnState& st, bool& zref, const bf16x8 (&qr)[4], const LAS3 unsigned char* kp  , const LAS3 unsigned char* vp  ,
                    const LAS3 float* tq, unsigned w0, unsigned w1  ) {
    f32x16 s0, s1;
    if constexpr (TAB4) {
#pragma unroll
        for (int g = 0; g < 4; ++g) { const f32x4 a = *(const LAS3 f32x4*)(tq + 8 * g), b = *(const LAS3 f32x4*)(tq + 32 + 8 * g);
#pragma unroll
            for (int e = 0; e < 4; ++e) { s0[4 * g + e] = a[e]; s1[4 * g + e] = b[e]; } }
    } else {
#pragma unroll
        for (int r = 0; r < 16; ++r) { s0[r] = tq[63 - crow16(r)]; s1[r] = tq[31 - crow16(r)]; }
    }
    bf16x8 kf[8];
#pragma unroll
    for (int d0 = 0; d0 < 4; ++d0) { kf[2 * d0] = *(const LAS3 bf16x8*)(kp + d0 * 2048); kf[2 * d0 + 1] = *(const LAS3 bf16x8*)(kp + d0 * 2048 + 512); }
#pragma unroll
    for (int d0 = 0; d0 < 4; ++d0) { s0 = MFMA32(kf[2 * d0], qr[d0], s0); s1 = MFMA32(kf[2 * d0 + 1], qr[d0], s1); }
    s16x4 vq[16];
#pragma unroll
    for (int s = 0; s < 4; ++s) { vq[4 * s] = vtr(vp + s * 1024); vq[4 * s + 1] = vtr(vp + s * 1024 + 512); vq[4 * s + 2] = vtr(vp + 4096 + s * 1024); vq[4 * s + 3] = vtr(vp + 4096 + s * 1024 + 512); }
    float mx = max3f(s0[0], s0[1], s1[0]);
#pragma unroll
    for (int r = 1; r < 16; r += 2) mx = max3f(mx, s0[r], r + 1 < 16 ? s0[r + 1] : s0[r]);
#pragma unroll
    for (int r = 1; r < 16; r += 2) mx = max3f(mx, s1[r], r + 1 < 16 ? s1[r + 1] : s1[r]);
    { auto rr = __builtin_amdgcn_permlane32_swap(__float_as_uint(mx), __float_as_uint(mx), false, false); mx = __builtin_fmaxf(__uint_as_float(rr[0]), __uint_as_float(rr[1])); }
    const float runmx = __builtin_fmaxf(st.mx, mx), refm = st.m, dlt = runmx - refm; st.mx = runmx;
    float mref = refm;
    if (__any(dlt > 40.f || (dlt < -80.f && runmx > -1e29f))) {
        const bool mv = dlt > 40.f || (dlt < -80.f && runmx > -1e29f); const float alpha = mv ? __builtin_amdgcn_exp2f(refm - runmx) : 1.0f;
        mref = mv ? runmx : refm; st.m = mref; st.l *= alpha; zref = false;
#pragma unroll
        for (int r = 0; r < 16; ++r) { st.o0[r] *= alpha; st.o1[r] *= alpha; }
    }
    if (zref) {
#pragma unroll
        for (int r = 0; r < 16; ++r) { s0[r] = __builtin_amdgcn_exp2f(s0[r]); s1[r] = __builtin_amdgcn_exp2f(s1[r]); }
    } else {
#pragma unroll
        for (int r = 0; r < 16; ++r) { s0[r] = __builtin_amdgcn_exp2f(s0[r] - mref); s1[r] = __builtin_amdgcn_exp2f(s1[r] - mref); }
    }
#define MSK1(S_, r_, w_, P_) S_[r_] = __uint_as_float(__float_as_uint(S_[r_]) & BFE1(w_, P_))
    MSK1(s0, 0, w0, 0); MSK1(s0, 1, w0, 1); MSK1(s0, 2, w0, 2); MSK1(s0, 3, w0, 3); MSK1(s0, 4, w0, 8); MSK1(s0, 5, w0, 9); MSK1(s0, 6, w0, 10); MSK1(s0, 7, w0, 11); MSK1(s0, 8, w0, 16); MSK1(s0, 9, w0, 17); MSK1(s0, 10, w0, 18); MSK1(s0, 11, w0, 19); MSK1(s0, 12, w0, 24); MSK1(s0, 13, w0, 25); MSK1(s0, 14, w0, 26); MSK1(s0, 15, w0, 27);
    MSK1(s1, 0, w1, 0); MSK1(s1, 1, w1, 1); MSK1(s1, 2, w1, 2); MSK1(s1, 3, w1, 3); MSK1(s1, 4, w1, 8); MSK1(s1, 5, w1, 9); MSK1(s1, 6, w1, 10); MSK1(s1, 7, w1, 11); MSK1(s1, 8, w1, 16); MSK1(s1, 9, w1, 17); MSK1(s1, 10, w1, 18); MSK1(s1, 11, w1, 19); MSK1(s1, 12, w1, 24); MSK1(s1, 13, w1, 25); MSK1(s1, 14, w1, 26); MSK1(s1, 15, w1, 27);
#undef MSK1
    u32x4 pw[4];
#pragma unroll
    for (int q = 0; q < 4; ++q) { pw[0][q] = cvt_pk_bf16(s0[2 * q], s0[2 * q + 1]); pw[1][q] = cvt_pk_bf16(s0[8 + 2 * q], s0[8 + 2 * q + 1]);
                                  pw[2][q] = cvt_pk_bf16(s1[2 * q], s1[2 * q + 1]); pw[3][q] = cvt_pk_bf16(s1[8 + 2 * q], s1[8 + 2 * q + 1]); }
    { float l0 = st.l, l1 = 0.f, l2 = 0.f, l3 = 0.f;
#pragma unroll
      for (int r = 0; r < 16; r += 2) { l0 = fadd1(l0, s0[r]); l1 = fadd1(l1, s0[r + 1]); l2 = fadd1(l2, s1[r]); l3 = fadd1(l3, s1[r + 1]); }
      st.l = fadd1(fadd1(l0, l1), fadd1(l2, l3)); }
#pragma unroll
    for (int s = 0; s < 4; ++s) {
        const s16x4 a0 = vq[4 * s], a1 = vq[4 * s + 1], c0 = vq[4 * s + 2], c1 = vq[4 * s + 3];
        const bf16x8 v0 = (bf16x8){a0[0], a0[1], a0[2], a0[3], a1[0], a1[1], a1[2], a1[3]}, v1 = (bf16x8){c0[0], c0[1], c0[2], c0[3], c1[0], c1[1], c1[2], c1[3]};
        const bf16x8 pf = __builtin_bit_cast(bf16x8, pw[s]);
        st.o0 = MFMA32(v0, pf, st.o0); st.o1 = MFMA32(v1, pf, st.o1);
    }
}
template <bool TAB4, int MASK = 2, bool OLM = true>
DEVI void attn_tile8(AttnState8& st, bool& zref, const pg::v8i_t& q8, const LAS3 unsigned char* kp  , const LAS3 unsigned char* vp  ,
                    const LAS3 float* tq, unsigned w0, unsigned w1  , const LAS3 unsigned char* lut = nullptr) {
    f32x16 s0, s1;
    if constexpr (TAB4) {
#pragma unroll
        for (int g = 0; g < 4; ++g) { const f32x4 a = *(const LAS3 f32x4*)(tq + 8 * g), b = *(const LAS3 f32x4*)(tq + 32 + 8 * g);
#pragma unroll
            for (int e = 0; e < 4; ++e) { s0[4 * g + e] = a[e]; s1[4 * g + e] = b[e]; } }
    } else {
#pragma unroll
        for (int r = 0; r < 16; ++r) { s0[r] = tq[63 - crow16(r)]; s1[r] = tq[31 - crow16(r)]; }
    }
    pg::v8i_t kA, kB;
    kA.lo = *(const LAS3 pg::v4i_t*)kp; kA.hi = *(const LAS3 pg::v4i_t*)(kp + 1024); kB.lo = *(const LAS3 pg::v4i_t*)(kp + 512); kB.hi = *(const LAS3 pg::v4i_t*)(kp + 1024 + 512);
    s0 = __builtin_amdgcn_mfma_scale_f32_32x32x64_f8f6f4(kA, q8, s0, 0, 0, 0, 0x7C7C7C7C, 0, 0x7C7C7C7C);
    s1 = __builtin_amdgcn_mfma_scale_f32_32x32x64_f8f6f4(kB, q8, s1, 0, 0, 0, 0x7C7C7C7C, 0, 0x7C7C7C7C);
    s16x4 vq[16];
#pragma unroll
    for (int s = 0; s < 4; ++s) { vq[4 * s] = vtr(vp + s * 1024); vq[4 * s + 1] = vtr(vp + s * 1024 + 512); vq[4 * s + 2] = vtr(vp + 4096 + s * 1024); vq[4 * s + 3] = vtr(vp + 4096 + s * 1024 + 512); }
    u32x2 pm[8];
    if constexpr (MASK == 2) {
#pragma unroll
        for (int j = 0; j < 4; ++j) { pm[j] = *(const LAS3 u32x2*)(lut + ((w0 >> (8 * j)) & 0xFFu) * 8); pm[4 + j] = *(const LAS3 u32x2*)(lut + ((w1 >> (8 * j)) & 0xFFu) * 8); }
    }
    float mx = max3f(s0[0], s0[1], s1[0]);
#pragma unroll
    for (int r = 1; r < 16; r += 2) mx = max3f(mx, s0[r], r + 1 < 16 ? s0[r + 1] : s0[r]);
#pragma unroll
    for (int r = 1; r < 16; r += 2) mx = max3f(mx, s1[r], r + 1 < 16 ? s1[r + 1] : s1[r]);
    { auto rr = __builtin_amdgcn_permlane32_swap(__float_as_uint(mx), __float_as_uint(mx), false, false); mx = __builtin_fmaxf(__uint_as_float(rr[0]), __uint_as_float(rr[1])); }
    const float runmx = __builtin_fmaxf(st.mx, mx), refm = st.m, dlt = runmx - refm; st.mx = runmx;
    float mref = refm;
    if (__any(dlt > 40.f || (dlt < -80.f && runmx > -1e29f))) {
        const bool mv = dlt > 40.f || (dlt < -80.f && runmx > -1e29f); const float alpha = mv ? __builtin_amdgcn_exp2f(refm - runmx) : 1.0f;
        mref = mv ? runmx : refm; st.m = mref; zref = false;
#pragma unroll
        for (int r = 0; r < 16; ++r) { st.o0[r] *= alpha; st.o1[r] *= alpha; if constexpr (OLM) st.ol[r] *= alpha; }
        if constexpr (!OLM) st.l *= alpha;
    }
    if (zref) {
#pragma unroll
        for (int r = 0; r < 16; ++r) { s0[r] = __builtin_amdgcn_exp2f(s0[r]); s1[r] = __builtin_amdgcn_exp2f(s1[r]); }
    } else {
#pragma unroll
        for (int r = 0; r < 16; ++r) { s0[r] = __builtin_amdgcn_exp2f(s0[r] - mref); s1[r] = __builtin_amdgcn_exp2f(s1[r] - mref); }
    }
#define MSK1(S_, r_, w_, P_) S_[r_] = __uint_as_float(__float_as_uint(S_[r_]) & BFE1(w_, P_))
    if constexpr (MASK == 1) {
    MSK1(s0, 0, w0, 0); MSK1(s0, 1, w0, 1); MSK1(s0, 2, w0, 2); MSK1(s0, 3, w0, 3); MSK1(s0, 4, w0, 8); MSK1(s0, 5, w0, 9); MSK1(s0, 6, w0, 10); MSK1(s0, 7, w0, 11); MSK1(s0, 8, w0, 16); MSK1(s0, 9, w0, 17); MSK1(s0, 10, w0, 18); MSK1(s0, 11, w0, 19); MSK1(s0, 12, w0, 24); MSK1(s0, 13, w0, 25); MSK1(s0, 14, w0, 26); MSK1(s0, 15, w0, 27);
    MSK1(s1, 0, w1, 0); MSK1(s1, 1, w1, 1); MSK1(s1, 2, w1, 2); MSK1(s1, 3, w1, 3); MSK1(s1, 4, w1, 8); MSK1(s1, 5, w1, 9); MSK1(s1, 6, w1, 10); MSK1(s1, 7, w1, 11); MSK1(s1, 8, w1, 16); MSK1(s1, 9, w1, 17); MSK1(s1, 10, w1, 18); MSK1(s1, 11, w1, 19); MSK1(s1, 12, w1, 24); MSK1(s1, 13, w1, 25); MSK1(s1, 14, w1, 26); MSK1(s1, 15, w1, 27);
    }
#undef MSK1
    u32x4 pw[4];
#pragma unroll
    for (int q = 0; q < 4; ++q) { pw[0][q] = cvt_pk_bf16(s0[2 * q], s0[2 * q + 1]); pw[1][q] = cvt_pk_bf16(s0[8 + 2 * q], s0[8 + 2 * q + 1]);
                                  pw[2][q] = cvt_pk_bf16(s1[2 * q], s1[2 * q + 1]); pw[3][q] = cvt_pk_bf16(s1[8 + 2 * q], s1[8 + 2 * q + 1]); }
    if constexpr (MASK == 2) {
#pragma unroll
        for (int t = 0; t < 4; ++t) { pw[t][0] &= pm[2 * t].x; pw[t][1] &= pm[2 * t].y; pw[t][2] &= pm[2 * t + 1].x; pw[t][3] &= pm[2 * t + 1].y; }
    }
    if constexpr (!OLM) { float l0 = st.l, l1 = 0.f, l2 = 0.f, l3 = 0.f;
#pragma unroll
      for (int r = 0; r < 16; r += 2) { l0 = fadd1(l0, s0[r]); l1 = fadd1(l1, s0[r + 1]); l2 = fadd1(l2, s1[r]); l3 = fadd1(l3, s1[r + 1]); }
      st.l = fadd1(fadd1(l0, l1), fadd1(l2, l3)); }
    const bf16x8 ones = (bf16x8){(short)0x3F80, (short)0x3F80, (short)0x3F80, (short)0x3F80, (short)0x3F80, (short)0x3F80, (short)0x3F80, (short)0x3F80};
#pragma unroll
    for (int s = 0; s < 4; ++s) {
        const s16x4 a0 = vq[4 * s], a1 = vq[4 * s + 1], c0 = vq[4 * s + 2], c1 = vq[4 * s + 3];
        const bf16x8 v0 = (bf16x8){a0[0], a0[1], a0[2], a0[3], a1[0], a1[1], a1[2], a1[3]}, v1 = (bf16x8){c0[0], c0[1], c0[2], c0[3], c1[0], c1[1], c1[2], c1[3]};
        const bf16x8 pf = __builtin_bit_cast(bf16x8, pw[s]);
        st.o0 = MFMA32(v0, pf, st.o0); st.o1 = MFMA32(v1, pf, st.o1); if constexpr (OLM) st.ol = MFMA32(ones, pf, st.ol);
    }
}
DEVI float attn_finish8l(AttnState8& st, float& lse2) {
    auto rr = __builtin_amdgcn_permlane32_swap(__float_as_uint(st.l), __float_as_uint(st.l), false, false);
    const float l = __uint_as_float(rr[0]) + __uint_as_float(rr[1]); lse2 = st.m + __builtin_amdgcn_logf(l);
    return __builtin_amdgcn_rcpf(l);
}
DEVI float attn_finish8(AttnState8& st, float& lse2) {
    const float l = st.ol[0]; lse2 = st.m + __builtin_amdgcn_logf(l);
    return __builtin_amdgcn_rcpf(l);
}
DEVI float attn_finish(AttnState& st, float& lse2) {
    auto rr = __builtin_amdgcn_permlane32_swap(__float_as_uint(st.l), __float_as_uint(st.l), false, false);
    const float l = __uint_as_float(rr[0]) + __uint_as_float(rr[1]); lse2 = st.m + __builtin_amdgcn_logf(l);
    return __builtin_amdgcn_rcpf(l);
}
template <class ST> DEVI void attn_store(const ST& st, float rl, bf16_t* rowp, int hi) {
#pragma unroll
    for (int g = 0; g < 4; ++g) {
        u32x2 a, b; a.x = cvt_pk_bf16(st.o0[4 * g] * rl, st.o0[4 * g + 1] * rl); a.y = cvt_pk_bf16(st.o0[4 * g + 2] * rl, st.o0[4 * g + 3] * rl);
        b.x = cvt_pk_bf16(st.o1[4 * g] * rl, st.o1[4 * g + 1] * rl); b.y = cvt_pk_bf16(st.o1[4 * g + 2] * rl, st.o1[4 * g + 3] * rl);
        *(u32x2*)(rowp + 8 * g + 4 * hi) = a; *(u32x2*)(rowp + 32 + 8 * g + 4 * hi) = b;
    }
}

constexpr float Y8_SCALE = 16.0f;
template <class ST> DEVI void attn_store8(const ST& st, float rl, unsigned char* rowp, int hi) {
    const float f = rl * Y8_SCALE;
#pragma unroll
    for (int g = 0; g < 4; ++g) {
        *(unsigned*)(rowp + 8 * g + 4 * hi) = pk4_fp8(st.o0[4 * g] * f, st.o0[4 * g + 1] * f, st.o0[4 * g + 2] * f, st.o0[4 * g + 3] * f);
        *(unsigned*)(rowp + 32 + 8 * g + 4 * hi) = pk4_fp8(st.o1[4 * g] * f, st.o1[4 * g + 1] * f, st.o1[4 * g + 2] * f, st.o1[4 * g + 3] * f);
    }
}

constexpr int DS_K = 0, DS_V = 32768, DS_TAB = 65536, DS_CS = 2128, DS_LUT = 100352;
DEVI void dsa_unit(const Params& p, LAS3 unsigned char* lds, int b, int h, int qb, bool build_tab) {
    const int tid = opaque_tid(), lane = tid & 63, wv = __builtin_amdgcn_readfirstlane(tid >> 6), r32 = lane & 31, hi = lane >> 5;
    const unsigned char* QA = (const unsigned char*)(p.ws + OFF_QA); const unsigned char* KA = (const unsigned char*)(p.ws + OFF_R1); const unsigned char* VA = KA + (size_t)NTOK * 512;
    const unsigned* SEL = (const unsigned*)(p.ws + OFF_SEL);
    LAS3 float* tab = (LAS3 float*)(lds + DS_TAB);
    __syncthreads();
    if (build_tab && tid < 256) { u32x2 e; e.x = ((tid & 1) ? 0xFFFFu : 0u) | ((tid & 2) ? 0xFFFF0000u : 0u); e.y = ((tid & 4) ? 0xFFFFu : 0u) | ((tid & 8) ? 0xFFFF0000u : 0u); *(LAS3 u32x2*)(lds + DS_LUT + tid * 8) = e; }
    if (build_tab)
    {   const float bb = p.rel_bias[(lane & 31) * 20 + h] * LOG2E;
        for (int i = tid; i < 4 * 2112 + 511; i += 512) { const int ii = i < 4 * 2112 ? i : 0, c = ii / 2112, j = ii % 2112, dist = (2111 - j) - 64; const float v = __shfl(bb, rel_bucket(dist < 0 ? 0 : dist));
            if (i < 4 * 2112) tab[c * DS_CS + j + c] = dist < 0 ? 0.f : v; } }
    const size_t hb = (size_t)(b * 8 + h) * SEQ; const int q0 = qb * 256, qw = q0 + 32 * wv, NT2 = 2 * qb + 2, mylast = 4 * qb + (wv >> 1);
    pg::v8i_t q8;
    q8.lo = *(const pg::v4i_t*)(QA + (hb + qw + r32) * 64 + 32 * hi); q8.hi = *(const pg::v4i_t*)(QA + (hb + qw + r32) * 64 + 32 * hi + 16);
    AttnState8 st; st.m = 0.f; st.mx = NEGB; bool zref = true;
#pragma unroll
    for (int r = 0; r < 16; ++r) { st.o0[r] = 0.f; st.o1[r] = 0.f; st.ol[r] = 0.f; }
    const unsigned char* ksrc = KA + (hb + (wv >> 2) * 64 + lane) * 64 + (wv & 3) * 16; const unsigned char* vsrc = VA + (hb + 16 * (wv & 3) + (lane >> 2)) * 64 + (wv >> 2) * 32 + (lane & 3) * 8;
    const int kdst = DS_K + (wv >> 2) * 4096 + (wv & 3) * 1024 + lane * 16, vdst = DS_V + (wv >> 2) * 4096 + (wv & 3) * 1024 + lane * 16;
    const LAS3 unsigned char* kp0 = lds + DS_K + 2 * hi * 1024 + r32 * 16;
    const LAS3 unsigned char* vp0 = lds + DS_V + ((lane >> 4) & 1) * 32 + (lane & 3) * 8 + (4 * hi + ((lane & 15) >> 2)) * 64;
    const unsigned* selrow = SEL + (size_t)(b * SEQ + qw + r32) * 64;
    const int jb = 2111 - (64 + qw + r32 - 4 * hi), cc = (4 - (jb & 3)) & 3;
    const LAS3 float* tqb = tab + cc * DS_CS + jb + cc;
    u32x4 kreg = *(const u32x4*)ksrc; u32x2 vreg0 = *(const u32x2*)vsrc, vreg1 = *(const u32x2*)(vsrc + 4096); u32x4 mwn = *(const u32x4*)selrow;
    *(LAS3 u32x4*)(lds + kdst) = kreg; *(LAS3 u32x4*)(lds + vdst) = fp8x8_to_bf16(vreg0); *(LAS3 u32x4*)(lds + vdst + 8192) = fp8x8_to_bf16(vreg1);
    __syncthreads();
#pragma unroll 1
    for (int t2 = 0; t2 < NT2; ++t2) {
        const int cur = (t2 & 1) * 16384, nxt = 16384 - cur, cur8 = (t2 & 1) * 8192, nxt8 = 8192 - cur8; const u32x4 mw = mwn;
        if (t2 + 1 < NT2) { const size_t o = (size_t)(t2 + 1) * 8192; kreg = *(const u32x4*)(ksrc + o); vreg0 = *(const u32x2*)(vsrc + o); vreg1 = *(const u32x2*)(vsrc + o + 4096);
            mwn = *(const u32x4*)(selrow + 4 * (t2 + 1)); }
        if (2 * t2 <= mylast)
            attn_tile8<true>(st, zref, q8, kp0 + cur8, vp0 + cur, tqb + 128 * t2, mw.x >> (4 * hi), mw.y >> (4 * hi), lds + DS_LUT);
        if (2 * t2 + 1 <= mylast)
            attn_tile8<true>(st, zref, q8, kp0 + cur8 + 4096, vp0 + cur + 8192, tqb + 128 * t2 + 64, mw.z >> (4 * hi), mw.w >> (4 * hi), lds + DS_LUT);
        if (t2 + 1 < NT2) { *(LAS3 u32x4*)(lds + kdst + nxt8) = kreg; *(LAS3 u32x4*)(lds + vdst + nxt) = fp8x8_to_bf16(vreg0); *(LAS3 u32x4*)(lds + vdst + nxt + 8192) = fp8x8_to_bf16(vreg1); }
        __syncthreads();
    }
    float lse2; const float rl = attn_finish8(st, lse2);
    attn_store8(st, rl * (1.0f / D8_SCALE), (unsigned char*)(p.ws + OFF_YA) + (size_t)(b * SEQ + qw + r32) * YAB_LD + h * 64, hi);
}
DEVI void phase_dil_merge(const Params& p) {
    const unsigned char* OG = (const unsigned char*)(p.ws + OFF_OG);
    const float* LSE = (const float*)(p.ws + OFF_LSE); unsigned char* YB = (unsigned char*)(p.ws + OFF_YA) + 512;
    const size_t stride = (size_t)gridDim.x * 512;
    for (size_t i0 = (size_t)blockIdx.x * 512 + opaque_tid(); i0 < (size_t)NTOK * 32; i0 += 2 * stride) {
        float l[2][3]; u32x2 x[2][3];
#pragma unroll
        for (int k = 0; k < 2; ++k) { const size_t i = i0 + k * stride < (size_t)NTOK * 32 ? i0 + k * stride : i0; const size_t tok = i >> 5; const int c8 = (int)(i & 31) * 8, j = c8 >> 6;
#pragma unroll
            for (int g = 0; g < 3; ++g) { l[k][g] = LSE[(size_t)NTOK * 4 * g + tok * 4 + j]; x[k][g] = *(const u32x2*)(OG + (size_t)NTOK * 256 * g + tok * 256 + c8); } }
#pragma unroll
        for (int k = 0; k < 2; ++k) { const size_t i = i0 + k * stride; if (i < (size_t)NTOK * 32) { const size_t tok = i >> 5; const int c8 = (int)(i & 31) * 8;
            const float mx = max3f(l[k][0], l[k][1], l[k][2]); float a0 = __builtin_amdgcn_exp2f(l[k][0] - mx), a1 = __builtin_amdgcn_exp2f(l[k][1] - mx), a2 = __builtin_amdgcn_exp2f(l[k][2] - mx);
            const float inv = 1.0f / (a0 + a1 + a2); a0 *= inv; a1 *= inv; a2 *= inv;
            float v[8];
#pragma unroll
            for (int hw = 0; hw < 2; ++hw) { const unsigned w0 = hw ? x[k][0].y : x[k][0].x, w1 = hw ? x[k][1].y : x[k][1].x, w2 = hw ? x[k][2].y : x[k][2].x;
                const f32x2 p0 = __builtin_amdgcn_cvt_pk_f32_fp8(w0, false), q0 = __builtin_amdgcn_cvt_pk_f32_fp8(w0, true), p1 = __builtin_amdgcn_cvt_pk_f32_fp8(w1, false), q1 = __builtin_amdgcn_cvt_pk_f32_fp8(w1, true),
                            p2 = __builtin_amdgcn_cvt_pk_f32_fp8(w2, false), q2 = __builtin_amdgcn_cvt_pk_f32_fp8(w2, true);
                v[4 * hw] = a0 * p0[0] + a1 * p1[0] + a2 * p2[0]; v[4 * hw + 1] = a0 * p0[1] + a1 * p1[1] + a2 * p2[1]; v[4 * hw + 2] = a0 * q0[0] + a1 * q1[0] + a2 * q2[0]; v[4 * hw + 3] = a0 * q0[1] + a1 * q1[1] + a2 * q2[1]; }
            u32x2 o; o.x = pk4_fp8(v[0], v[1], v[2], v[3]); o.y = pk4_fp8(v[4], v[5], v[6], v[7]);
            *(u32x2*)(YB + tok * YAB_LD + c8) = o; } }
    }
}
DEVI void phase_dsa(const Params& p, LAS3 unsigned char* lds) {
    int hprev = -1;
    for (int u = blockIdx.x; u < BATCH * 8 * 4; u += gridDim.x) {
        const int b = u >> 5, h = (u >> 2) & 7, j = u & 3;
        dsa_unit(p, lds, b, h, j, h != hprev); dsa_unit(p, lds, b, h, 7 - j, false); hprev = h;
    }
}

constexpr int DL_SET = 73728, DL_VOFF = 24576, DL_TAB = 2 * DL_SET;
static_assert(DL_TAB + 12 * 224 * 4 <= LDS_XB, "dilated phase LDS overflow");
struct DilU { bool tB; int b, gj, r, ls, res0, res1, i0, sg0, nst; size_t hb; };
DEVI DilU dil_decode(int u) {
    DilU d; d.tB = (u % 3) == 2; const int ix = d.tB ? u / 3 : (u / 3) * 2 + (u % 3);
    if (!d.tB) { const int e8 = ix & 7; d.gj = (ix >> 3) & 7; d.b = ix >> 6; d.r = (d.gj >> 2) ? 4 : 1; d.ls = SEQ / d.r; const int nb = d.ls >> 8; d.res0 = d.res1 = e8 / nb; d.i0 = (e8 % nb) * 256; d.sg0 = d.i0 == 0 ? 1 : 0; d.nst = 3; }
    else { const int e8 = ix & 7; d.gj = 8 + ((ix >> 3) & 3); d.b = ix >> 5; d.r = 16; d.ls = 128; d.res0 = 2 * e8; d.res1 = 2 * e8 + 1; d.i0 = 0; d.sg0 = 0; d.nst = 2; }
    d.hb = ((size_t)d.gj * BATCH + d.b) * SEQ; return d;
}
DEVI void phase_dil(const Params& p, LAS3 unsigned char* lds) {
    const int tid = opaque_tid(), lane = tid & 63, wv = __builtin_amdgcn_readfirstlane(tid >> 6), r32 = lane & 31, hi = lane >> 5;
    LAS3 float* tabs = (LAS3 float*)(lds + DL_TAB);
    LAS3 float* rb = (LAS3 float*)lds;
    { const float b0 = p.rel_bias[tid], b1 = tid < 128 ? p.rel_bias[512 + tid] : 0.f; rb[tid] = b0; if (tid < 128) rb[512 + tid] = b1; }
    __syncthreads();
    for (int i = tid; i < 12 * 224; i += 512) { const int gj = i / 224, dist = i % 224 - 64, g = gj >> 2;
        tabs[i] = (dist < 0 || dist > 128) ? NEGB : rb[rel_bucket(dist * dil_r(g)) * 20 + 8 + gj] * LOG2E; }
    __syncthreads();
    const unsigned char* DQ = (const unsigned char*)(p.ws + OFF_DIL); const unsigned char* DK = DQ + DIL_SZ; const unsigned char* DV = DK + DIL_SZ;
    unsigned char* OG = (unsigned char*)(p.ws + OFF_OG); float* LSE = (float*)(p.ws + OFF_LSE);
    u32x4 kreg[3]; u32x2 vreg[3][2]; pg::v8i_t q8n;
#define DLU_TS(d_, sg_, s_) ((d_).tB ? 64 * (sg_) : (d_).i0 - 128 + 64 * (2 * (sg_) + (s_)))
#define DLU_LOAD(d_) do { _Pragma("unroll") for (int j_ = 0; j_ < 3; ++j_) { const int sg_ = (d_).sg0 + j_; if (sg_ < (d_).nst) { \
        { const int sl_ = wv >> 2, ts_ = DLU_TS(d_, sg_, sl_); int kk = ts_ + lane; kk = kk < 0 ? 0 : (kk > (d_).ls - 1 ? (d_).ls - 1 : kk); \
          kreg[j_] = *(const u32x4*)(DK + ((d_).hb + (size_t)(sl_ ? (d_).res1 : (d_).res0) * (d_).ls + kk) * 64 + (wv & 3) * 16); } \
        _Pragma("unroll") for (int s_ = 0; s_ < 2; ++s_) { const int ts_ = DLU_TS(d_, sg_, s_); int vk = ts_ + 16 * (wv & 3) + (lane >> 2); vk = vk < 0 ? 0 : (vk > (d_).ls - 1 ? (d_).ls - 1 : vk); \
          vreg[j_][s_] = *(const u32x2*)(DV + ((d_).hb + (size_t)(s_ ? (d_).res1 : (d_).res0) * (d_).ls + vk) * 64 + (wv >> 2) * 32 + (lane & 3) * 8); } } } \
        { const int wres_ = (d_).tB ? ((wv >> 2) ? (d_).res1 : (d_).res0) : (d_).res0, qpos_ = (d_).i0 + ((d_).tB ? 32 * (wv & 3) : 32 * wv) + r32; \
          const unsigned char* qp_ = DQ + ((d_).hb + (size_t)wres_ * (d_).ls + qpos_) * 64 + 32 * hi; q8n.lo = *(const pg::v4i_t*)qp_; q8n.hi = *(const pg::v4i_t*)(qp_ + 16); } } while (0)
#define DLU_WRITE(d_, set_) do { _Pragma("unroll") for (int j_ = 0; j_ < 3; ++j_) { const int sg_ = (d_).sg0 + j_; if (sg_ < (d_).nst) { \
        *(LAS3 u32x4*)(lds + (set_) + (2 * sg_ + (wv >> 2)) * 4096 + (wv & 3) * 1024 + lane * 16) = kreg[j_]; \
        _Pragma("unroll") for (int s_ = 0; s_ < 2; ++s_) *(LAS3 u32x4*)(lds + (set_) + DL_VOFF + (2 * sg_ + s_) * 8192 + (wv >> 2) * 4096 + (wv & 3) * 1024 + lane * 16) = fp8x8_to_bf16(vreg[j_][s_]); } } } while (0)
    int u = blockIdx.x; DilU d = dil_decode(u < 3072 ? u : 0); pg::v8i_t q8;
    if (u < 3072) { DLU_LOAD(d); DLU_WRITE(d, 0); }
    q8 = q8n;
#pragma unroll 1
    for (int it = 0; u < 3072; u += gridDim.x, ++it) {
        const int set = (it & 1) * DL_SET; const int un = u + gridDim.x; const bool has_next = un < 3072;
        DilU dn = dil_decode(has_next ? un : u);
        if (has_next) DLU_LOAD(dn);
        __syncthreads();
        const int g = d.gj >> 2, j = d.gj & 3;
        const int wres = d.tB ? ((wv >> 2) ? d.res1 : d.res0) : d.res0, wq = d.tB ? 32 * (wv & 3) : 32 * wv, qpos = d.i0 + wq + r32;
        const int tlo = wq >> 6, thi = (wq + 159) >> 6;
        AttnState8 st; st.m = 0.f; st.mx = NEGB; st.l = 0.f; bool zref = true;
#pragma unroll
        for (int q = 0; q < 16; ++q) { st.o0[q] = 0.f; st.o1[q] = 0.f; }
        const LAS3 float* tb = (const LAS3 float*)(lds + DL_TAB) + d.gj * 224;
        const LAS3 unsigned char* kp0 = lds + set + 2 * hi * 1024 + r32 * 16;
        const LAS3 unsigned char* vp0 = lds + set + DL_VOFF + ((lane >> 4) & 1) * 32 + (lane & 3) * 8 + (4 * hi + ((lane & 15) >> 2)) * 64;
#pragma unroll 1
        for (int sg = d.sg0; sg < d.nst; ++sg) {
#pragma unroll
            for (int s_ = 0; s_ < 2; ++s_) {
                const int tau = d.tB ? 2 + sg : 2 * sg + s_, ts = DLU_TS(d, sg, s_), T = 2 * sg + s_;
                const bool mine = tau >= tlo && tau <= thi && (!d.tB || s_ == (wv >> 2)) && ts + 63 >= 0;
                if (mine) {
                    if (ts >= 0) attn_tile8<false, 0, false>(st, zref, q8, kp0 + T * 4096, vp0 + T * 8192, tb + 64 + qpos - ts - 4 * hi - 63, 0u, 0u);
                    else { const unsigned long long vm = ~0ull << (-ts);
                        attn_tile8<false, 1, false>(st, zref, q8, kp0 + T * 4096, vp0 + T * 8192, tb + 64 + qpos - ts - 4 * hi - 63, (unsigned)vm >> (4 * hi), (unsigned)(vm >> 32) >> (4 * hi)); }
                }
            }
        }
        float lse2; const float rl = attn_finish8l(st, lse2);
        const int stok = qpos * d.r + wres; const size_t tok = (size_t)d.b * SEQ + stok;
        attn_store8(st, rl * (1.0f / D8_SCALE), OG + ((size_t)g * NTOK + tok) * 256 + j * 64, hi);
        if (hi == 0) LSE[((size_t)g * NTOK + tok) * 4 + j] = lse2;
        if (has_next) DLU_WRITE(dn, DL_SET - set);
        d = dn; q8 = q8n;
    }
#undef DLU_TS
#undef DLU_LOAD
#undef DLU_WRITE
}


#define XB_TMO      128
#define XB_XCNT(j)  (256  + 64 * (j))
#define XB_XSUB(j)  (1280 + 64 * (j))
#define XB_XGEN(j)  (2304 + 64 * (j))
#define XB_TOP      3328
#define XB_TOPGEN   3392
#define XCD_BAR_WORDS 3456
#define XB_SPIN_CAP (1u << 18)
#define LAS __attribute__((address_space(3)))

__device__ __forceinline__ unsigned xb_ld(unsigned* p)              { return __hip_atomic_load(p, __ATOMIC_RELAXED, __HIP_MEMORY_SCOPE_AGENT); }
__device__ __forceinline__ unsigned xb_add(unsigned* p, unsigned v) { return __hip_atomic_fetch_add(p, v, __ATOMIC_RELAXED, __HIP_MEMORY_SCOPE_AGENT); }
__device__ __forceinline__ unsigned xb_xcc_id() { return (unsigned)__builtin_amdgcn_s_getreg((3 << 11) | 20) & 0xFu; }
#define XB_SPIN(cond, bar) do { unsigned _sp = 0; while (cond) { __builtin_amdgcn_s_sleep(1); \
    if ((++_sp & 255u) == 0u) { if (xb_ld(&(bar)[XB_TMO])) break; if (_sp > XB_SPIN_CAP) { atomicAdd(&(bar)[XB_TMO], 1u); break; } } } } while (0)

struct XcdBarrier {
    unsigned* bar; unsigned x;
    volatile LAS unsigned* st;
};

__device__ __forceinline__ XcdBarrier xcd_barrier_post(unsigned* bar, volatile LAS unsigned* st) {
    XcdBarrier b; b.bar = bar; b.x = xb_xcc_id(); b.st = st;
    if (threadIdx.x == 0) (void)xb_add(&bar[XB_XCNT(b.x)], 1u);
    return b;
}
__device__ __forceinline__ void xcd_barrier_complete(unsigned* bar, unsigned x, unsigned& nloc, unsigned& nx) {
    const unsigned G = gridDim.x * gridDim.y * gridDim.z;
    unsigned sum, cnt, mine, sp = 0u;
    for (;;) {
        sum = 0u; cnt = 0u; mine = 0u;
#pragma unroll
        for (unsigned j = 0; j < 16; ++j) { const unsigned c = xb_ld(&bar[XB_XCNT(j)]); sum += c; cnt += (c > 0u) ? 1u : 0u; mine = (j == x) ? c : mine; }
        if (sum == G) break;
        __builtin_amdgcn_s_sleep(1);
        if ((++sp & 255u) == 0u) { if (xb_ld(&bar[XB_TMO])) break; if (sp > XB_SPIN_CAP) { atomicAdd(&bar[XB_TMO], 1u); break; } }
    }
    nloc = mine > 0u ? mine : 1u; nx = cnt > 0u ? cnt : 1u;
}

__device__ __forceinline__ void xcd_barrier(const XcdBarrier& b) {
    asm volatile("s_waitcnt vmcnt(0)" ::: "memory");
    __syncthreads();
    if (threadIdx.x == 0) {
        unsigned* bar = b.bar;
        __builtin_amdgcn_s_waitcnt(0);
        unsigned nloc = b.st[0], nx = b.st[1];
        if (nloc == 0u) { xcd_barrier_complete(bar, b.x, nloc, nx); b.st[0] = nloc; b.st[1] = nx; }
        const unsigned old = xb_add(&bar[XB_XSUB(b.x)], 1u);
        const unsigned gen = old / nloc;
        if (old + 1u == (gen + 1u) * nloc) {
            __builtin_amdgcn_fence(__ATOMIC_RELEASE, "agent");
            asm volatile("s_waitcnt vmcnt(0)" ::: "memory");
            const unsigned og = xb_add(&bar[XB_TOP], 1u);
            const unsigned tg = og / nx;
            if (og + 1u == (tg + 1u) * nx) xb_add(&bar[XB_TOPGEN], 1u);
            else XB_SPIN(xb_ld(&bar[XB_TOPGEN]) == tg, bar);
            __builtin_amdgcn_fence(__ATOMIC_ACQUIRE, "agent");
            xb_add(&bar[XB_XGEN(b.x)], 1u);
            asm volatile("s_waitcnt vmcnt(0)" ::: "memory");
        } else {
            XB_SPIN(xb_ld(&bar[XB_XGEN(b.x)]) == gen, bar);
            __builtin_amdgcn_fence(__ATOMIC_ACQUIRE, "agent");
            asm volatile("s_waitcnt vmcnt(0)" ::: "memory");
        }
    }
    __syncthreads();
}


__global__ void __launch_bounds__(512, 2) fwd(Params p) {
    extern __shared__ __attribute__((aligned(16))) unsigned char smem[];
    LAS3 unsigned char* lds = (LAS3 unsigned char*)smem;
    if (threadIdx.x < 4) ((LAS3 unsigned*)(lds + LDS_XB))[threadIdx.x] = 0u;
    __syncthreads();
    XcdBarrier bar = xcd_barrier_post((unsigned*)(p.ws + OFF_BAR), (volatile LAS unsigned*)(lds + LDS_XB));
    phase_prologue(p, lds);
#if PROBE_DUP == 1
    phase_prologue(p, lds);
#endif
    xcd_barrier(bar);
    phase_proj(p, lds);
    xcd_barrier(bar);
    phase_kv(p, lds);
#if PROBE_DUP == 2
    phase_kv(p, lds);
#endif
    phase_topk(p, lds);
#if PROBE_DUP == 3
    phase_topk(p, lds);
#endif
    __syncthreads();
    phase_dil(p, lds);
#if PROBE_DUP == 4
    __syncthreads(); phase_dil(p, lds);
#endif
    xcd_barrier(bar);
    phase_dil_merge(p);
    phase_dsa(p, lds);
#if PROBE_DUP == 5
    phase_dsa(p, lds);
#endif
    xcd_barrier(bar);
    phase_mix(p, lds);
#if PROBE_DUP == 6
    phase_mix(p, lds);
#endif
    __builtin_amdgcn_fence(__ATOMIC_SEQ_CST, "workgroup"); __syncthreads();
    phase_out(p, lds);
#if PROBE_DUP == 7
    phase_out(p, lds);
#endif
    __builtin_amdgcn_fence(__ATOMIC_SEQ_CST, "workgroup"); __syncthreads();
    phase_route(p, lds);
    phase_expert_weights(p, lds);
#if PROBE_DUP == 11
    phase_expert_weights(p, lds);
#endif
    xcd_barrier(bar);
    build_expert_tables(p, lds);
    phase_gu(p, lds);
#if PROBE_DUP == 8
    phase_gu(p, lds);
#endif
    xcd_barrier(bar);
    phase_down(p, lds);
#if PROBE_DUP == 9
    phase_down(p, lds);
#endif
    xcd_barrier(bar);
    phase_final(p, lds);
#if PROBE_DUP == 10
    phase_final(p, lds);
#endif
}
extern "C" void kernel_launch(void* const* d_in, const int* in_sizes, int n_in, void* d_out, int out_size, void* d_ws, size_t ws_size, hipStream_t stream) {
    Params p{};
    p.x = (const float*)d_in[0]; p.attn_norm = (const float*)d_in[1]; p.w_in = (const float*)d_in[2]; p.kv_norm = (const float*)d_in[3];
    p.w_uk = (const float*)d_in[4]; p.w_uv = (const float*)d_in[5]; p.rel_bias = (const float*)d_in[6]; p.w_a = (const float*)d_in[7]; p.w_b = (const float*)d_in[8];
    p.w_out = (const float*)d_in[9]; p.ffn_norm = (const float*)d_in[10]; p.w_rg = (const float*)d_in[11]; p.b_rg = (const float*)d_in[12]; p.w_re = (const float*)d_in[13];
    p.b_re = (const float*)d_in[14]; p.w_gate = (const float*)d_in[15]; p.w_up = (const float*)d_in[16]; p.w_down = (const float*)d_in[17]; p.final_norm = (const float*)d_in[18];
    p.out = (float*)d_out; p.ws = (char*)d_ws;
    static int grid = 0;
    if (!grid) {
        (void)hipFuncSetAttribute((const void*)fwd, hipFuncAttributeMaxDynamicSharedMemorySize, LDS_TOTAL);
        int dev = 0, cus = 0, per_cu = 0; (void)hipGetDevice(&dev); (void)hipDeviceGetAttribute(&cus, hipDeviceAttributeMultiprocessorCount, dev);
        (void)hipOccupancyMaxActiveBlocksPerMultiprocessor(&per_cu, (const void*)fwd, 512, LDS_TOTAL);
        grid = (cus > 0 ? cus : 256) * (per_cu >= 1 ? 1 : 0);
        if (grid <= 0) { fprintf(stderr, "kernel_launch: fwd does not fit a CU (occupancy query %d)\n", per_cu); grid = -1; }
    }
    if (grid < 0) return;
    (void)hipMemsetAsync((char*)d_ws + OFF_BAR, 0, XCD_BAR_WORDS * sizeof(unsigned), stream);
    (void)hipMemsetAsync((char*)d_ws + OFF_ECNT, 0, 1024, stream);
    fwd<<<grid, 512, LDS_TOTAL, stream>>>(p);
}
```

```cpp
#include <hip/hip_runtime.h>
#include <stdint.h>
#include <stdio.h>
#define PROBE_DUP 0
#define TK_REP_SEL 1
#define TK_REP_TIE 1

typedef unsigned short bf16_t;
#define DEVI __device__ __forceinline__

constexpr int BATCH = 32, SEQ = 2048, DM = 1024, NTOK = BATCH * SEQ;
constexpr int IN_COLS = 5444;
constexpr int NEXP = 32, EFF = 512;
constexpr float RMS_EPS = 1e-6f;
constexpr float LOG2E = 1.4426950408889634f;
constexpr float QSCALE = 0.125f * LOG2E;

constexpr size_t MiB = 1ull << 20;
constexpr size_t OFF_BAR   = 0;
constexpr size_t OFF_SSQ   = 1 * MiB;
constexpr size_t OFF_WI    = 2 * MiB;
constexpr size_t OFF_ECNT  = 3 * MiB;
constexpr size_t OFF_LSE   = 4 * MiB;
constexpr size_t OFF_WTIN  = 8 * MiB;
constexpr size_t OFF_WSM   = 20 * MiB;
constexpr size_t OFF_OG    = 24 * MiB;
constexpr size_t OFF_R1    = 120 * MiB;
constexpr size_t OFF_QA    = 248 * MiB;
constexpr size_t OFF_CR    = 312 * MiB;
constexpr size_t OFF_QI    = 344 * MiB;
constexpr size_t OFF_YA    = 312 * MiB;
constexpr int    YAB_LD    = 768;
constexpr size_t OFF_KI    = 376 * MiB;
constexpr size_t OFF_DIL   = 384 * MiB;
constexpr size_t DIL_SZ    = (size_t)12 * NTOK * 64;
constexpr size_t OFF_YB    = 944 * MiB;
constexpr size_t OFF_MIX   = 416 * MiB;
constexpr size_t OFF_G     = 672 * MiB;
constexpr size_t OFF_H     = 672 * MiB;
constexpr size_t OFF_SEL   = 928 * MiB;

DEVI float bf2f(bf16_t v) { return __uint_as_float(((unsigned)v) << 16); }
DEVI bf16_t f2bf(float f) { unsigned u = __float_as_uint(f); u += 0x7FFFu + ((u >> 16) & 1u); return (bf16_t)(u >> 16); }

DEVI int rel_bucket(int n) {
    if (n < 16) return n < 0 ? 0 : n;
    int b = 16;
    b += (n >= 22) + (n >= 30) + (n >= 40) + (n >= 54) + (n >= 73) + (n >= 99) + (n >= 134) + (n >= 182);
    b += (n >= 246) + (n >= 332) + (n >= 450) + (n >= 609) + (n >= 825) + (n >= 1117) + (n >= 1513);
    return b;
}
DEVI int dil_r(int g) { return g == 0 ? 1 : (g == 1 ? 4 : 16); }


#define LAS3 __attribute__((address_space(3)))
DEVI int opaque_tid() { int t = threadIdx.x; asm volatile("" : "+v"(t)); return t; }
typedef short bf16x8 __attribute__((ext_vector_type(8)));
typedef float f32x4 __attribute__((ext_vector_type(4)));
typedef float f32x2 __attribute__((ext_vector_type(2)));
typedef unsigned u32x4 __attribute__((ext_vector_type(4)));
typedef unsigned u32x2 __attribute__((ext_vector_type(2)));

constexpr int LDS_TOTAL = 163840;
constexpr int LDS_TAB   = 131072;
constexpr int LDS_XB    = LDS_TOTAL - 16;

constexpr size_t OFF_LIST  = 8 * MiB;
constexpr size_t OFF_WEXP  = 16 * MiB;
constexpr size_t OFF_WDN   = OFF_WEXP + 64 * MiB;
constexpr size_t OFF_TT    = OFF_R1;
constexpr size_t OFF_HID   = 248 * MiB;
constexpr size_t OFF_EO    = 384 * MiB;
constexpr size_t OFF_RT    = 5 * MiB;
constexpr size_t OFF_U     = OFF_R1;
constexpr size_t OFF_WKV   = OFF_WSM;
constexpr size_t OFF_WAT   = OFF_WSM + 512 * 1024;
constexpr size_t OFF_WBT   = OFF_WSM + 1536 * 1024;
constexpr size_t OFF_WOT   = 984 * MiB;
constexpr size_t OFF_U8    = OFF_OG;
constexpr size_t OFF_WT8   = 976 * MiB;
constexpr size_t OFF_WAB   = 982 * MiB;
constexpr int NPAD = 5632;

typedef __bf16 bf16x2_t __attribute__((ext_vector_type(2)));
DEVI float fadd1(float a, float b) { float d; asm("v_add_f32 %0, %1, %2" : "=v"(d) : "v"(a), "v"(b)); return d; }
DEVI unsigned cvt_pk_bf16(float lo, float hi) { f32x2 v = {lo, hi}; bf16x2_t r = __builtin_convertvector(v, bf16x2_t); return __builtin_bit_cast(unsigned, r); }
DEVI u32x4 pack8(const f32x4& a, const f32x4& b) { u32x4 w; w.x = cvt_pk_bf16(a[0], a[1]); w.y = cvt_pk_bf16(a[2], a[3]); w.z = cvt_pk_bf16(b[0], b[1]); w.w = cvt_pk_bf16(b[2], b[3]); return w; }
DEVI unsigned pk4_fp8(float a, float b, float c, float d) { unsigned w = 0u; w = __builtin_amdgcn_cvt_pk_fp8_f32(a, b, w, false); w = __builtin_amdgcn_cvt_pk_fp8_f32(c, d, w, true); return w; }
constexpr float D8_SCALE = 8.0f;
constexpr float W8_SCALE = 32.0f, W8_INV = 1.0f / 32.0f;
DEVI u32x4 fp8x8_to_bf16(u32x2 w, float scale) {
    const f32x2 a = __builtin_amdgcn_cvt_pk_f32_fp8(w.x, false), b = __builtin_amdgcn_cvt_pk_f32_fp8(w.x, true), c = __builtin_amdgcn_cvt_pk_f32_fp8(w.y, false), d = __builtin_amdgcn_cvt_pk_f32_fp8(w.y, true);
    u32x4 r; r.x = cvt_pk_bf16(a[0] * scale, a[1] * scale); r.y = cvt_pk_bf16(b[0] * scale, b[1] * scale); r.z = cvt_pk_bf16(c[0] * scale, c[1] * scale); r.w = cvt_pk_bf16(d[0] * scale, d[1] * scale); return r;
}
DEVI u32x4 fp8x8_to_bf16(u32x2 w) {
    const f32x2 a = __builtin_amdgcn_cvt_pk_f32_fp8(w.x, false), b = __builtin_amdgcn_cvt_pk_f32_fp8(w.x, true), c = __builtin_amdgcn_cvt_pk_f32_fp8(w.y, false), d = __builtin_amdgcn_cvt_pk_f32_fp8(w.y, true);
    u32x4 r; r.x = cvt_pk_bf16(a[0], a[1]); r.y = cvt_pk_bf16(b[0], b[1]); r.z = cvt_pk_bf16(c[0], c[1]); r.w = cvt_pk_bf16(d[0], d[1]); return r;
}
DEVI unsigned pk4_u8(float a, float b, float c, float d) { unsigned w = 0u; w = __builtin_amdgcn_cvt_pk_u8_f32(a, 0, w); w = __builtin_amdgcn_cvt_pk_u8_f32(b, 1, w); w = __builtin_amdgcn_cvt_pk_u8_f32(c, 2, w); return __builtin_amdgcn_cvt_pk_u8_f32(d, 3, w); }
DEVI float bflo(unsigned w) { return __uint_as_float(w << 16); }
DEVI float bfhi(unsigned w) { return __uint_as_float(w & 0xFFFF0000u); }
DEVI float fast_sigmoid(float v) { return __builtin_amdgcn_rcpf(1.0f + __expf(-v)); }

struct Params {
    const float *x, *attn_norm, *w_in, *kv_norm, *w_uk, *w_uv, *rel_bias, *w_a, *w_b, *w_out, *ffn_norm, *w_rg, *b_rg, *w_re, *b_re, *w_gate, *w_up, *w_down, *final_norm;
    float* out; char* ws;
};

DEVI void tr_tile(const float* src, int lds_, int ncols_valid, bf16_t* dst, int ldd, const float* rs, LAS3 float* tile) {
    const int tid = opaque_tid();
    { const int c = tid & 63, cs = c < ncols_valid ? c : 0; float v[8], sc[8];
#pragma unroll
      for (int i = 0; i < 8; ++i) { const int r = (tid >> 6) + 8 * i; v[i] = src[(size_t)r * lds_ + cs]; sc[i] = rs ? rs[r] : 1.0f; }
#pragma unroll
      for (int i = 0; i < 8; ++i) tile[((tid >> 6) + 8 * i) * 65 + c] = c < ncols_valid ? v[i] * sc[i] : 0.f; }
    __syncthreads();
    { const int c = tid >> 3, r0 = (tid & 7) * 8;
      u32x4 w;
#pragma unroll
      for (int q = 0; q < 4; ++q) w[q] = cvt_pk_bf16(tile[(r0 + 2 * q) * 65 + c], tile[(r0 + 2 * q + 1) * 65 + c]);
      *(u32x4*)(dst + (size_t)c * ldd + r0) = w; }
    __syncthreads();
}

DEVI void tr_tile8(const float* src, int lds_, unsigned char* dst, int ldd, float scale, LAS3 float* tile, int ncols_valid = 64) {
    const int tid = opaque_tid();
    { const int c = tid & 63, cs = c < ncols_valid ? c : 0; float v[8];
#pragma unroll
      for (int i = 0; i < 8; ++i) v[i] = src[(size_t)((tid >> 6) + 8 * i) * lds_ + cs];
#pragma unroll
      for (int i = 0; i < 8; ++i) tile[((tid >> 6) + 8 * i) * 65 + c] = c < ncols_valid ? v[i] * scale : 0.f; }
    __syncthreads();
    { const int c = tid >> 3, r0 = (tid & 7) * 8; u32x2 w;
      w.x = pk4_fp8(tile[(r0 + 0) * 65 + c], tile[(r0 + 1) * 65 + c], tile[(r0 + 2) * 65 + c], tile[(r0 + 3) * 65 + c]);
      w.y = pk4_fp8(tile[(r0 + 4) * 65 + c], tile[(r0 + 5) * 65 + c], tile[(r0 + 6) * 65 + c], tile[(r0 + 7) * 65 + c]);
      *(u32x2*)(dst + (size_t)c * ldd + r0) = w; }
    __syncthreads();
}

DEVI void phase_prologue(const Params& p, LAS3 unsigned char* lds) {
    LAS3 float* tile = (LAS3 float*)lds;
    const int G = gridDim.x, c = blockIdx.x;
    for (int t = c; t < 88 * 16; t += G) {
        const int nt = t >> 4, kt = t & 15, n0 = nt * 64;
        int sc, nv;
        if (n0 < 1088) { sc = n0; nv = 64; } else if (n0 == 1088) { sc = 1088; nv = 4; } else if (n0 < 1280) { sc = 0; nv = 0; }
        else if (n0 < 3584) { sc = 1092 + (n0 - 1280); nv = 64; } else { sc = 3396 + (n0 - 3584); nv = 64; }
        tr_tile8(p.w_in + (size_t)kt * 64 * IN_COLS + sc, IN_COLS, (unsigned char*)(p.ws + OFF_WT8) + (size_t)n0 * 1024 + kt * 64, 1024, W8_SCALE, tile, nv);
    }
    for (int t = c; t < 16 * 4; t += G) {
        const int which = t >> 5, h = (t >> 2) & 7, kt = t & 3; const float* W = which ? p.w_uv : p.w_uk;
        tr_tile(W + ((size_t)h * 256 + kt * 64) * 64, 64, 64, (bf16_t*)(p.ws + OFF_WKV) + (size_t)(which * 512 + h * 64) * 256 + kt * 64, 256, p.kv_norm + kt * 64, tile);
    }
    for (int t = c; t < 16 * 12 * 2; t += G) {
        const int half = t / 192, r = t % 192, nt = r / 12, kt = r % 12; const bool real = half == 0 ? kt < 8 : kt >= 8;
        const float* src = half == 0 ? p.w_a + (size_t)kt * 64 * 1024 + nt * 64 : p.w_b + (size_t)(kt - 8) * 64 * 1024 + nt * 64;
        tr_tile8(real ? src : p.w_a, 1024, (unsigned char*)(p.ws + OFF_WAB) + (size_t)((nt >> 1) * 256 + half * 128 + (nt & 1) * 64) * YAB_LD + kt * 64, YAB_LD, W8_SCALE, tile, real ? 64 : 0);
    }
    for (int t = c; t < 16 * 16; t += G) { const int nt = t >> 4, kt = t & 15; tr_tile8(p.w_out + (size_t)kt * 64 * 1024 + nt * 64, 1024, (unsigned char*)(p.ws + OFF_WOT) + (size_t)nt * 64 * 1024 + kt * 64, 1024, W8_SCALE, tile); }
    const int lane = opaque_tid() & 63, wv = opaque_tid() >> 6;
    f32x4 gn[4];
#pragma unroll
    for (int q = 0; q < 4; ++q) gn[q] = *(const f32x4*)(p.attn_norm + q * 256 + 4 * lane);
    {
        const int st = G * 8; int tok = c * 8 + wv; f32x4 nx[2][4];
#pragma unroll
        for (int k = 0; k < 2; ++k) if (tok + k * st < NTOK) {
#pragma unroll
            for (int q = 0; q < 4; ++q) nx[k][q] = *(const f32x4*)(p.x + (size_t)(tok + k * st) * 1024 + q * 256 + 4 * lane);
        }
#pragma unroll 1
        for (; tok < NTOK; tok += 2 * st) {
            f32x4 v[2][4];
#pragma unroll
            for (int k = 0; k < 2; ++k)
#pragma unroll
                for (int q = 0; q < 4; ++q) v[k][q] = nx[k][q];
#pragma unroll
            for (int k = 0; k < 2; ++k) if (tok + (2 + k) * st < NTOK) {
#pragma unroll
                for (int q = 0; q < 4; ++q) nx[k][q] = *(const f32x4*)(p.x + (size_t)(tok + (2 + k) * st) * 1024 + q * 256 + 4 * lane);
            }
#pragma unroll
            for (int k = 0; k < 2; ++k) if (tok + k * st < NTOK) {
                float ss = 0.f;
#pragma unroll
                for (int q = 0; q < 4; ++q) ss += v[k][q][0] * v[k][q][0] + v[k][q][1] * v[k][q][1] + v[k][q][2] * v[k][q][2] + v[k][q][3] * v[k][q][3];
#pragma unroll
                for (int o = 32; o > 0; o >>= 1) ss += __shfl_xor(ss, o);
                const float rinv = rsqrtf(ss * (1.0f / 1024.0f) + RMS_EPS);
#pragma unroll
                for (int q = 0; q < 4; ++q)
                    *(unsigned*)((unsigned char*)(p.ws + OFF_U8) + (size_t)(tok + k * st) * 1024 + q * 256 + 4 * lane) = pk4_fp8(v[k][q][0] * rinv * gn[q][0], v[k][q][1] * rinv * gn[q][1], v[k][q][2] * rinv * gn[q][2], v[k][q][3] * rinv * gn[q][3]);
            }
        }
    }
}

DEVI void phase_expert_weights(const Params& p, LAS3 unsigned char* lds) {
    LAS3 float* tile = (LAS3 float*)lds;
    const int G = gridDim.x, c = blockIdx.x, tid = opaque_tid();
    constexpr int NT = NEXP * 256 + NEXP * 128, TB = 4, TSZ = 64 * 65;
#pragma unroll 1
    for (int t0 = c * TB; t0 < NT; t0 += G * TB) {
        const float* src[TB]; int ld[TB]; unsigned char* dst[TB]; int ldd[TB]; float rg[TB][8];
#pragma unroll
        for (int q = 0; q < TB; ++q) {
            const int t = t0 + q;
            if (t < NEXP * 256) { const int e = t >> 8, r = t & 255, half = r >> 7, ft = (r >> 4) & 7, kt = r & 15, pnl = ft >> 1, n = pnl * 256 + half * 128 + (ft & 1) * 64;
                src[q] = (half ? p.w_up : p.w_gate) + (size_t)e * 1024 * 512 + (size_t)kt * 64 * 512 + ft * 64; ld[q] = 512;
                dst[q] = (unsigned char*)(p.ws + OFF_WEXP) + ((size_t)e * 1024 + n) * 1024 + kt * 64; ldd[q] = 1024; }
            else { const int t2 = t - NEXP * 256, e = t2 >> 7, nt = (t2 >> 3) & 15, kt = t2 & 7;
                src[q] = p.w_down + (size_t)e * 512 * 1024 + (size_t)kt * 64 * 1024 + nt * 64; ld[q] = 1024;
                dst[q] = (unsigned char*)(p.ws + OFF_WDN) + ((size_t)e * 1024 + nt * 64) * 512 + kt * 64; ldd[q] = 512; }
#pragma unroll
            for (int i = 0; i < 8; ++i) rg[q][i] = src[q][(size_t)((tid >> 6) + 8 * i) * ld[q] + (tid & 63)];
        }
#pragma unroll
        for (int q = 0; q < TB; ++q)
#pragma unroll
            for (int i = 0; i < 8; ++i) tile[q * TSZ + ((tid >> 6) + 8 * i) * 65 + (tid & 63)] = rg[q][i] * W8_SCALE;
        __syncthreads();
#pragma unroll
        for (int q = 0; q < TB; ++q) { const int cc = tid >> 3, r0 = (tid & 7) * 8; const LAS3 float* tq = tile + q * TSZ; u32x2 w;
            w.x = pk4_fp8(tq[(r0 + 0) * 65 + cc], tq[(r0 + 1) * 65 + cc], tq[(r0 + 2) * 65 + cc], tq[(r0 + 3) * 65 + cc]);
            w.y = pk4_fp8(tq[(r0 + 4) * 65 + cc], tq[(r0 + 5) * 65 + cc], tq[(r0 + 6) * 65 + cc], tq[(r0 + 7) * 65 + cc]);
            *(u32x2*)(dst[q] + (size_t)cc * ldd[q] + r0) = w; }
        __syncthreads();
    }
}

namespace pg {
constexpr int BM = 256, BK = 64, HALF = 128, HTB = HALF * BK * 2, STAGE_BYTES = 8 * HTB, NXCD = 8, WGM = 8;
__host__ __device__ __forceinline__ int lds_byte(int r, int c) { const int st = (r >> 4) * 2 + (c >> 5), rr = r & 15, cc = c & 31, ob = rr * 64 + cc * 2; return st * 1024 + (ob ^ (((ob >> 9) & 1) << 5)); }
__host__ __device__ __forceinline__ void stage_rc(int b, int& R, int& C) { const int st = b / 1024, sb = b % 1024, swz = sb ^ (((sb >> 9) & 1) << 5); R = (st >> 1) * 16 + swz / 64; C = (st & 1) * 32 + (swz % 64) / 2; }
__host__ __device__ __forceinline__ int perm32(int rho) { const int n = rho >> 4, i = rho & 15; return 8 * (i >> 2) + 4 * n + (i & 3); }

struct Unit { int pm, pn, pb, lbase, nvalid; };
struct Gemm { const bf16_t* A; const bf16_t* Bt; int K; const int* list; };

struct StaticOrder {
    int nM, nN, nwg, G, c, pnoff, skip0, skipn;
    __device__ void init(int M, int N, int G_, int c_, int pnoff_ = 0, int skip0_ = 1 << 30, int skipn_ = 0) { nM = M / BM; nN = N / BM; nwg = nM * nN; G = G_; c = c_; pnoff = pnoff_; skip0 = skip0_; skipn = skipn_; }
    __device__ bool next(int i, Unit& u) const {
        const long L = (long)i * G + c; if (L >= nwg) return false;
        int wgid = (int)L; { const int q = nwg / NXCD, r = nwg % NXCD, xcd = wgid % NXCD, off = wgid / NXCD; wgid = (xcd < r ? xcd * (q + 1) : r * (q + 1) + (xcd - r) * q) + off; }
        const int nig = WGM * nN, gid = wgid / nig, fm = gid * WGM, gsz = (nM - fm) < WGM ? (nM - fm) : WGM;
        u.pm = fm + ((wgid % nig) % gsz); u.pb = (wgid % nig) / gsz; u.pn = u.pb + pnoff + (u.pb >= skip0 ? skipn : 0); u.lbase = 0; u.nvalid = 0; return true;
    }
};
struct RowOrder {
    int nM, nN, G, c;
    __device__ bool next(int i, Unit& u) const { const int rt = c + (i / nN) * G; if (rt >= nM) return false; u.pm = rt; u.pb = i % nN; u.pn = u.pb; u.lbase = 0; u.nvalid = 0; return true; }
};
struct GroupedOrder {
    const LAS3 int* tb; const LAS3 int* cnt; int G, c; mutable int ecur = 0;
    __device__ bool next(int i, Unit& u) const {
        const int L = i * G + c; const int T = tb[32]; if (L >= T * 4) return false;
        const int t = L >> 2; int e = ecur;
#pragma unroll 1
        while (tb[e + 1] <= t) ++e;
        ecur = e;
        const int ti = t - tb[e];
        u.pm = t; u.pn = e * 4 + (L & 3); u.pb = u.pn; u.lbase = e * 65536 + ti * 256; u.nvalid = cnt[e] - ti * 256; return true;
    }
};

typedef int v8i_t __attribute__((ext_vector_type(8)));
typedef int v4i_t __attribute__((ext_vector_type(4)));
template <bool F8> struct Frag;
template <> struct Frag<false> { bf16x8 v[2]; };
template <> struct Frag<true>  { v8i_t v; };
__device__ __forceinline__ void frag_load(Frag<false>& f, const LAS3 unsigned char* p) { f.v[0] = *(const LAS3 bf16x8*)p; f.v[1] = *(const LAS3 bf16x8*)(p + 1024); }
__device__ __forceinline__ void frag_load(Frag<true>& f, const LAS3 unsigned char* p) { f.v.lo = *(const LAS3 v4i_t*)p; f.v.hi = *(const LAS3 v4i_t*)(p + 1024); }
__device__ __forceinline__ f32x4 frag_mma(const Frag<false>& b, const Frag<false>& a, f32x4 c) { c = __builtin_amdgcn_mfma_f32_16x16x32_bf16(b.v[0], a.v[0], c, 0, 0, 0); return __builtin_amdgcn_mfma_f32_16x16x32_bf16(b.v[1], a.v[1], c, 0, 0, 0); }
__device__ __forceinline__ f32x4 frag_mma(const Frag<true>& b, const Frag<true>& a, f32x4 c) {
    asm volatile("v_mfma_scale_f32_16x16x128_f8f6f4 %0, %1, %2, %0, %3, %3 op_sel_hi:[0,0,0]" : "+v"(c) : "v"(b.v), "v"(a.v), "v"(0x7F7F7F7F));
    return c;
}

template <class Epi, class Sched, bool GATHER, bool F8 = false, int TSPLIT = 0>
__device__ __forceinline__ void gemm_phase(LAS3 unsigned char* lds, const Gemm g, const Sched& S, const Epi& E) {
    const int tid = opaque_tid(), wid = __builtin_amdgcn_readfirstlane(tid >> 6), lane = tid & 63, wr = wid >> 2, wc = wid & 3, fr = lane & 15, fq = lane >> 4;
    const int K = F8 ? g.K : g.K * 2, nt = K / (BK * 2);
    unsigned voffA[2], voffB[2]; int Rr[2], Cc[2];
#pragma unroll
    for (int i = 0; i < 2; ++i) { int R, C; stage_rc(tid * 16 + i * 8192, R, C); const int Rb = Epi::PERM ? ((R & ~31) + perm32(R & 31)) : R; Rr[i] = R; Cc[i] = C;
        voffA[i] = (unsigned)(R * K + C * 2); voffB[i] = (unsigned)(Rb * K + C * 2); }
    const size_t kstep = (size_t)(BK * 2);
    const size_t hstep = (size_t)HALF * K;
    const size_t tstep = 2 * hstep;
    const unsigned ldsw = (unsigned)wid * 1024u;
    const int aoff = lds_byte(wr * 64 + fr, fq * 8), boff = lds_byte(wc * 32 + fr, fq * 8);
#define PG_SA(b, h) (((b) * 2 + (h)) * HTB)
#define PG_SB(b, h) ((4 + (b) * 2 + (h)) * HTB)
#define PG_STAGE(bufoff, gbase, voff) do { _Pragma("unroll") for (int _i = 0; _i < 2; ++_i) \
        __builtin_amdgcn_global_load_lds((const unsigned*)((const char*)(gbase) + (voff)[_i]), (LAS3 unsigned*)(lds + (bufoff) + ldsw + _i * 8192), 16, 0, 0); } while (0)
#define PG_STAGE2(bufoff, gbase, o0, o1) do { \
        __builtin_amdgcn_global_load_lds((const unsigned*)((const char*)(gbase) + (o0)), (LAS3 unsigned*)(lds + (bufoff) + ldsw), 16, 0, 0); \
        __builtin_amdgcn_global_load_lds((const unsigned*)((const char*)(gbase) + (o1)), (LAS3 unsigned*)(lds + (bufoff) + ldsw + 8192), 16, 0, 0); } while (0)
#define PG_LDA(dst, b, h) do { _Pragma("unroll") for (int m = 0; m < 4; ++m) frag_load(dst[m], lds + PG_SA(b, h) + aoff + m * 2048); } while (0)
#define PG_LDB(dst, b, h) do { _Pragma("unroll") for (int n = 0; n < 2; ++n) frag_load(dst[n], lds + PG_SB(b, h) + boff + n * 2048); } while (0)
#define PG_MMA(ai, bj, At, Bt) do { __builtin_amdgcn_s_setprio(1); _Pragma("unroll") for (int m = 0; m < 4; ++m) _Pragma("unroll") for (int n = 0; n < 2; ++n) \
        acc[ai][bj][m][n] = frag_mma(Bt[n], At[m], acc[ai][bj][m][n]); __builtin_amdgcn_s_setprio(0); } while (0)
#define PG_WAIT_V(n) asm volatile("s_waitcnt vmcnt(" #n ")" ::: "memory")
#define PG_WAIT_L(n) asm volatile("s_waitcnt lgkmcnt(" #n ")" ::: "memory")
#define PG_BAR __builtin_amdgcn_s_barrier()
#define PG_SCHED __builtin_amdgcn_sched_barrier(0)
    Unit cur, nxt; int ui = 0;
    if (!S.next(0, cur)) return;
    f32x4 acc[2][2][4][2];
#pragma unroll
    for (int a = 0; a < 2; ++a)
#pragma unroll
        for (int b = 0; b < 2; ++b)
#pragma unroll
            for (int m = 0; m < 4; ++m)
#pragma unroll
                for (int n = 0; n < 2; ++n) acc[a][b][m][n] = (f32x4){0.f, 0.f, 0.f, 0.f};
    Frag<F8> At[4], B0[2], B1[2];
    unsigned gc[2][2] = {{0u, 0u}, {0u, 0u}}, gn[2][2] = {{0u, 0u}, {0u, 0u}};
    auto load_go = [&](const Unit& u, unsigned (&go)[2][2]) {
#pragma unroll
        for (int h = 0; h < 2; ++h)
#pragma unroll
            for (int i = 0; i < 2; ++i) { int r = h * HALF + Rr[i]; r = r < u.nvalid ? r : u.nvalid - 1; const int tok = g.list[u.lbase + r]; go[h][i] = (unsigned)tok * (unsigned)K + (unsigned)(Cc[i] * 2); }
    };
    const char* cA = GATHER ? (const char*)g.A : (const char*)g.A + (size_t)cur.pm * tstep; const char* cB = (const char*)g.Bt + (size_t)cur.pb * tstep;
    if (GATHER) {
        load_go(cur, gc);
#pragma unroll
        for (int h = 0; h < 2; ++h)
#pragma unroll
            for (int i = 0; i < 2; ++i) gn[h][i] = gc[h][i];
        PG_STAGE(PG_SB(0, 0), cB, voffB); PG_STAGE2(PG_SA(0, 0), cA, gc[0][0], gc[0][1]); PG_STAGE(PG_SB(0, 1), cB + hstep, voffB); PG_STAGE2(PG_SA(0, 1), cA, gc[1][0], gc[1][1]);
        if (wr == 1) PG_BAR;
        PG_WAIT_V(4); PG_BAR;
        PG_STAGE(PG_SB(1, 0), cB + kstep, voffB); PG_STAGE2(PG_SA(1, 0), cA + kstep, gc[0][0], gc[0][1]); PG_STAGE(PG_SB(1, 1), cB + hstep + kstep, voffB);
        PG_WAIT_V(6); PG_BAR;
    } else {
        PG_STAGE(PG_SB(0, 0), cB, voffB); PG_STAGE(PG_SA(0, 0), cA, voffA); PG_STAGE(PG_SB(0, 1), cB + hstep, voffB); PG_STAGE(PG_SA(0, 1), cA + hstep, voffA);
        if (wr == 1) PG_BAR;
        PG_WAIT_V(4); PG_BAR;
        PG_STAGE(PG_SB(1, 0), cB + kstep, voffB); PG_STAGE(PG_SA(1, 0), cA + kstep, voffA); PG_STAGE(PG_SB(1, 1), cB + hstep + kstep, voffB);
        PG_WAIT_V(6); PG_BAR;
    }
    for (;;) {
        const bool has_next = S.next(ui + 1, nxt);
        const char* nA = GATHER ? cA : (has_next ? (const char*)g.A + (size_t)nxt.pm * tstep : cA); const char* nB = has_next ? (const char*)g.Bt + (size_t)nxt.pb * tstep : cB;
#pragma unroll 1
        for (int t = 0; t < nt; t += 2) {
            const bool last = (t == nt - 2);
            if (GATHER) { if (last && has_next) load_go(nxt, gn); }
            const char* a1 = cA + (size_t)(t + 1) * kstep;
            const char* a2 = last ? nA : cA + (size_t)(t + 2) * kstep; const char* b2 = last ? nB : cB + (size_t)(t + 2) * kstep;
            const char* a3 = a2 + kstep; const char* b3 = b2 + kstep;
            const bool sel0 = t < TSPLIT;
            PG_LDB(B0, 0, 0); PG_SCHED; PG_LDA(At, 0, 0);
            if (GATHER) PG_STAGE2(PG_SA(1, 1), a1, gc[1][0], gc[1][1]); else PG_STAGE(PG_SA(1, 1), a1 + hstep, voffA);
            PG_WAIT_L(8); PG_BAR; PG_WAIT_L(0); if (!TSPLIT || sel0) PG_MMA(0, 0, At, B0); PG_BAR; PG_SCHED;
            PG_LDB(B1, 0, 1); PG_STAGE(PG_SB(0, 0), b2, voffB);
            PG_BAR; PG_WAIT_L(0); if (!TSPLIT || !sel0) PG_MMA(0, 1, At, B1); PG_BAR;
            PG_LDA(At, 0, 1);
            if (GATHER) PG_STAGE2(PG_SA(0, 0), a2, last ? gn[0][0] : gc[0][0], last ? gn[0][1] : gc[0][1]); else PG_STAGE(PG_SA(0, 0), a2, voffA);
            PG_BAR; PG_WAIT_L(0); if (!TSPLIT || sel0) PG_MMA(1, 0, At, B0); PG_BAR; PG_SCHED;
            PG_STAGE(PG_SB(0, 1), b2 + hstep, voffB);
            PG_WAIT_V(6); PG_BAR; if (!TSPLIT || !sel0) PG_MMA(1, 1, At, B1); PG_BAR;
            PG_LDB(B0, 1, 0); PG_SCHED; PG_LDA(At, 1, 0);
            if (GATHER) PG_STAGE2(PG_SA(0, 1), a2, last ? gn[1][0] : gc[1][0], last ? gn[1][1] : gc[1][1]); else PG_STAGE(PG_SA(0, 1), a2 + hstep, voffA);
            PG_WAIT_L(8); PG_BAR; PG_WAIT_L(0); if (!TSPLIT || sel0) PG_MMA(0, 0, At, B0); PG_BAR; PG_SCHED;
            PG_LDB(B1, 1, 1); PG_STAGE(PG_SB(1, 0), b3, voffB);
            PG_BAR; PG_WAIT_L(0); if (!TSPLIT || !sel0) PG_MMA(0, 1, At, B1); PG_BAR;
            PG_LDA(At, 1, 1);
            if (GATHER) PG_STAGE2(PG_SA(1, 0), a3, last ? gn[0][0] : gc[0][0], last ? gn[0][1] : gc[0][1]); else PG_STAGE(PG_SA(1, 0), a3, voffA);
            PG_BAR; PG_WAIT_L(0); if (!TSPLIT || sel0) PG_MMA(1, 0, At, B0); PG_BAR; PG_SCHED;
            PG_STAGE(PG_SB(1, 1), b3 + hstep, voffB);
            PG_WAIT_V(6); PG_BAR; if (!TSPLIT || !sel0) PG_MMA(1, 1, At, B1); PG_BAR;
        }
        if constexpr (F8) asm volatile("s_nop 15\n\ts_nop 15" ::: "memory");
        E(acc, cur, wr, wc, fr, fq);
        if (!has_next) break;
#pragma unroll
        for (int a = 0; a < 2; ++a)
#pragma unroll
            for (int b = 0; b < 2; ++b)
#pragma unroll
                for (int m = 0; m < 4; ++m)
#pragma unroll
                    for (int n = 0; n < 2; ++n) acc[a][b][m][n] = (f32x4){0.f, 0.f, 0.f, 0.f};
        cur = nxt; cA = nA; cB = nB; ++ui;
        if (GATHER) {
#pragma unroll
            for (int h = 0; h < 2; ++h)
#pragma unroll
                for (int i = 0; i < 2; ++i) gc[h][i] = gn[h][i];
        }
    }
    PG_WAIT_V(0);
    if (wr == 0) PG_BAR;
    PG_BAR;
#undef PG_SA
#undef PG_SB
#undef PG_STAGE
#undef PG_STAGE2
#undef PG_LDA
#undef PG_LDB
#undef PG_MMA
#undef PG_WAIT_V
#undef PG_WAIT_L
#undef PG_BAR
#undef PG_SCHED
}
}

template <class F> __device__ __forceinline__ void epi_rows(int row0, F f) {
#pragma unroll
    for (int ai = 0; ai < 2; ++ai)
#pragma unroll
        for (int m = 0; m < 4; ++m) f(ai, m, row0 + ai * 128 + m * 16);
}
struct EpiProj {
    static constexpr bool PERM = true; char* ws;
    __device__ __forceinline__ void operator()(const f32x4 (&acc)[2][2][4][2], const pg::Unit& u, int wr, int wc, int fr, int fq) const {
        const int row0 = u.pm * 256 + wr * 64 + fr, pn = u.pn, cw = wc * 32 + 8 * fq;
        if (pn < 2) {
            unsigned char* QA = (unsigned char*)(ws + OFF_QA);
            epi_rows(row0, [&](int ai, int m, int tok) { const int b = tok >> 11, s = tok & 2047;
#pragma unroll
                for (int bj = 0; bj < 2; ++bj) { const int col = pn * 256 + bj * 128 + cw, h = col >> 6, d = col & 63;
                    const f32x4 a = acc[ai][bj][m][0] * (QSCALE * W8_INV * D8_SCALE), c = acc[ai][bj][m][1] * (QSCALE * W8_INV * D8_SCALE); u32x2 w; w.x = pk4_fp8(a[0], a[1], a[2], a[3]); w.y = pk4_fp8(c[0], c[1], c[2], c[3]);
                    *(u32x2*)(QA + ((size_t)(b * 8 + h) * SEQ + s) * 64 + d) = w; } });
        } else if (pn == 2) {
            bf16_t* CR = (bf16_t*)(ws + OFF_CR); float* SSQ = (float*)(ws + OFF_SSQ);
            epi_rows(row0, [&](int ai, int m, int tok) { float ss = 0.f;
#pragma unroll
                for (int bj = 0; bj < 2; ++bj) { const f32x4 a = acc[ai][bj][m][0] * W8_INV, b = acc[ai][bj][m][1] * W8_INV;
                    ss += a[0] * a[0] + a[1] * a[1] + a[2] * a[2] + a[3] * a[3] + b[0] * b[0] + b[1] * b[1] + b[2] * b[2] + b[3] * b[3];
                    *(u32x4*)(CR + (size_t)tok * 256 + bj * 128 + cw) = pack8(a, b); }
                ss += __shfl_xor(ss, 16); ss += __shfl_xor(ss, 32);
                if (fq == 0) SSQ[(size_t)tok * 4 + wc] = ss; });
        } else if (pn == 3) {
            bf16_t* QI = (bf16_t*)(ws + OFF_QI);
            epi_rows(row0, [&](int ai, int m, int tok) {
#pragma unroll
                for (int bj = 0; bj < 2; ++bj) *(u32x4*)(QI + (size_t)tok * 256 + bj * 128 + cw) = pack8(acc[ai][bj][m][0] * W8_INV, acc[ai][bj][m][1] * W8_INV); });
        } else if (pn == 4) {
            bf16_t* KI = (bf16_t*)(ws + OFF_KI); float* WI = (float*)(ws + OFF_WI);
            epi_rows(row0, [&](int ai, int m, int tok) { if (cw < 64) *(u32x4*)(KI + (size_t)tok * 64 + cw) = pack8(acc[ai][0][m][0] * W8_INV, acc[ai][0][m][1] * W8_INV);
                       else if (cw == 64) *(f32x4*)(WI + (size_t)tok * 4) = acc[ai][0][m][0] * W8_INV; });
        } else if (pn < 14) {
            const int t9 = pn - 5, qkv = t9 / 3, g = t9 % 3, r = dil_r(g), ls = SEQ / r;
            unsigned char* base = (unsigned char*)(ws + OFF_DIL) + (size_t)qkv * DIL_SZ; const float sc = (qkv == 0 ? QSCALE : 1.0f) * W8_INV * D8_SCALE;
            epi_rows(row0, [&](int ai, int m, int tok) { const int b = tok >> 11, s = tok & 2047, pp = (s % r) * ls + s / r;
#pragma unroll
                for (int bj = 0; bj < 2; ++bj) { const int col = bj * 128 + cw, j = col >> 6, d = col & 63;
                    const f32x4 a = acc[ai][bj][m][0] * sc, c = acc[ai][bj][m][1] * sc; u32x2 w; w.x = pk4_fp8(a[0], a[1], a[2], a[3]); w.y = pk4_fp8(c[0], c[1], c[2], c[3]);
                    *(u32x2*)(base + (((size_t)(g * 4 + j) * BATCH + b) * SEQ + pp) * 64 + d) = w; } });
        } else {
            unsigned char* G = (unsigned char*)(ws + OFF_G);
            epi_rows(row0, [&](int ai, int m, int tok) {
#pragma unroll
                for (int bj = 0; bj < 2; ++bj) { f32x4 a = acc[ai][bj][m][0], b = acc[ai][bj][m][1];
#pragma unroll
                    for (int q = 0; q < 4; ++q) { a[q] = fast_sigmoid(a[q] * W8_INV) * 255.0f; b[q] = fast_sigmoid(b[q] * W8_INV) * 255.0f; }
                    u32x2 w; w.x = pk4_u8(a[0], a[1], a[2], a[3]); w.y = pk4_u8(b[0], b[1], b[2], b[3]);
                    *(u32x2*)(G + (size_t)tok * 2048 + (pn - 14) * 256 + bj * 128 + cw) = w; } });
        }
    }
};
struct EpiKV {
    static constexpr bool PERM = true; char* ws;
    __device__ __forceinline__ void operator()(const f32x4 (&acc)[2][2][4][2], const pg::Unit& u, int wr, int wc, int fr, int fq) const {
        const int row0 = u.pm * 256 + wr * 64 + fr, pn = u.pn, cw = wc * 32 + 8 * fq;
        unsigned char* O = (unsigned char*)(ws + OFF_R1) + (size_t)(pn >> 1) * NTOK * 512; const float* SSQ = (const float*)(ws + OFF_SSQ);
        f32x4 sqv[2][4];
        epi_rows(row0, [&](int ai, int m, int tok) { sqv[ai][m] = *(const f32x4*)(SSQ + (size_t)tok * 4); });
        epi_rows(row0, [&](int ai, int m, int tok) { const int b = tok >> 11, s = tok & 2047; const f32x4 sq = sqv[ai][m]; const float rinv = rsqrtf(((sq[0] + sq[1]) + (sq[2] + sq[3])) * (1.0f / 256.0f) + RMS_EPS);
#pragma unroll
            for (int bj = 0; bj < 2; ++bj) { const int col = (pn & 1) * 256 + bj * 128 + cw, h = col >> 6, d = col & 63;
                const f32x4 a = acc[ai][bj][m][0] * (rinv * D8_SCALE), c = acc[ai][bj][m][1] * (rinv * D8_SCALE); u32x2 w; w.x = pk4_fp8(a[0], a[1], a[2], a[3]); w.y = pk4_fp8(c[0], c[1], c[2], c[3]);
                *(u32x2*)(O + ((size_t)(b * 8 + h) * SEQ + s) * 64 + d) = w; } });
    }
};
struct EpiMix2 {
    static constexpr bool PERM = true; char* ws;
    __device__ __forceinline__ void operator()(const f32x4 (&acc)[2][2][4][2], const pg::Unit& u, int wr, int wc, int fr, int fq) const {
        const int row0 = u.pm * 256 + wr * 64 + fr, col = u.pn * 128 + wc * 32 + 8 * fq;
        unsigned char* MIX = (unsigned char*)(ws + OFF_MIX); const unsigned char* G = (const unsigned char*)(ws + OFF_G); constexpr float I255 = 1.0f / 255.0f;
        u32x2 gav[2][4], gbv[2][4];
        epi_rows(row0, [&](int ai, int m, int tok) { gav[ai][m] = *(const u32x2*)(G + (size_t)tok * 2048 + col); gbv[ai][m] = *(const u32x2*)(G + (size_t)tok * 2048 + 1024 + col); });
        epi_rows(row0, [&](int ai, int m, int tok) {
            const u32x2 ga = gav[ai][m], gb = gbv[ai][m];
            f32x4 a = acc[ai][0][m][0], b = acc[ai][0][m][1]; const f32x4 c = acc[ai][1][m][0], d = acc[ai][1][m][1];
            a[0] = a[0] * (float)(ga.x & 255u) + c[0] * (float)(gb.x & 255u); a[1] = a[1] * (float)((ga.x >> 8) & 255u) + c[1] * (float)((gb.x >> 8) & 255u);
            a[2] = a[2] * (float)((ga.x >> 16) & 255u) + c[2] * (float)((gb.x >> 16) & 255u); a[3] = a[3] * (float)(ga.x >> 24) + c[3] * (float)(gb.x >> 24);
            b[0] = b[0] * (float)(ga.y & 255u) + d[0] * (float)(gb.y & 255u); b[1] = b[1] * (float)((ga.y >> 8) & 255u) + d[1] * (float)((gb.y >> 8) & 255u);
            b[2] = b[2] * (float)((ga.y >> 16) & 255u) + d[2] * (float)((gb.y >> 16) & 255u); b[3] = b[3] * (float)(ga.y >> 24) + d[3] * (float)(gb.y >> 24);
            a = a * (I255 * W8_INV / 16.0f); b = b * (I255 * W8_INV / 16.0f);
            u32x2 w; w.x = pk4_fp8(a[0], a[1], a[2], a[3]); w.y = pk4_fp8(b[0], b[1], b[2], b[3]);
            *(u32x2*)(MIX + (size_t)tok * 1024 + col) = w; });
    }
};
struct EpiOut {
    static constexpr bool PERM = true; char* ws; const float* x;
    __device__ __forceinline__ void operator()(const f32x4 (&acc)[2][2][4][2], const pg::Unit& u, int wr, int wc, int fr, int fq) const {
        const int row0 = u.pm * 256 + wr * 64 + fr, cw = wc * 32 + 8 * fq; bf16_t* D = (bf16_t*)(ws + OFF_H);
        epi_rows(row0, [&](int ai, int m, int tok) {
#pragma unroll
            for (int bj = 0; bj < 2; ++bj) *(u32x4*)(D + (size_t)tok * 1024 + u.pn * 256 + bj * 128 + cw) = pack8(acc[ai][bj][m][0] * W8_INV, acc[ai][bj][m][1] * W8_INV); });
    }
};
struct EpiGU {
    static constexpr bool PERM = true; char* ws;
    __device__ __forceinline__ void operator()(const f32x4 (&acc)[2][2][4][2], const pg::Unit& u, int wr, int wc, int fr, int fq) const {
        const int row0 = u.pm * 256 + wr * 64 + fr, cw = wc * 32 + 8 * fq; unsigned char* HID = (unsigned char*)(ws + OFF_HID);
        epi_rows(row0, [&](int ai, int m, int tok) { f32x4 a = acc[ai][0][m][0] * W8_INV, b = acc[ai][0][m][1] * W8_INV; const f32x4 ua = acc[ai][1][m][0] * W8_INV, ub = acc[ai][1][m][1] * W8_INV;
#pragma unroll
            for (int q = 0; q < 4; ++q) { a[q] = a[q] * fast_sigmoid(a[q]) * ua[q]; b[q] = b[q] * fast_sigmoid(b[q]) * ub[q]; }
            u32x2 w; w.x = pk4_fp8(a[0], a[1], a[2], a[3]); w.y = pk4_fp8(b[0], b[1], b[2], b[3]);
            *(u32x2*)(HID + (size_t)tok * 512 + (u.pn & 3) * 128 + cw) = w; });
    }
};
struct EpiDown {
    static constexpr bool PERM = true; char* ws;
    __device__ __forceinline__ void operator()(const f32x4 (&acc)[2][2][4][2], const pg::Unit& u, int wr, int wc, int fr, int fq) const {
        const int row0 = u.pm * 256 + wr * 64 + fr, cw = wc * 32 + 8 * fq; unsigned char* EO = (unsigned char*)(ws + OFF_EO);
        epi_rows(row0, [&](int ai, int m, int tok) {
#pragma unroll
            for (int bj = 0; bj < 2; ++bj) { const f32x4 a = acc[ai][bj][m][0] * W8_INV, b = acc[ai][bj][m][1] * W8_INV; u32x2 w; w.x = pk4_fp8(a[0], a[1], a[2], a[3]); w.y = pk4_fp8(b[0], b[1], b[2], b[3]);
                *(u32x2*)(EO + (size_t)tok * 1024 + (u.pn & 3) * 256 + bj * 128 + cw) = w; } });
    }
};

DEVI void phase_proj(const Params& p, LAS3 unsigned char* lds) {
    pg::StaticOrder S; S.init(NTOK, 5632, gridDim.x, blockIdx.x);
    pg::gemm_phase<EpiProj, pg::StaticOrder, false, true>(lds, pg::Gemm{(const bf16_t*)(p.ws + OFF_U8), (const bf16_t*)(p.ws + OFF_WT8), 1024, nullptr}, S, EpiProj{p.ws});
}
DEVI void phase_kv(const Params& p, LAS3 unsigned char* lds) {
    pg::StaticOrder S; S.init(NTOK, 1024, gridDim.x, blockIdx.x);
    pg::gemm_phase<EpiKV, pg::StaticOrder, false>(lds, pg::Gemm{(const bf16_t*)(p.ws + OFF_CR), (const bf16_t*)(p.ws + OFF_WKV), 256, nullptr}, S, EpiKV{p.ws});
}
DEVI void phase_mix(const Params& p, LAS3 unsigned char* lds) {
    pg::RowOrder S{NTOK / 256, 8, (int)gridDim.x, (int)blockIdx.x};
    pg::gemm_phase<EpiMix2, pg::RowOrder, false, true, 4>(lds, pg::Gemm{(const bf16_t*)(p.ws + OFF_YA), (const bf16_t*)(p.ws + OFF_WAB), YAB_LD, nullptr}, S, EpiMix2{p.ws});
}
DEVI void phase_out(const Params& p, LAS3 unsigned char* lds) {
    pg::RowOrder S{NTOK / 256, 4, (int)gridDim.x, (int)blockIdx.x};
    pg::gemm_phase<EpiOut, pg::RowOrder, false, true>(lds, pg::Gemm{(const bf16_t*)(p.ws + OFF_MIX), (const bf16_t*)(p.ws + OFF_WOT), 1024, nullptr}, S, EpiOut{p.ws, p.x});
}

DEVI void build_expert_tables(const Params& p, LAS3 unsigned char* lds) {
    LAS3 int* tb = (LAS3 int*)(lds + LDS_TAB); LAS3 int* cnt = tb + 64;
    if (opaque_tid() < 64) {
        const int lane = opaque_tid(); const int c = lane < 32 ? __hip_atomic_load((const int*)(p.ws + OFF_ECNT) + lane, __ATOMIC_RELAXED, __HIP_MEMORY_SCOPE_AGENT) : 0;
        int t = (c + 255) >> 8, incl = t;
#pragma unroll
        for (int o = 1; o < 32; o <<= 1) { const int v = __shfl_up(incl, o); if (lane >= o) incl += v; }
        if (lane < 32) { cnt[lane] = c; tb[lane + 1] = incl; }
        if (lane == 0) tb[0] = 0;
    }
    __syncthreads();
}
DEVI void phase_gu(const Params& p, LAS3 unsigned char* lds) {
    pg::GroupedOrder S; S.tb = (const LAS3 int*)(lds + LDS_TAB); S.cnt = S.tb + 64; S.G = gridDim.x; S.c = blockIdx.x;
    pg::gemm_phase<EpiGU, pg::GroupedOrder, true, true>(lds, pg::Gemm{(const bf16_t*)(p.ws + OFF_TT), (const bf16_t*)(p.ws + OFF_WEXP), 1024, (const int*)(p.ws + OFF_LIST)}, S, EpiGU{p.ws});
}
DEVI void phase_down(const Params& p, LAS3 unsigned char* lds) {
    pg::GroupedOrder S; S.tb = (const LAS3 int*)(lds + LDS_TAB); S.cnt = S.tb + 64; S.G = gridDim.x; S.c = blockIdx.x;
    pg::gemm_phase<EpiDown, pg::GroupedOrder, false, true>(lds, pg::Gemm{(const bf16_t*)(p.ws + OFF_HID), (const bf16_t*)(p.ws + OFF_WDN), 512, nullptr}, S, EpiDown{p.ws});
}

constexpr int LDS_RW   = 0;
constexpr int LDS_LG   = 147456;
constexpr int LDS_LC   = LDS_LG + 8 * 8 * 37 * 4;
constexpr int LDS_RTK  = LDS_LC + 256;
static_assert(LDS_RTK + 256 * 6 * 4 <= LDS_XB, "route phase LDS overflow");
DEVI void phase_route(const Params& p, LAS3 unsigned char* lds) {
    const int tid = opaque_tid(), lane = tid & 63, wv = tid >> 6, G = gridDim.x;
    LAS3 float* rw = (LAS3 float*)(lds + LDS_RW); LAS3 float* lg = (LAS3 float*)(lds + LDS_LG) + wv * 8 * 37;
    LAS3 int* lcnt = (LAS3 int*)(lds + LDS_LC); LAS3 int* gbase = lcnt + 32; LAS3 unsigned* rtk = (LAS3 unsigned*)(lds + LDS_RTK);
    for (int k = tid; k < 1024; k += 512) { const f32x4 v = *(const f32x4*)(p.w_rg + (size_t)k * 4); rw[k] = v[0]; rw[1024 + k] = v[1]; rw[2048 + k] = v[2]; rw[3072 + k] = v[3]; }
#pragma unroll 1
    for (int base = 0; base < 8192; base += 4096) {
        f32x4 t[8];
#pragma unroll
        for (int j = 0; j < 8; ++j) t[j] = *(const f32x4*)(p.w_re + (size_t)(base + j * 512 + tid) * 4);
#pragma unroll
        for (int j = 0; j < 8; ++j) { const int idx = base + j * 512 + tid, row = idx >> 1, g = row >> 10, k = row & 1023, o0 = 4 + g * 8 + (idx & 1) * 4;
#pragma unroll
            for (int e = 0; e < 4; ++e) rw[(o0 + e) * 1024 + k] = t[j][e]; }
    }
    if (tid < 32) lcnt[tid] = 0;
    f32x4 gn[4];
#pragma unroll
    for (int q = 0; q < 4; ++q) gn[q] = *(const f32x4*)(p.ffn_norm + q * 256 + 4 * lane);
    __syncthreads();
    const bf16_t* H = (const bf16_t*)(p.ws + OFF_H); bf16_t* Hw = (bf16_t*)(p.ws + OFF_H); unsigned char* TT = (unsigned char*)(p.ws + OFF_TT);
    for (int chunk = blockIdx.x; chunk < NTOK / 256; chunk += G) {
        const int tokw = chunk * 256 + wv * 32;
        f32x4 nxv[4]; u32x2 ndv[4];
#pragma unroll
        for (int q = 0; q < 4; ++q) { nxv[q] = *(const f32x4*)(p.x + (size_t)tokw * 1024 + q * 256 + 4 * lane); ndv[q] = *(const u32x2*)(H + (size_t)tokw * 1024 + q * 256 + 4 * lane); }
#pragma unroll 1
        for (int sub = 0; sub < 4; ++sub) {
#pragma unroll 1
            for (int tk = 0; tk < 8; ++tk) {
                const int tok = tokw + sub * 8 + tk;
                f32x4 v[4]; float ss = 0.f; u32x2 dcur[4];
#pragma unroll
                for (int q = 0; q < 4; ++q) { v[q] = nxv[q]; dcur[q] = ndv[q]; }
                if (sub * 8 + tk < 31) {
#pragma unroll
                    for (int q = 0; q < 4; ++q) { nxv[q] = *(const f32x4*)(p.x + (size_t)(tok + 1) * 1024 + q * 256 + 4 * lane); ndv[q] = *(const u32x2*)(H + (size_t)(tok + 1) * 1024 + q * 256 + 4 * lane); }
                }
#pragma unroll
                for (int q = 0; q < 4; ++q) { const u32x2 dd = dcur[q];
                    v[q][0] += bflo(dd.x); v[q][1] += bfhi(dd.x); v[q][2] += bflo(dd.y); v[q][3] += bfhi(dd.y); ss += v[q][0] * v[q][0] + v[q][1] * v[q][1] + v[q][2] * v[q][2] + v[q][3] * v[q][3];
                    u32x2 hh; hh.x = cvt_pk_bf16(v[q][0], v[q][1]); hh.y = cvt_pk_bf16(v[q][2], v[q][3]); *(u32x2*)(Hw + (size_t)tok * 1024 + q * 256 + 4 * lane) = hh; }
#pragma unroll
                for (int o = 32; o > 0; o >>= 1) ss += __shfl_xor(ss, o);
                const float rinv = rsqrtf(ss * (1.0f / 1024.0f) + RMS_EPS);
#pragma unroll
                for (int q = 0; q < 4; ++q) { v[q] = v[q] * rinv * gn[q]; *(unsigned*)(TT + (size_t)tok * 1024 + q * 256 + 4 * lane) = pk4_fp8(v[q][0], v[q][1], v[q][2], v[q][3]); }
                float a[36];
#pragma unroll
                for (int o = 0; o < 36; ++o) { float s = 0.f;
#pragma unroll
                    for (int q = 0; q < 4; ++q) { const f32x4 w = *(const LAS3 f32x4*)(rw + o * 1024 + q * 256 + 4 * lane); s += v[q][0] * w[0] + v[q][1] * w[1] + v[q][2] * w[2] + v[q][3] * w[3]; }
                    a[o] = s; }
#pragma unroll
                for (int st = 0; st < 5; ++st) { const int msk = 32 >> st, half = 16 >> st; const bool up = (lane & msk) != 0;
#pragma unroll
                    for (int i = 0; i < half; ++i) { const float lo = a[i], hi = a[i + half]; const float send = up ? lo : hi, keep = up ? hi : lo; a[i] = keep + __shfl_xor(send, msk); } }
                a[0] += __shfl_xor(a[0], 1);
#pragma unroll
                for (int e = 32; e < 36; ++e) {
#pragma unroll
                    for (int o = 32; o > 0; o >>= 1) a[e] += __shfl_xor(a[e], o); }
                if ((lane & 1) == 0) lg[tk * 37 + (lane >> 1)] = a[0];
                if (lane < 4) lg[tk * 37 + 32 + lane] = lane == 0 ? a[32] : (lane == 1 ? a[33] : (lane == 2 ? a[34] : a[35]));
            }
            asm volatile("s_waitcnt lgkmcnt(0)" ::: "memory");
            if (lane < 8) {
                const LAS3 float* l = lg + lane * 37; float gl[4];
#pragma unroll
                for (int g = 0; g < 4; ++g) gl[g] = l[g] + p.b_rg[g];
                int gs = 0;
#pragma unroll
                for (int g = 1; g < 4; ++g) if (gl[g] > gl[gs]) gs = g;
                float den = 0.f;
#pragma unroll
                for (int g = 0; g < 4; ++g) den += expf(gl[g] - gl[gs]);
                const float pg_ = 1.0f / den; float el[8];
#pragma unroll
                for (int e = 0; e < 8; ++e) el[e] = l[4 + gs * 8 + e] + p.b_re[gs * 8 + e];
                int i0 = 0;
#pragma unroll
                for (int e = 1; e < 8; ++e) if (el[e] > el[i0]) i0 = e;
                int i1 = i0 == 0 ? 1 : 0;
#pragma unroll
                for (int e = 0; e < 8; ++e) if (e != i0 && el[e] > el[i1]) i1 = e;
                const float e1 = expf(el[i1] - el[i0]), w0 = pg_ / (1.0f + e1), w1 = pg_ * e1 / (1.0f + e1);
                const int E0 = gs * 8 + i0, E1 = gs * 8 + i1;
                const int s0 = __hip_atomic_fetch_add(lcnt + E0, 1, __ATOMIC_RELAXED, __HIP_MEMORY_SCOPE_WORKGROUP), s1 = __hip_atomic_fetch_add(lcnt + E1, 1, __ATOMIC_RELAXED, __HIP_MEMORY_SCOPE_WORKGROUP);
                LAS3 unsigned* r = rtk + (wv * 32 + sub * 8 + lane) * 6;
                r[0] = (unsigned)E0; r[1] = (unsigned)s0; r[2] = __float_as_uint(w0); r[3] = (unsigned)E1; r[4] = (unsigned)s1; r[5] = __float_as_uint(w1);
            }
        }
        __syncthreads();
        if (tid < 32) { const int n = lcnt[tid]; gbase[tid] = n ? atomicAdd((int*)(p.ws + OFF_ECNT) + tid, n) : 0; lcnt[tid] = 0; }
        __syncthreads();
        if (tid < 256) {
            const int tok = chunk * 256 + tid; const LAS3 unsigned* r = rtk + tid * 6;
            const int E0 = (int)r[0], E1 = (int)r[3], s0 = gbase[E0] + (int)r[1], s1 = gbase[E1] + (int)r[4];
            u32x4 w0; w0.x = (unsigned)E0; w0.y = (unsigned)s0; w0.z = r[2]; w0.w = 0u; u32x4 w1; w1.x = (unsigned)E1; w1.y = (unsigned)s1; w1.z = r[5]; w1.w = 0u;
            unsigned* RT = (unsigned*)(p.ws + OFF_RT) + (size_t)tok * 8; *(u32x4*)RT = w0; *(u32x4*)(RT + 4) = w1;
            int* LIST = (int*)(p.ws + OFF_LIST); LIST[(size_t)E0 * 65536 + s0] = tok; LIST[(size_t)E1 * 65536 + s1] = tok;
        }
        __syncthreads();
    }
}

DEVI void phase_final(const Params& p, LAS3 unsigned char* lds) {
    const LAS3 int* tb = (const LAS3 int*)(lds + LDS_TAB);
    const int lane = opaque_tid() & 63, wv = opaque_tid() >> 6, G = gridDim.x;
    f32x4 gn[4];
#pragma unroll
    for (int q = 0; q < 4; ++q) gn[q] = *(const f32x4*)(p.final_norm + q * 256 + 4 * lane);
    const bf16_t* H = (const bf16_t*)(p.ws + OFF_H); const unsigned char* EO = (const unsigned char*)(p.ws + OFF_EO); const unsigned* RT = (const unsigned*)(p.ws + OFF_RT);
    const int st = G * 8; int tok = blockIdx.x * 8 + wv;
    u32x4 ra[2], rb[2], na[2], nb[2]; u32x2 dv[2][4]; unsigned ea[2][4], eb[2][4];
#pragma unroll
    for (int k = 0; k < 2; ++k) { ra[k] = (u32x4){0, 0, 0, 0}; rb[k] = ra[k]; na[k] = ra[k]; nb[k] = ra[k]; }
#define FIN_LOADR(t_, a_, b_) do { a_ = *(const u32x4*)(RT + (size_t)(t_) * 8); b_ = *(const u32x4*)(RT + (size_t)(t_) * 8 + 4); } while (0)
#define FIN_LOADD(k_, t_, a_, b_) do { const size_t r0_ = (size_t)tb[a_.x] * 256 + a_.y, r1_ = (size_t)tb[b_.x] * 256 + b_.y; \
        _Pragma("unroll") for (int q = 0; q < 4; ++q) { dv[k_][q] = *(const u32x2*)(H + (size_t)(t_) * 1024 + q * 256 + 4 * lane); \
            ea[k_][q] = *(const unsigned*)(EO + r0_ * 1024 + q * 256 + 4 * lane); eb[k_][q] = *(const unsigned*)(EO + r1_ * 1024 + q * 256 + 4 * lane); } } while (0)
#pragma unroll
    for (int k = 0; k < 2; ++k) if (tok + k * st < NTOK) FIN_LOADR(tok + k * st, ra[k], rb[k]);
#pragma unroll
    for (int k = 0; k < 2; ++k) if (tok + k * st < NTOK) { FIN_LOADD(k, tok + k * st, ra[k], rb[k]); if (tok + (2 + k) * st < NTOK) FIN_LOADR(tok + (2 + k) * st, na[k], nb[k]); }
#pragma unroll 1
    for (; tok < NTOK; tok += 2 * st) {
        f32x4 v[2][4]; float ss[2];
#pragma unroll
        for (int k = 0; k < 2; ++k) {
            const float w0 = __uint_as_float(ra[k].z), w1 = __uint_as_float(rb[k].z); ss[k] = 0.f;
#pragma unroll
            for (int q = 0; q < 4; ++q) {
                const f32x2 a01 = __builtin_amdgcn_cvt_pk_f32_fp8(ea[k][q], false), a23 = __builtin_amdgcn_cvt_pk_f32_fp8(ea[k][q], true), b01 = __builtin_amdgcn_cvt_pk_f32_fp8(eb[k][q], false), b23 = __builtin_amdgcn_cvt_pk_f32_fp8(eb[k][q], true);
                v[k][q][0] = bflo(dv[k][q].x) + w0 * a01[0] + w1 * b01[0]; v[k][q][1] = bfhi(dv[k][q].x) + w0 * a01[1] + w1 * b01[1];
                v[k][q][2] = bflo(dv[k][q].y) + w0 * a23[0] + w1 * b23[0]; v[k][q][3] = bfhi(dv[k][q].y) + w0 * a23[1] + w1 * b23[1];
                ss[k] += v[k][q][0] * v[k][q][0] + v[k][q][1] * v[k][q][1] + v[k][q][2] * v[k][q][2] + v[k][q][3] * v[k][q][3];
            }
        }
#pragma unroll
        for (int k = 0; k < 2; ++k) if (tok + (2 + k) * st < NTOK) { ra[k] = na[k]; rb[k] = nb[k]; FIN_LOADD(k, tok + (2 + k) * st, ra[k], rb[k]); if (tok + (4 + k) * st < NTOK) FIN_LOADR(tok + (4 + k) * st, na[k], nb[k]); }
#pragma unroll
        for (int k = 0; k < 2; ++k) if (tok + k * st < NTOK) {
            float s1 = ss[k];
#pragma unroll
            for (int o = 32; o > 0; o >>= 1) s1 += __shfl_xor(s1, o);
            const float rinv = rsqrtf(s1 * (1.0f / 1024.0f) + RMS_EPS);
#pragma unroll
            for (int q = 0; q < 4; ++q) *(f32x4*)(p.out + (size_t)(tok + k * st) * 1024 + q * 256 + 4 * lane) = v[k][q] * rinv * gn[q];
        }
    }
#undef FIN_LOADR
#undef FIN_LOADD
}


typedef float f32x16 __attribute__((ext_vector_type(16)));
typedef short s16x4 __attribute__((ext_vector_type(4)));
#define MFMA32(a, b, c) __builtin_amdgcn_mfma_f32_32x32x16_bf16(a, b, c, 0, 0, 0)
#define MFMA16(a, b, c) __builtin_amdgcn_mfma_f32_16x16x32_bf16(a, b, c, 0, 0, 0)
constexpr float NEGB = -1e30f;
DEVI s16x4 vtr(const LAS3 unsigned char* p) { return __builtin_bit_cast(s16x4, __builtin_amdgcn_ds_read_tr16_b64_v4i16((LAS3 s16x4*)p)); }
DEVI float max3f(float a, float b, float c) { return __builtin_fmaxf(__builtin_fmaxf(a, b), c); }

constexpr int TK_STRIDE = 2052;
DEVI unsigned fkey(float f) { const unsigned u = __float_as_uint(f); return u ^ ((u >> 31) ? 0xFFFFFFFFu : 0x80000000u); }
DEVI int wave_sum_pair(int a, int b, int& sumb) {
    int v = a | (b << 16);
    v += __builtin_amdgcn_update_dpp(0, v, 0xB1, 0xF, 0xF, true);
    v += __builtin_amdgcn_update_dpp(0, v, 0x4E, 0xF, 0xF, true);
    v += __builtin_amdgcn_update_dpp(0, v, 0x141, 0xF, 0xF, true);
    v += __builtin_amdgcn_update_dpp(0, v, 0x140, 0xF, 0xF, true);
    const int t = __builtin_amdgcn_readlane(v, 0) + __builtin_amdgcn_readlane(v, 16) + __builtin_amdgcn_readlane(v, 32) + __builtin_amdgcn_readlane(v, 48);
    sumb = (int)((unsigned)t >> 16); return t & 0xFFFF;
}
DEVI void phase_topk(const Params& p, LAS3 unsigned char* lds) {
    LAS3 float* sc = (LAS3 float*)lds;
    const int tid = opaque_tid(), lane = tid & 63, wv = __builtin_amdgcn_readfirstlane(tid >> 6), r16 = lane & 15, g4 = lane >> 4;
    const bf16_t* QI = (const bf16_t*)(p.ws + OFF_QI); const bf16_t* KI = (const bf16_t*)(p.ws + OFF_KI); const float* WI = (const float*)(p.ws + OFF_WI);
    unsigned* SEL = (unsigned*)(p.ws + OFF_SEL);
#define TK_UNIT(u_, b_, t0_) do { b_ = (u_) >> 7; t0_ = ((((u_) & 127) + 8 * ((u_) >> 8)) & 127) * 16; } while (0)
#define TK_LOADQ(b_, t0_) do { const bf16_t* qrow = QI + (size_t)((b_) * SEQ + (t0_) + r16) * 256 + 8 * g4; \
        _Pragma("unroll") for (int h = 0; h < 4; ++h) { qf[h][0] = *(const bf16x8*)(qrow + h * 64); qf[h][1] = *(const bf16x8*)(qrow + h * 64 + 32); } \
        w4 = *(const f32x4*)(WI + (size_t)((b_) * SEQ + (t0_) + r16) * 4); } while (0)
#define TK_LOADK(dst, kb_, gi_) do { const bf16_t* kp_ = (kb_) + (size_t)(gi_) * 4096; \
        _Pragma("unroll") for (int j = 0; j < 4; ++j) { dst[j][0] = *(const bf16x8*)(kp_ + j * 1024); dst[j][1] = *(const bf16x8*)(kp_ + j * 1024 + 32); } } while (0)
    bf16x8 qf[4][2]; f32x4 w4; bf16x8 kf[4][2];
    int u = blockIdx.x, b = 0, t0 = 0;
    if (u < NTOK / 16) { TK_UNIT(u, b, t0); TK_LOADQ(b, t0); if (wv * 64 < t0 + 16) TK_LOADK(kf, KI + (size_t)(b * SEQ + r16) * 64 + 8 * g4, wv); }
    for (; u < NTOK / 16; u += gridDim.x) {
        const int tokb = b * SEQ, nkey = t0 + 16;
        const bf16_t* kbase = KI + (size_t)(tokb + r16) * 64 + 8 * g4;
        const float wq[4] = {w4[0], w4[1], w4[2], w4[3]};
#pragma unroll 1
        for (int gi = wv; gi * 64 < nkey; gi += 8) {
            bf16x8 cf[4][2];
#pragma unroll
            for (int j = 0; j < 4; ++j) { cf[j][0] = kf[j][0]; cf[j][1] = kf[j][1]; }
            if ((gi + 8) * 64 < nkey) TK_LOADK(kf, kbase, gi + 8);
#pragma unroll
            for (int j = 0; j < 4; ++j) {
                f32x4 s = (f32x4){0.f, 0.f, 0.f, 0.f};
#pragma unroll
                for (int h = 0; h < 4; ++h) { f32x4 a = (f32x4){0.f, 0.f, 0.f, 0.f}; a = MFMA16(cf[j][0], qf[h][0], a); a = MFMA16(cf[j][1], qf[h][1], a);
#pragma unroll
                    for (int e = 0; e < 4; ++e) s[e] += wq[h] * __builtin_fmaxf(a[e], 0.f); }
#pragma unroll
                for (int e = 0; e < 4; ++e) s[e] = (s[e] == 0.f) ? 0.f : s[e];
                *(LAS3 f32x4*)(sc + r16 * TK_STRIDE + gi * 64 + j * 16 + 4 * g4) = s;
            }
        }
        const int un = u + gridDim.x; int bn = 0, t0n = 0;
        if (un < NTOK / 16) { TK_UNIT(un, bn, t0n); TK_LOADQ(bn, t0n); if (wv * 64 < t0n + 16) TK_LOADK(kf, KI + (size_t)(bn * SEQ + r16) * 64 + 8 * g4, wv); }
        __syncthreads();
#pragma unroll 1
        for (int qq = 0; qq < 2; ++qq) {
            const int q = 2 * wv + qq, t = t0 + q, n = t + 1; const LAS3 float* row = sc + q * TK_STRIDE;
            const int nv = (n - lane + 63) >> 6; const unsigned valid = nv >= 32 ? 0xFFFFFFFFu : (nv <= 0 ? 0u : ((1u << nv) - 1u));
            unsigned sel = valid;
            if (n > 256) {
                unsigned a[32];
#pragma unroll
                for (int i = 0; i < 32; ++i) a[i] = __float_as_uint(row[i * 64 + lane]);
#pragma unroll
                for (int k = 0; k < 16; ++k) { const unsigned x = a[k], y = a[k + 16]; a[k] = __builtin_amdgcn_perm(y, x, 0x05040100u); a[k + 16] = __builtin_amdgcn_perm(y, x, 0x07060302u); }
#pragma unroll
                for (int k = 0; k < 32; ++k) if (!(k & 8)) { const unsigned x = a[k], y = a[k + 8]; a[k] = __builtin_amdgcn_perm(y, x, 0x06020400u); a[k + 8] = __builtin_amdgcn_perm(y, x, 0x07030501u); }
#pragma unroll
                for (int k = 0; k < 32; ++k) if (!(k & 4)) { const unsigned x = a[k], y = a[k + 4]; a[k] = (x & 0x0F0F0F0Fu) | ((y << 4) & 0xF0F0F0F0u); a[k + 4] = ((x >> 4) & 0x0F0F0F0Fu) | (y & 0xF0F0F0F0u); }
#pragma unroll
                for (int k = 0; k < 32; ++k) if (!(k & 2)) { const unsigned x = a[k], y = a[k + 2]; a[k] = (x & 0x33333333u) | ((y << 2) & 0xCCCCCCCCu); a[k + 2] = ((x >> 2) & 0x33333333u) | (y & 0xCCCCCCCCu); }
#pragma unroll
                for (int k = 0; k < 32; ++k) if (!(k & 1)) { const unsigned x = a[k], y = a[k + 1]; a[k] = (x & 0x55555555u) | ((y << 1) & 0xAAAAAAAAu); a[k + 1] = ((x >> 1) & 0x55555555u) | (y & 0xAAAAAAAAu); }
                { const unsigned sg = a[31];
#pragma unroll
                  for (int bb = 0; bb < 31; ++bb) a[bb] ^= sg;
                  a[31] = ~sg; }
                unsigned alive = valid, gt = 0u; int above = 0; bool exact = false;
#pragma unroll
                for (int bb = 31; bb >= 0; --bb) {
                    if (!exact) {
                        const unsigned ones = alive & a[bb];
                        int dummy; const int c = wave_sum_pair(__builtin_popcount(ones), 0, dummy);
                        if (above + c >= 256) { alive = ones; if (above + c == 256) exact = true; }
                        else { above += c; gt |= ones; alive &= ~a[bb]; }
                    }
                }
                sel = gt | alive;
                if (!exact) {
                    int need = 256 - above; unsigned tsel = 0u;
#pragma unroll 1
                    for (int i = 0; i < 32 && need > 0; ++i) {
                        unsigned long long m = __ballot((alive >> i) & 1u); const int c = __builtin_popcountll(m);
                        if (c <= need) { need -= c; }
                        else { unsigned long long keep = 0ull; for (int k2 = 0; k2 < need; ++k2) { const unsigned long long low = m & (~m + 1ull); keep |= low; m ^= low; } m = keep; need = 0; }
                        if ((m >> lane) & 1ull) tsel |= 1u << i;
                    }
                    sel = gt | tsel;
                }
            }
            unsigned long long mine = 0ull;
#pragma unroll
            for (int i = 0; i < 32; ++i) { const unsigned long long m = __ballot((sel >> i) & 1u); mine = (lane == i) ? m : mine; }
            if (lane < 32) *(unsigned long long*)(SEL + (size_t)(tokb + t) * 64 + 2 * lane) = mine;
        }
        __syncthreads();
        b = bn; t0 = t0n;
    }
#undef TK_UNIT
#undef TK_LOADQ
#undef TK_LOADK
}

struct AttnState { f32x16 o0, o1; float m, l, mx; };
struct AttnState8 { f32x16 o0, o1, ol; float m, mx, l; };
DEVI int crow16(int r) { return (r & 3) + 8 * (r >> 2); }
typedef __bf16 bf16x2v __attribute__((ext_vector_type(2)));
#define BFE1(w_, P_) ({ unsigned r_; asm("v_bfe_i32 %0, %1, " #P_ ", 1" : "=v"(r_) : "v"(w_)); r_; })
template <bool TAB4>
DEVI void attn_tile(AttnState& st, bool& zref, const bf16x8 (&qr)[4], const LAS3 unsigned char* kp  , const LAS3 unsigned char* vp  ,
                    const LAS3 float* tq, unsigned w0, unsigned w1  ) {
    f32x16 s0, s1;
    if constexpr (TAB4) {
#pragma unroll
        for (int g = 0; g < 4; ++g) { const f32x4 a = *(const LAS3 f32x4*)(tq + 8 * g), b = *(const LAS3 f32x4*)(tq + 32 + 8 * g);
#pragma unroll
            for (int e = 0; e < 4; ++e) { s0[4 * g + e] = a[e]; s1[4 * g + e] = b[e]; } }
    } else {
#pragma unroll
        for (int r = 0; r < 16; ++r) { s0[r] = tq[63 - crow16(r)]; s1[r] = tq[31 - crow16(r)]; }
    }
    bf16x8 kf[8];
#pragma unroll
    for (int d0 = 0; d0 < 4; ++d0) { kf[2 * d0] = *(const LAS3 bf16x8*)(kp + d0 * 2048); kf[2 * d0 + 1] = *(const LAS3 bf16x8*)(kp + d0 * 2048 + 512); }
#pragma unroll
    for (int d0 = 0; d0 < 4; ++d0) { s0 = MFMA32(kf[2 * d0], qr[d0], s0); s1 = MFMA32(kf[2 * d0 + 1], qr[d0], s1); }
    s16x4 vq[16];
#pragma unroll
    for (int s = 0; s < 4; ++s) { vq[4 * s] = vtr(vp + s * 1024); vq[4 * s + 1] = vtr(vp + s * 1024 + 512); vq[4 * s + 2] = vtr(vp + 4096 + s * 1024); vq[4 * s + 3] = vtr(vp + 4096 + s * 1024 + 512); }
    float mx = max3f(s0[0], s0[1], s1[0]);
#pragma unroll
    for (int r = 1; r < 16; r += 2) mx = max3f(mx, s0[r], r + 1 < 16 ? s0[r + 1] : s0[r]);
#pragma unroll
    for (int r = 1; r < 16; r += 2) mx = max3f(mx, s1[r], r + 1 < 16 ? s1[r + 1] : s1[r]);
    { auto rr = __builtin_amdgcn_permlane32_swap(__float_as_uint(mx), __float_as_uint(mx), false, false); mx = __builtin_fmaxf(__uint_as_float(rr[0]), __uint_as_float(rr[1])); }
    const float runmx = __builtin_fmaxf(st.mx, mx), refm = st.m, dlt = runmx - refm; st.mx = runmx;
    float mref = refm;
    if (__any(dlt > 40.f || (dlt < -80.f && runmx > -1e29f))) {
        const bool mv = dlt > 40.f || (dlt < -80.f && runmx > -1e29f); const float alpha = mv ? __builtin_amdgcn_exp2f(refm - runmx) : 1.0f;
        mref = mv ? runmx : refm; st.m = mref; st.l *= alpha; zref = false;
#pragma unroll
        for (int r = 0; r < 16; ++r) { st.o0[r] *= alpha; st.o1[r] *= alpha; }
    }
    if (zref) {
#pragma unroll
        for (int r = 0; r < 16; ++r) { s0[r] = __builtin_amdgcn_exp2f(s0[r]); s1[r] = __builtin_amdgcn_exp2f(s1[r]); }
    } else {
#pragma unroll
        for (int r = 0; r < 16; ++r) { s0[r] = __builtin_amdgcn_exp2f(s0[r] - mref); s1[r] = __builtin_amdgcn_exp2f(s1[r] - mref); }
    }
#define MSK1(S_, r_, w_, P_) S_[r_] = __uint_as_float(__float_as_uint(S_[r_]) & BFE1(w_, P_))
    MSK1(s0, 0, w0, 0); MSK1(s0, 1, w0, 1); MSK1(s0, 2, w0, 2); MSK1(s0, 3, w0, 3); MSK1(s0, 4, w0, 8); MSK1(s0, 5, w0, 9); MSK1(s0, 6, w0, 10); MSK1(s0, 7, w0, 11); MSK1(s0, 8, w0, 16); MSK1(s0, 9, w0, 17); MSK1(s0, 10, w0, 18); MSK1(s0, 11, w0, 19); MSK1(s0, 12, w0, 24); MSK1(s0, 13, w0, 25); MSK1(s0, 14, w0, 26); MSK1(s0, 15, w0, 27);
    MSK1(s1, 0, w1, 0); MSK1(s1, 1, w1, 1); MSK1(s1, 2, w1, 2); MSK1(s1, 3, w1, 3); MSK1(s1, 4, w1, 8); MSK1(s1, 5, w1, 9); MSK1(s1, 6, w1, 10); MSK1(s1, 7, w1, 11); MSK1(s1, 8, w1, 16); MSK1(s1, 9, w1, 17); MSK1(s1, 10, w1, 18); MSK1(s1, 11, w1, 19); MSK1(s1, 12, w1, 24); MSK1(s1, 13, w1, 25); MSK1(s1, 14, w1, 26); MSK1(s1, 15, w1, 27);
#undef MSK1
    u32x4 pw[4];
#pragma unroll
    for (int q = 0; q < 4; ++q) { pw[0][q] = cvt_pk_bf16(s0[2 * q], s0[2 * q + 1]); pw[1][q] = cvt_pk_bf16(s0[8 + 2 * q], s0[8 + 2 * q + 1]);
                                  pw[2][q] = cvt_pk_bf16(s1[2 * q], s1[2 * q + 1]); pw[3][q] = cvt_pk_bf16(s1[8 + 2 * q], s1[8 + 2 * q + 1]); }
    { float l0 = st.l, l1 = 0.f, l2 = 0.f, l3 = 0.f;
#pragma unroll
      for (int r = 0; r < 16; r += 2) { l0 = fadd1(l0, s0[r]); l1 = fadd1(l1, s0[r + 1]); l2 = fadd1(l2, s1[r]); l3 = fadd1(l3, s1[r + 1]); }
      st.l = fadd1(fadd1(l0, l1), fadd1(l2, l3)); }
#pragma unroll
    for (int s = 0; s < 4; ++s) {
        const s16x4 a0 = vq[4 * s], a1 = vq[4 * s + 1], c0 = vq[4 * s + 2], c1 = vq[4 * s + 3];
        const bf16x8 v0 = (bf16x8){a0[0], a0[1], a0[2], a0[3], a1[0], a1[1], a1[2], a1[3]}, v1 = (bf16x8){c0[0], c0[1], c0[2], c0[3], c1[0], c1[1], c1[2], c1[3]};
        const bf16x8 pf = __builtin_bit_cast(bf16x8, pw[s]);
        st.o0 = MFMA32(v0, pf, st.o0); st.o1 = MFMA32(v1, pf, st.o1);
    }
}
template <bool TAB4, int MASK = 2, bool OLM = true>
DEVI void attn_tile8(AttnState8& st, bool& zref, const pg::v8i_t& q8, const LAS3 unsigned char* kp  , const LAS3 unsigned char* vp  ,
                    const LAS3 float* tq, unsigned w0, unsigned w1  , const LAS3 unsigned char* lut = nullptr) {
    f32x16 s0, s1;
    if constexpr (TAB4) {
#pragma unroll
        for (int g = 0; g < 4; ++g) { const f32x4 a = *(const LAS3 f32x4*)(tq + 8 * g), b = *(const LAS3 f32x4*)(tq + 32 + 8 * g);
#pragma unroll
            for (int e = 0; e < 4; ++e) { s0[4 * g + e] = a[e]; s1[4 * g + e] = b[e]; } }
    } else {
#pragma unroll
        for (int r = 0; r < 16; ++r) { s0[r] = tq[63 - crow16(r)]; s1[r] = tq[31 - crow16(r)]; }
    }
    pg::v8i_t kA, kB;
    kA.lo = *(const LAS3 pg::v4i_t*)kp; kA.hi = *(const LAS3 pg::v4i_t*)(kp + 1024); kB.lo = *(const LAS3 pg::v4i_t*)(kp + 512); kB.hi = *(const LAS3 pg::v4i_t*)(kp + 1024 + 512);
    s0 = __builtin_amdgcn_mfma_scale_f32_32x32x64_f8f6f4(kA, q8, s0, 0, 0, 0, 0x7C7C7C7C, 0, 0x7C7C7C7C);
    s1 = __builtin_amdgcn_mfma_scale_f32_32x32x64_f8f6f4(kB, q8, s1, 0, 0, 0, 0x7C7C7C7C, 0, 0x7C7C7C7C);
    s16x4 vq[16];
#pragma unroll
    for (int s = 0; s < 4; ++s) { vq[4 * s] = vtr(vp + s * 1024); vq[4 * s + 1] = vtr(vp + s * 1024 + 512); vq[4 * s + 2] = vtr(vp + 4096 + s * 1024); vq[4 * s + 3] = vtr(vp + 4096 + s * 1024 + 512); }
    u32x2 pm[8];
    if constexpr (MASK == 2) {
#pragma unroll
        for (int j = 0; j < 4; ++j) { pm[j] = *(const LAS3 u32x2*)(lut + ((w0 >> (8 * j)) & 0xFFu) * 8); pm[4 + j] = *(const LAS3 u32x2*)(lut + ((w1 >> (8 * j)) & 0xFFu) * 8); }
    }
    float mx = max3f(s0[0], s0[1], s1[0]);
#pragma unroll
    for (int r = 1; r < 16; r += 2) mx = max3f(mx, s0[r], r + 1 < 16 ? s0[r + 1] : s0[r]);
#pragma unroll
    for (int r = 1; r < 16; r += 2) mx = max3f(mx, s1[r], r + 1 < 16 ? s1[r + 1] : s1[r]);
    { auto rr = __builtin_amdgcn_permlane32_swap(__float_as_uint(mx), __float_as_uint(mx), false, false); mx = __builtin_fmaxf(__uint_as_float(rr[0]), __uint_as_float(rr[1])); }
    const float runmx = __builtin_fmaxf(st.mx, mx), refm = st.m, dlt = runmx - refm; st.mx = runmx;
    float mref = refm;
    if (__any(dlt > 40.f || (dlt < -80.f && runmx > -1e29f))) {
        const bool mv = dlt > 40.f || (dlt < -80.f && runmx > -1e29f); const float alpha = mv ? __builtin_amdgcn_exp2f(refm - runmx) : 1.0f;
        mref = mv ? runmx : refm; st.m = mref; zref = false;
#pragma unroll
        for (int r = 0; r < 16; ++r) { st.o0[r] *= alpha; st.o1[r] *= alpha; if constexpr (OLM) st.ol[r] *= alpha; }
        if constexpr (!OLM) st.l *= alpha;
    }
    if (zref) {
#pragma unroll
        for (int r = 0; r < 16; ++r) { s0[r] = __builtin_amdgcn_exp2f(s0[r]); s1[r] = __builtin_amdgcn_exp2f(s1[r]); }
    } else {
#pragma unroll
        for (int r = 0; r < 16; ++r) { s0[r] = __builtin_amdgcn_exp2f(s0[r] - mref); s1[r] = __builtin_amdgcn_exp2f(s1[r] - mref); }
    }
#define MSK1(S_, r_, w_, P_) S_[r_] = __uint_as_float(__float_as_uint(S_[r_]) & BFE1(w_, P_))
    if constexpr (MASK == 1) {
    MSK1(s0, 0, w0, 0); MSK1(s0, 1, w0, 1); MSK1(s0, 2, w0, 2); MSK1(s0, 3, w0, 3); MSK1(s0, 4, w0, 8); MSK1(s0, 5, w0, 9); MSK1(s0, 6, w0, 10); MSK1(s0, 7, w0, 11); MSK1(s0, 8, w0, 16); MSK1(s0, 9, w0, 17); MSK1(s0, 10, w0, 18); MSK1(s0, 11, w0, 19); MSK1(s0, 12, w0, 24); MSK1(s0, 13, w0, 25); MSK1(s0, 14, w0, 26); MSK1(s0, 15, w0, 27);
    MSK1(s1, 0, w1, 0); MSK1(s1, 1, w1, 1); MSK1(s1, 2, w1, 2); MSK1(s1, 3, w1, 3); MSK1(s1, 4, w1, 8); MSK1(s1, 5, w1, 9); MSK1(s1, 6, w1, 10); MSK1(s1, 7, w1, 11); MSK1(s1, 8, w1, 16); MSK1(s1, 9, w1, 17); MSK1(s1, 10, w1, 18); MSK1(s1, 11, w1, 19); MSK1(s1, 12, w1, 24); MSK1(s1, 13, w1, 25); MSK1(s1, 14, w1, 26); MSK1(s1, 15, w1, 27);
    }
#undef MSK1
    u32x4 pw[4];
#pragma unroll
    for (int q = 0; q < 4; ++q) { pw[0][q] = cvt_pk_bf16(s0[2 * q], s0[2 * q + 1]); pw[1][q] = cvt_pk_bf16(s0[8 + 2 * q], s0[8 + 2 * q + 1]);
                                  pw[2][q] = cvt_pk_bf16(s1[2 * q], s1[2 * q + 1]); pw[3][q] = cvt_pk_bf16(s1[8 + 2 * q], s1[8 + 2 * q + 1]); }
    if constexpr (MASK == 2) {
#pragma unroll
        for (int t = 0; t < 4; ++t) { pw[t][0] &= pm[2 * t].x; pw[t][1] &= pm[2 * t].y; pw[t][2] &= pm[2 * t + 1].x; pw[t][3] &= pm[2 * t + 1].y; }
    }
    if constexpr (!OLM) { float l0 = st.l, l1 = 0.f, l2 = 0.f, l3 = 0.f;
#pragma unroll
      for (int r = 0; r < 16; r += 2) { l0 = fadd1(l0, s0[r]); l1 = fadd1(l1, s0[r + 1]); l2 = fadd1(l2, s1[r]); l3 = fadd1(l3, s1[r + 1]); }
      st.l = fadd1(fadd1(l0, l1), fadd1(l2, l3)); }
    const bf16x8 ones = (bf16x8){(short)0x3F80, (short)0x3F80, (short)0x3F80, (short)0x3F80, (short)0x3F80, (short)0x3F80, (short)0x3F80, (short)0x3F80};
#pragma unroll
    for (int s = 0; s < 4; ++s) {
        const s16x4 a0 = vq[4 * s], a1 = vq[4 * s + 1], c0 = vq[4 * s + 2], c1 = vq[4 * s + 3];
        const bf16x8 v0 = (bf16x8){a0[0], a0[1], a0[2], a0[3], a1[0], a1[1], a1[2], a1[3]}, v1 = (bf16x8){c0[0], c0[1], c0[2], c0[3], c1[0], c1[1], c1[2], c1[3]};
        const bf16x8 pf = __builtin_bit_cast(bf16x8, pw[s]);
        st.o0 = MFMA32(v0, pf, st.o0); st.o1 = MFMA32(v1, pf, st.o1); if constexpr (OLM) st.ol = MFMA32(ones, pf, st.ol);
    }
}
DEVI float attn_finish8l(AttnState8& st, float& lse2) {
    auto rr = __builtin_amdgcn_permlane32_swap(__float_as_uint(st.l), __float_as_uint(st.l), false, false);
    const float l = __uint_as_float(rr[0]) + __uint_as_float(rr[1]); lse2 = st.m + __builtin_amdgcn_logf(l);
    return __builtin_amdgcn_rcpf(l);
}
DEVI float attn_finish8(AttnState8& st, float& lse2) {
    const float l = st.ol[0]; lse2 = st.m + __builtin_amdgcn_logf(l);
    return __builtin_amdgcn_rcpf(l);
}
DEVI float attn_finish(AttnState& st, float& lse2) {
    auto rr = __builtin_amdgcn_permlane32_swap(__float_as_uint(st.l), __float_as_uint(st.l), false, false);
    const float l = __uint_as_float(rr[0]) + __uint_as_float(rr[1]); lse2 = st.m + __builtin_amdgcn_logf(l);
    return __builtin_amdgcn_rcpf(l);
}
template <class ST> DEVI void attn_store(const ST& st, float rl, bf16_t* rowp, int hi) {
#pragma unroll
    for (int g = 0; g < 4; ++g) {
        u32x2 a, b; a.x = cvt_pk_bf16(st.o0[4 * g] * rl, st.o0[4 * g + 1] * rl); a.y = cvt_pk_bf16(st.o0[4 * g + 2] * rl, st.o0[4 * g + 3] * rl);
        b.x = cvt_pk_bf16(st.o1[4 * g] * rl, st.o1[4 * g + 1] * rl); b.y = cvt_pk_bf16(st.o1[4 * g + 2] * rl, st.o1[4 * g + 3] * rl);
        *(u32x2*)(rowp + 8 * g + 4 * hi) = a; *(u32x2*)(rowp + 32 + 8 * g + 4 * hi) = b;
    }
}

constexpr float Y8_SCALE = 16.0f;
template <class ST> DEVI void attn_store8(const ST& st, float rl, unsigned char* rowp, int hi) {
    const float f = rl * Y8_SCALE;
#pragma unroll
    for (int g = 0; g < 4; ++g) {
        *(unsigned*)(rowp + 8 * g + 4 * hi) = pk4_fp8(st.o0[4 * g] * f, st.o0[4 * g + 1] * f, st.o0[4 * g + 2] * f, st.o0[4 * g + 3] * f);
        *(unsigned*)(rowp + 32 + 8 * g + 4 * hi) = pk4_fp8(st.o1[4 * g] * f, st.o1[4 * g + 1] * f, st.o1[4 * g + 2] * f, st.o1[4 * g + 3] * f);
    }
}

constexpr int DS_K = 0, DS_V = 32768, DS_TAB = 65536, DS_CS = 2128, DS_LUT = 100352;
DEVI void dsa_unit(const Params& p, LAS3 unsigned char* lds, int b, int h, int qb, bool build_tab) {
    const int tid = opaque_tid(), lane = tid & 63, wv = __builtin_amdgcn_readfirstlane(tid >> 6), r32 = lane & 31, hi = lane >> 5;
    const unsigned char* QA = (const unsigned char*)(p.ws + OFF_QA); const unsigned char* KA = (const unsigned char*)(p.ws + OFF_R1); const unsigned char* VA = KA + (size_t)NTOK * 512;
    const unsigned* SEL = (const unsigned*)(p.ws + OFF_SEL);
    LAS3 float* tab = (LAS3 float*)(lds + DS_TAB);
    __syncthreads();
    if (build_tab && tid < 256) { u32x2 e; e.x = ((tid & 1) ? 0xFFFFu : 0u) | ((tid & 2) ? 0xFFFF0000u : 0u); e.y = ((tid & 4) ? 0xFFFFu : 0u) | ((tid & 8) ? 0xFFFF0000u : 0u); *(LAS3 u32x2*)(lds + DS_LUT + tid * 8) = e; }
    if (build_tab)
    {   const float bb = p.rel_bias[(lane & 31) * 20 + h] * LOG2E;
        for (int i = tid; i < 4 * 2112 + 511; i += 512) { const int ii = i < 4 * 2112 ? i : 0, c = ii / 2112, j = ii % 2112, dist = (2111 - j) - 64; const float v = __shfl(bb, rel_bucket(dist < 0 ? 0 : dist));
            if (i < 4 * 2112) tab[c * DS_CS + j + c] = dist < 0 ? 0.f : v; } }
    const size_t hb = (size_t)(b * 8 + h) * SEQ; const int q0 = qb * 256, qw = q0 + 32 * wv, NT2 = 2 * qb + 2, mylast = 4 * qb + (wv >> 1);
    pg::v8i_t q8;
    q8.lo = *(const pg::v4i_t*)(QA + (hb + qw + r32) * 64 + 32 * hi); q8.hi = *(const pg::v4i_t*)(QA + (hb + qw + r32) * 64 + 32 * hi + 16);
    AttnState8 st; st.m = 0.f; st.mx = NEGB; bool zref = true;
#pragma unroll
    for (int r = 0; r < 16; ++r) { st.o0[r] = 0.f; st.o1[r] = 0.f; st.ol[r] = 0.f; }
    const unsigned char* ksrc = KA + (hb + (wv >> 2) * 64 + lane) * 64 + (wv & 3) * 16; const unsigned char* vsrc = VA + (hb + 16 * (wv & 3) + (lane >> 2)) * 64 + (wv >> 2) * 32 + (lane & 3) * 8;
    const int kdst = DS_K + (wv >> 2) * 4096 + (wv & 3) * 1024 + lane * 16, vdst = DS_V + (wv >> 2) * 4096 + (wv & 3) * 1024 + lane * 16;
    const LAS3 unsigned char* kp0 = lds + DS_K + 2 * hi * 1024 + r32 * 16;
    const LAS3 unsigned char* vp0 = lds + DS_V + ((lane >> 4) & 1) * 32 + (lane & 3) * 8 + (4 * hi + ((lane & 15) >> 2)) * 64;
    const unsigned* selrow = SEL + (size_t)(b * SEQ + qw + r32) * 64;
    const int jb = 2111 - (64 + qw + r32 - 4 * hi), cc = (4 - (jb & 3)) & 3;
    const LAS3 float* tqb = tab + cc * DS_CS + jb + cc;
    u32x4 kreg = *(const u32x4*)ksrc; u32x2 vreg0 = *(const u32x2*)vsrc, vreg1 = *(const u32x2*)(vsrc + 4096); u32x4 mwn = *(const u32x4*)selrow;
    *(LAS3 u32x4*)(lds + kdst) = kreg; *(LAS3 u32x4*)(lds + vdst) = fp8x8_to_bf16(vreg0); *(LAS3 u32x4*)(lds + vdst + 8192) = fp8x8_to_bf16(vreg1);
    __syncthreads();
#pragma unroll 1
    for (int t2 = 0; t2 < NT2; ++t2) {
        const int cur = (t2 & 1) * 16384, nxt = 16384 - cur, cur8 = (t2 & 1) * 8192, nxt8 = 8192 - cur8; const u32x4 mw = mwn;
        if (t2 + 1 < NT2) { const size_t o = (size_t)(t2 + 1) * 8192; kreg = *(const u32x4*)(ksrc + o); vreg0 = *(const u32x2*)(vsrc + o); vreg1 = *(const u32x2*)(vsrc + o + 4096);
            mwn = *(const u32x4*)(selrow + 4 * (t2 + 1)); }
        if (2 * t2 <= mylast)
            attn_tile8<true>(st, zref, q8, kp0 + cur8, vp0 + cur, tqb + 128 * t2, mw.x >> (4 * hi), mw.y >> (4 * hi), lds + DS_LUT);
        if (2 * t2 + 1 <= mylast)
            attn_tile8<true>(st, zref, q8, kp0 + cur8 + 4096, vp0 + cur + 8192, tqb + 128 * t2 + 64, mw.z >> (4 * hi), mw.w >> (4 * hi), lds + DS_LUT);
        if (t2 + 1 < NT2) { *(LAS3 u32x4*)(lds + kdst + nxt8) = kreg; *(LAS3 u32x4*)(lds + vdst + nxt) = fp8x8_to_bf16(vreg0); *(LAS3 u32x4*)(lds + vdst + nxt + 8192) = fp8x8_to_bf16(vreg1); }
        __syncthreads();
    }
    float lse2; const float rl = attn_finish8(st, lse2);
    attn_store8(st, rl * (1.0f / D8_SCALE), (unsigned char*)(p.ws + OFF_YA) + (size_t)(b * SEQ + qw + r32) * YAB_LD + h * 64, hi);
}
DEVI void phase_dil_merge(const Params& p) {
    const unsigned char* OG = (const unsigned char*)(p.ws + OFF_OG);
    const float* LSE = (const float*)(p.ws + OFF_LSE); unsigned char* YB = (unsigned char*)(p.ws + OFF_YA) + 512;
    const size_t stride = (size_t)gridDim.x * 512;
    for (size_t i0 = (size_t)blockIdx.x * 512 + opaque_tid(); i0 < (size_t)NTOK * 32; i0 += 2 * stride) {
        float l[2][3]; u32x2 x[2][3];
#pragma unroll
        for (int k = 0; k < 2; ++k) { const size_t i = i0 + k * stride < (size_t)NTOK * 32 ? i0 + k * stride : i0; const size_t tok = i >> 5; const int c8 = (int)(i & 31) * 8, j = c8 >> 6;
#pragma unroll
            for (int g = 0; g < 3; ++g) { l[k][g] = LSE[(size_t)NTOK * 4 * g + tok * 4 + j]; x[k][g] = *(const u32x2*)(OG + (size_t)NTOK * 256 * g + tok * 256 + c8); } }
#pragma unroll
        for (int k = 0; k < 2; ++k) { const size_t i = i0 + k * stride; if (i < (size_t)NTOK * 32) { const size_t tok = i >> 5; const int c8 = (int)(i & 31) * 8;
            const float mx = max3f(l[k][0], l[k][1], l[k][2]); float a0 = __builtin_amdgcn_exp2f(l[k][0] - mx), a1 = __builtin_amdgcn_exp2f(l[k][1] - mx), a2 = __builtin_amdgcn_exp2f(l[k][2] - mx);
            const float inv = 1.0f / (a0 + a1 + a2); a0 *= inv; a1 *= inv; a2 *= inv;
            float v[8];
#pragma unroll
            for (int hw = 0; hw < 2; ++hw) { const unsigned w0 = hw ? x[k][0].y : x[k][0].x, w1 = hw ? x[k][1].y : x[k][1].x, w2 = hw ? x[k][2].y : x[k][2].x;
                const f32x2 p0 = __builtin_amdgcn_cvt_pk_f32_fp8(w0, false), q0 = __builtin_amdgcn_cvt_pk_f32_fp8(w0, true), p1 = __builtin_amdgcn_cvt_pk_f32_fp8(w1, false), q1 = __builtin_amdgcn_cvt_pk_f32_fp8(w1, true),
                            p2 = __builtin_amdgcn_cvt_pk_f32_fp8(w2, false), q2 = __builtin_amdgcn_cvt_pk_f32_fp8(w2, true);
                v[4 * hw] = a0 * p0[0] + a1 * p1[0] + a2 * p2[0]; v[4 * hw + 1] = a0 * p0[1] + a1 * p1[1] + a2 * p2[1]; v[4 * hw + 2] = a0 * q0[0] + a1 * q1[0] + a2 * q2[0]; v[4 * hw + 3] = a0 * q0[1] + a1 * q1[1] + a2 * q2[1]; }
            u32x2 o; o.x = pk4_fp8(v[0], v[1], v[2], v[3]); o.y = pk4_fp8(v[4], v[5], v[6], v[7]);
            *(u32x2*)(YB + tok * YAB_LD + c8) = o; } }
    }
}
DEVI void phase_dsa(const Params& p, LAS3 unsigned char* lds) {
    int hprev = -1;
    for (int u = blockIdx.x; u < BATCH * 8 * 4; u += gridDim.x) {
        const int b = u >> 5, h = (u >> 2) & 7, j = u & 3;
        dsa_unit(p, lds, b, h, j, h != hprev); dsa_unit(p, lds, b, h, 7 - j, false); hprev = h;
    }
}

constexpr int DL_SET = 73728, DL_VOFF = 24576, DL_TAB = 2 * DL_SET;
static_assert(DL_TAB + 12 * 224 * 4 <= LDS_XB, "dilated phase LDS overflow");
struct DilU { bool tB; int b, gj, r, ls, res0, res1, i0, sg0, nst; size_t hb; };
DEVI DilU dil_decode(int u) {
    DilU d; d.tB = (u % 3) == 2; const int ix = d.tB ? u / 3 : (u / 3) * 2 + (u % 3);
    if (!d.tB) { const int e8 = ix & 7; d.gj = (ix >> 3) & 7; d.b = ix >> 6; d.r = (d.gj >> 2) ? 4 : 1; d.ls = SEQ / d.r; const int nb = d.ls >> 8; d.res0 = d.res1 = e8 / nb; d.i0 = (e8 % nb) * 256; d.sg0 = d.i0 == 0 ? 1 : 0; d.nst = 3; }
    else { const int e8 = ix & 7; d.gj = 8 + ((ix >> 3) & 3); d.b = ix >> 5; d.r = 16; d.ls = 128; d.res0 = 2 * e8; d.res1 = 2 * e8 + 1; d.i0 = 0; d.sg0 = 0; d.nst = 2; }
    d.hb = ((size_t)d.gj * BATCH + d.b) * SEQ; return d;
}
DEVI void phase_dil(const Params& p, LAS3 unsigned char* lds) {
    const int tid = opaque_tid(), lane = tid & 63, wv = __builtin_amdgcn_readfirstlane(tid >> 6), r32 = lane & 31, hi = lane >> 5;
    LAS3 float* tabs = (LAS3 float*)(lds + DL_TAB);
    LAS3 float* rb = (LAS3 float*)lds;
    { const float b0 = p.rel_bias[tid], b1 = tid < 128 ? p.rel_bias[512 + tid] : 0.f; rb[tid] = b0; if (tid < 128) rb[512 + tid] = b1; }
    __syncthreads();
    for (int i = tid; i < 12 * 224; i += 512) { const int gj = i / 224, dist = i % 224 - 64, g = gj >> 2;
        tabs[i] = (dist < 0 || dist > 128) ? NEGB : rb[rel_bucket(dist * dil_r(g)) * 20 + 8 + gj] * LOG2E; }
    __syncthreads();
    const unsigned char* DQ = (const unsigned char*)(p.ws + OFF_DIL); const unsigned char* DK = DQ + DIL_SZ; const unsigned char* DV = DK + DIL_SZ;
    unsigned char* OG = (unsigned char*)(p.ws + OFF_OG); float* LSE = (float*)(p.ws + OFF_LSE);
    u32x4 kreg[3]; u32x2 vreg[3][2]; pg::v8i_t q8n;
#define DLU_TS(d_, sg_, s_) ((d_).tB ? 64 * (sg_) : (d_).i0 - 128 + 64 * (2 * (sg_) + (s_)))
#define DLU_LOAD(d_) do { _Pragma("unroll") for (int j_ = 0; j_ < 3; ++j_) { const int sg_ = (d_).sg0 + j_; if (sg_ < (d_).nst) { \
        { const int sl_ = wv >> 2, ts_ = DLU_TS(d_, sg_, sl_); int kk = ts_ + lane; kk = kk < 0 ? 0 : (kk > (d_).ls - 1 ? (d_).ls - 1 : kk); \
          kreg[j_] = *(const u32x4*)(DK + ((d_).hb + (size_t)(sl_ ? (d_).res1 : (d_).res0) * (d_).ls + kk) * 64 + (wv & 3) * 16); } \
        _Pragma("unroll") for (int s_ = 0; s_ < 2; ++s_) { const int ts_ = DLU_TS(d_, sg_, s_); int vk = ts_ + 16 * (wv & 3) + (lane >> 2); vk = vk < 0 ? 0 : (vk > (d_).ls - 1 ? (d_).ls - 1 : vk); \
          vreg[j_][s_] = *(const u32x2*)(DV + ((d_).hb + (size_t)(s_ ? (d_).res1 : (d_).res0) * (d_).ls + vk) * 64 + (wv >> 2) * 32 + (lane & 3) * 8); } } } \
        { const int wres_ = (d_).tB ? ((wv >> 2) ? (d_).res1 : (d_).res0) : (d_).res0, qpos_ = (d_).i0 + ((d_).tB ? 32 * (wv & 3) : 32 * wv) + r32; \
          const unsigned char* qp_ = DQ + ((d_).hb + (size_t)wres_ * (d_).ls + qpos_) * 64 + 32 * hi; q8n.lo = *(const pg::v4i_t*)qp_; q8n.hi = *(const pg::v4i_t*)(qp_ + 16); } } while (0)
#define DLU_WRITE(d_, set_) do { _Pragma("unroll") for (int j_ = 0; j_ < 3; ++j_) { const int sg_ = (d_).sg0 + j_; if (sg_ < (d_).nst) { \
        *(LAS3 u32x4*)(lds + (set_) + (2 * sg_ + (wv >> 2)) * 4096 + (wv & 3) * 1024 + lane * 16) = kreg[j_]; \
        _Pragma("unroll") for (int s_ = 0; s_ < 2; ++s_) *(LAS3 u32x4*)(lds + (set_) + DL_VOFF + (2 * sg_ + s_) * 8192 + (wv >> 2) * 4096 + (wv & 3) * 1024 + lane * 16) = fp8x8_to_bf16(vreg[j_][s_]); } } } while (0)
    int u = blockIdx.x; DilU d = dil_decode(u < 3072 ? u : 0); pg::v8i_t q8;
    if (u < 3072) { DLU_LOAD(d); DLU_WRITE(d, 0); }
    q8 = q8n;
#pragma unroll 1
    for (int it = 0; u < 3072; u += gridDim.x, ++it) {
        const int set = (it & 1) * DL_SET; const int un = u + gridDim.x; const bool has_next = un < 3072;
        DilU dn = dil_decode(has_next ? un : u);
        if (has_next) DLU_LOAD(dn);
        __syncthreads();
        const int g = d.gj >> 2, j = d.gj & 3;
        const int wres = d.tB ? ((wv >> 2) ? d.res1 : d.res0) : d.res0, wq = d.tB ? 32 * (wv & 3) : 32 * wv, qpos = d.i0 + wq + r32;
        const int tlo = wq >> 6, thi = (wq + 159) >> 6;
        AttnState8 st; st.m = 0.f; st.mx = NEGB; st.l = 0.f; bool zref = true;
#pragma unroll
        for (int q = 0; q < 16; ++q) { st.o0[q] = 0.f; st.o1[q] = 0.f; }
        const LAS3 float* tb = (const LAS3 float*)(lds + DL_TAB) + d.gj * 224;
        const LAS3 unsigned char* kp0 = lds + set + 2 * hi * 1024 + r32 * 16;
        const LAS3 unsigned char* vp0 = lds + set + DL_VOFF + ((lane >> 4) & 1) * 32 + (lane & 3) * 8 + (4 * hi + ((lane & 15) >> 2)) * 64;
#pragma unroll 1
        for (int sg = d.sg0; sg < d.nst; ++sg) {
#pragma unroll
            for (int s_ = 0; s_ < 2; ++s_) {
                const int tau = d.tB ? 2 + sg : 2 * sg + s_, ts = DLU_TS(d, sg, s_), T = 2 * sg + s_;
                const bool mine = tau >= tlo && tau <= thi && (!d.tB || s_ == (wv >> 2)) && ts + 63 >= 0;
                if (mine) {
                    if (ts >= 0) attn_tile8<false, 0, false>(st, zref, q8, kp0 + T * 4096, vp0 + T * 8192, tb + 64 + qpos - ts - 4 * hi - 63, 0u, 0u);
                    else { const unsigned long long vm = ~0ull << (-ts);
                        attn_tile8<false, 1, false>(st, zref, q8, kp0 + T * 4096, vp0 + T * 8192, tb + 64 + qpos - ts - 4 * hi - 63, (unsigned)vm >> (4 * hi), (unsigned)(vm >> 32) >> (4 * hi)); }
                }
            }
        }
        float lse2; const float rl = attn_finish8l(st, lse2);
        const int stok = qpos * d.r + wres; const size_t tok = (size_t)d.b * SEQ + stok;
        attn_store8(st, rl * (1.0f / D8_SCALE), OG + ((size_t)g * NTOK + tok) * 256 + j * 64, hi);
        if (hi == 0) LSE[((size_t)g * NTOK + tok) * 4 + j] = lse2;
        if (has_next) DLU_WRITE(dn, DL_SET - set);
        d = dn; q8 = q8n;
    }
#undef DLU_TS
#undef DLU_LOAD
#undef DLU_WRITE
}


#define XB_TMO      128
#define XB_XCNT(j)  (256  + 64 * (j))
#define XB_XSUB(j)  (1280 + 64 * (j))
#define XB_XGEN(j)  (2304 + 64 * (j))
#define XB_TOP      3328
#define XB_TOPGEN   3392
#define XCD_BAR_WORDS 3456
#define XB_SPIN_CAP (1u << 18)
#define LAS __attribute__((address_space(3)))

__device__ __forceinline__ unsigned xb_ld(unsigned* p)              { return __hip_atomic_load(p, __ATOMIC_RELAXED, __HIP_MEMORY_SCOPE_AGENT); }
__device__ __forceinline__ unsigned xb_add(unsigned* p, unsigned v) { return __hip_atomic_fetch_add(p, v, __ATOMIC_RELAXED, __HIP_MEMORY_SCOPE_AGENT); }
__device__ __forceinline__ unsigned xb_xcc_id() { return (unsigned)__builtin_amdgcn_s_getreg((3 << 11) | 20) & 0xFu; }
#define XB_SPIN(cond, bar) do { unsigned _sp = 0; while (cond) { __builtin_amdgcn_s_sleep(1); \
    if ((++_sp & 255u) == 0u) { if (xb_ld(&(bar)[XB_TMO])) break; if (_sp > XB_SPIN_CAP) { atomicAdd(&(bar)[XB_TMO], 1u); break; } } } } while (0)

struct XcdBarrier {
    unsigned* bar; unsigned x;
    volatile LAS unsigned* st;
};

__device__ __forceinline__ XcdBarrier xcd_barrier_post(unsigned* bar, volatile LAS unsigned* st) {
    XcdBarrier b; b.bar = bar; b.x = xb_xcc_id(); b.st = st;
    if (threadIdx.x == 0) (void)xb_add(&bar[XB_XCNT(b.x)], 1u);
    return b;
}
__device__ __forceinline__ void xcd_barrier_complete(unsigned* bar, unsigned x, unsigned& nloc, unsigned& nx) {
    const unsigned G = gridDim.x * gridDim.y * gridDim.z;
    unsigned sum, cnt, mine, sp = 0u;
    for (;;) {
        sum = 0u; cnt = 0u; mine = 0u;
#pragma unroll
        for (unsigned j = 0; j < 16; ++j) { const unsigned c = xb_ld(&bar[XB_XCNT(j)]); sum += c; cnt += (c > 0u) ? 1u : 0u; mine = (j == x) ? c : mine; }
        if (sum == G) break;
        __builtin_amdgcn_s_sleep(1);
        if ((++sp & 255u) == 0u) { if (xb_ld(&bar[XB_TMO])) break; if (sp > XB_SPIN_CAP) { atomicAdd(&bar[XB_TMO], 1u); break; } }
    }
    nloc = mine > 0u ? mine : 1u; nx = cnt > 0u ? cnt : 1u;
}

__device__ __forceinline__ void xcd_barrier(const XcdBarrier& b) {
    asm volatile("s_waitcnt vmcnt(0)" ::: "memory");
    __syncthreads();
    if (threadIdx.x == 0) {
        unsigned* bar = b.bar;
        __builtin_amdgcn_s_waitcnt(0);
        unsigned nloc = b.st[0], nx = b.st[1];
        if (nloc == 0u) { xcd_barrier_complete(bar, b.x, nloc, nx); b.st[0] = nloc; b.st[1] = nx; }
        const unsigned old = xb_add(&bar[XB_XSUB(b.x)], 1u);
        const unsigned gen = old / nloc;
        if (old + 1u == (gen + 1u) * nloc) {
            __builtin_amdgcn_fence(__ATOMIC_RELEASE, "agent");
            asm volatile("s_waitcnt vmcnt(0)" ::: "memory");
            const unsigned og = xb_add(&bar[XB_TOP], 1u);
            const unsigned tg = og / nx;
            if (og + 1u == (tg + 1u) * nx) xb_add(&bar[XB_TOPGEN], 1u);
            else XB_SPIN(xb_ld(&bar[XB_TOPGEN]) == tg, bar);
            __builtin_amdgcn_fence(__ATOMIC_ACQUIRE, "agent");
            xb_add(&bar[XB_XGEN(b.x)], 1u);
            asm volatile("s_waitcnt vmcnt(0)" ::: "memory");
        } else {
            XB_SPIN(xb_ld(&bar[XB_XGEN(b.x)]) == gen, bar);
            __builtin_amdgcn_fence(__ATOMIC_ACQUIRE, "agent");
            asm volatile("s_waitcnt vmcnt(0)" ::: "memory");
        }
    }
    __syncthreads();
}


__global__ void __launch_bounds__(512, 2) fwd(Params p) {
    extern __shared__ __attribute__((aligned(16))) unsigned char smem[];
    LAS3 unsigned char* lds = (LAS3 unsigned char*)smem;
    if (threadIdx.x < 4) ((LAS3 unsigned*)(lds + LDS_XB))[threadIdx.x] = 0u;
    __syncthreads();
    XcdBarrier bar = xcd_barrier_post((unsigned*)(p.ws + OFF_BAR), (volatile LAS unsigned*)(lds + LDS_XB));
    phase_prologue(p, lds);
#if PROBE_DUP == 1
    phase_prologue(p, lds);
#endif
    xcd_barrier(bar);
    phase_proj(p, lds);
    xcd_barrier(bar);
    phase_kv(p, lds);
#if PROBE_DUP == 2
    phase_kv(p, lds);
#endif
    phase_topk(p, lds);
#if PROBE_DUP == 3
    phase_topk(p, lds);
#endif
    __syncthreads();
    phase_dil(p, lds);
#if PROBE_DUP == 4
    __syncthreads(); phase_dil(p, lds);
#endif
    xcd_barrier(bar);
    phase_dil_merge(p);
    phase_dsa(p, lds);
#if PROBE_DUP == 5
    phase_dsa(p, lds);
#endif
    xcd_barrier(bar);
    phase_mix(p, lds);
#if PROBE_DUP == 6
    phase_mix(p, lds);
#endif
    __builtin_amdgcn_fence(__ATOMIC_SEQ_CST, "workgroup"); __syncthreads();
    phase_out(p, lds);
#if PROBE_DUP == 7
    phase_out(p, lds);
#endif
    __builtin_amdgcn_fence(__ATOMIC_SEQ_CST, "workgroup"); __syncthreads();
    phase_route(p, lds);
    phase_expert_weights(p, lds);
#if PROBE_DUP == 11
    phase_expert_weights(p, lds);
#endif
    xcd_barrier(bar);
    build_expert_tables(p, lds);
    phase_gu(p, lds);
#if PROBE_DUP == 8
    phase_gu(p, lds);
#endif
    xcd_barrier(bar);
    phase_down(p, lds);
#if PROBE_DUP == 9
    phase_down(p, lds);
#endif
    xcd_barrier(bar);
    phase_final(p, lds);
#if PROBE_DUP == 10
    phase_final(p, lds);
#endif
}
extern "C" void kernel_launch(void* const* d_in, const int* in_sizes, int n_in, void* d_out, int out_size, void* d_ws, size_t ws_size, hipStream_t stream) {
    Params p{};
    p.x = (const float*)d_in[0]; p.attn_norm = (const float*)d_in[1]; p.w_in = (const float*)d_in[2]; p.kv_norm = (const float*)d_in[3];
    p.w_uk = (const float*)d_in[4]; p.w_uv = (const float*)d_in[5]; p.rel_bias = (const float*)d_in[6]; p.w_a = (const float*)d_in[7]; p.w_b = (const float*)d_in[8];
    p.w_out = (const float*)d_in[9]; p.ffn_norm = (const float*)d_in[10]; p.w_rg = (const float*)d_in[11]; p.b_rg = (const float*)d_in[12]; p.w_re = (const float*)d_in[13];
    p.b_re = (const float*)d_in[14]; p.w_gate = (const float*)d_in[15]; p.w_up = (const float*)d_in[16]; p.w_down = (const float*)d_in[17]; p.final_norm = (const float*)d_in[18];
    p.out = (float*)d_out; p.ws = (char*)d_ws;
    static int grid = 0;
    if (!grid) {
        (void)hipFuncSetAttribute((const void*)fwd, hipFuncAttributeMaxDynamicSharedMemorySize, LDS_TOTAL);
        int dev = 0, cus = 0, per_cu = 0; (void)hipGetDevice(&dev); (void)hipDeviceGetAttribute(&cus, hipDeviceAttributeMultiprocessorCount, dev);
        (void)hipOccupancyMaxActiveBlocksPerMultiprocessor(&per_cu, (const void*)fwd, 512, LDS_TOTAL);
        grid = (cus > 0 ? cus : 256) * (per_cu >= 1 ? 1 : 0);
        if (grid <= 0) { fprintf(stderr, "kernel_launch: fwd does not fit a CU (occupancy query %d)\n", per_cu); grid = -1; }
    }
    if (grid < 0) return;
    (void)hipMemsetAsync((char*)d_ws + OFF_BAR, 0, XCD_BAR_WORDS * sizeof(unsigned), stream);
    (void)hipMemsetAsync((char*)d_ws + OFF_ECNT, 0, 1024, stream);
    fwd<<<grid, 512, LDS_TOTAL, stream>>>(p);
}
```

```cpp
#include <hip/hip_runtime.h>
#include <stdint.h>
#include <stdio.h>
#define PROBE_DUP 0
#define TK_REP_SEL 1
#define TK_REP_TIE 1

typedef unsigned short bf16_t;
#define DEVI __device__ __forceinline__

constexpr int BATCH = 32, SEQ = 2048, DM = 1024, NTOK = BATCH * SEQ;
constexpr int IN_COLS = 5444;
constexpr int NEXP = 32, EFF = 512;
constexpr float RMS_EPS = 1e-6f;
constexpr float LOG2E = 1.4426950408889634f;
constexpr float QSCALE = 0.125f * LOG2E;

constexpr size_t MiB = 1ull << 20;
constexpr size_t OFF_BAR   = 0;
constexpr size_t OFF_SSQ   = 1 * MiB;
constexpr size_t OFF_WI    = 2 * MiB;
constexpr size_t OFF_ECNT  = 3 * MiB;
constexpr size_t OFF_LSE   = 4 * MiB;
constexpr size_t OFF_WTIN  = 8 * MiB;
constexpr size_t OFF_WSM   = 20 * MiB;
constexpr size_t OFF_OG    = 24 * MiB;
constexpr size_t OFF_R1    = 120 * MiB;
constexpr size_t OFF_QA    = 248 * MiB;
constexpr size_t OFF_CR    = 312 * MiB;
constexpr size_t OFF_QI    = 344 * MiB;
constexpr size_t OFF_YA    = 312 * MiB;
constexpr int    YAB_LD    = 768;
constexpr size_t OFF_KI    = 376 * MiB;
constexpr size_t OFF_DIL   = 384 * MiB;
constexpr size_t DIL_SZ    = (size_t)12 * NTOK * 64;
constexpr size_t OFF_YB    = 944 * MiB;
constexpr size_t OFF_MIX   = 416 * MiB;
constexpr size_t OFF_G     = 672 * MiB;
constexpr size_t OFF_H     = 672 * MiB;
constexpr size_t OFF_SEL   = 928 * MiB;

DEVI float bf2f(bf16_t v) { return __uint_as_float(((unsigned)v) << 16); }
DEVI bf16_t f2bf(float f) { unsigned u = __float_as_uint(f); u += 0x7FFFu + ((u >> 16) & 1u); return (bf16_t)(u >> 16); }

DEVI int rel_bucket(int n) {
    if (n < 16) return n < 0 ? 0 : n;
    int b = 16;
    b += (n >= 22) + (n >= 30) + (n >= 40) + (n >= 54) + (n >= 73) + (n >= 99) + (n >= 134) + (n >= 182);
    b += (n >= 246) + (n >= 332) + (n >= 450) + (n >= 609) + (n >= 825) + (n >= 1117) + (n >= 1513);
    return b;
}
DEVI int dil_r(int g) { return g == 0 ? 1 : (g == 1 ? 4 : 16); }


#define LAS3 __attribute__((address_space(3)))
DEVI int opaque_tid() { int t = threadIdx.x; asm volatile("" : "+v"(t)); return t; }
typedef short bf16x8 __attribute__((ext_vector_type(8)));
typedef float f32x4 __attribute__((ext_vector_type(4)));
typedef float f32x2 __attribute__((ext_vector_type(2)));
typedef unsigned u32x4 __attribute__((ext_vector_type(4)));
typedef unsigned u32x2 __attribute__((ext_vector_type(2)));

constexpr int LDS_TOTAL = 163840;
constexpr int LDS_TAB   = 131072;
constexpr int LDS_XB    = LDS_TOTAL - 16;

constexpr size_t OFF_LIST  = 8 * MiB;
constexpr size_t OFF_WEXP  = 16 * MiB;
constexpr size_t OFF_WDN   = OFF_WEXP + 64 * MiB;
constexpr size_t OFF_TT    = OFF_R1;
constexpr size_t OFF_HID   = 248 * MiB;
constexpr size_t OFF_EO    = 384 * MiB;
constexpr size_t OFF_RT    = 5 * MiB;
constexpr size_t OFF_U     = OFF_R1;
constexpr size_t OFF_WKV   = OFF_WSM;
constexpr size_t OFF_WAT   = OFF_WSM + 512 * 1024;
constexpr size_t OFF_WBT   = OFF_WSM + 1536 * 1024;
constexpr size_t OFF_WOT   = 984 * MiB;
constexpr size_t OFF_U8    = OFF_OG;
constexpr size_t OFF_WT8   = 976 * MiB;
constexpr size_t OFF_WAB   = 982 * MiB;
constexpr int NPAD = 5632;

typedef __bf16 bf16x2_t __attribute__((ext_vector_type(2)));
DEVI float fadd1(float a, float b) { float d; asm("v_add_f32 %0, %1, %2" : "=v"(d) : "v"(a), "v"(b)); return d; }
DEVI unsigned cvt_pk_bf16(float lo, float hi) { f32x2 v = {lo, hi}; bf16x2_t r = __builtin_convertvector(v, bf16x2_t); return __builtin_bit_cast(unsigned, r); }
DEVI u32x4 pack8(const f32x4& a, const f32x4& b) { u32x4 w; w.x = cvt_pk_bf16(a[0], a[1]); w.y = cvt_pk_bf16(a[2], a[3]); w.z = cvt_pk_bf16(b[0], b[1]); w.w = cvt_pk_bf16(b[2], b[3]); return w; }
DEVI unsigned pk4_fp8(float a, float b, float c, float d) { unsigned w = 0u; w = __builtin_amdgcn_cvt_pk_fp8_f32(a, b, w, false); w = __builtin_amdgcn_cvt_pk_fp8_f32(c, d, w, true); return w; }
constexpr float D8_SCALE = 8.0f;
constexpr float W8_SCALE = 32.0f, W8_INV = 1.0f / 32.0f;
DEVI u32x4 fp8x8_to_bf16(u32x2 w, float scale) {
    const f32x2 a = __builtin_amdgcn_cvt_pk_f32_fp8(w.x, false), b = __builtin_amdgcn_cvt_pk_f32_fp8(w.x, true), c = __builtin_amdgcn_cvt_pk_f32_fp8(w.y, false), d = __builtin_amdgcn_cvt_pk_f32_fp8(w.y, true);
    u32x4 r; r.x = cvt_pk_bf16(a[0] * scale, a[1] * scale); r.y = cvt_pk_bf16(b[0] * scale, b[1] * scale); r.z = cvt_pk_bf16(c[0] * scale, c[1] * scale); r.w = cvt_pk_bf16(d[0] * scale, d[1] * scale); return r;
}
DEVI u32x4 fp8x8_to_bf16(u32x2 w) {
    const f32x2 a = __builtin_amdgcn_cvt_pk_f32_fp8(w.x, false), b = __builtin_amdgcn_cvt_pk_f32_fp8(w.x, true), c = __builtin_amdgcn_cvt_pk_f32_fp8(w.y, false), d = __builtin_amdgcn_cvt_pk_f32_fp8(w.y, true);
    u32x4 r; r.x = cvt_pk_bf16(a[0], a[1]); r.y = cvt_pk_bf16(b[0], b[1]); r.z = cvt_pk_bf16(c[0], c[1]); r.w = cvt_pk_bf16(d[0], d[1]); return r;
}
DEVI unsigned pk4_u8(float a, float b, float c, float d) { unsigned w = 0u; w = __builtin_amdgcn_cvt_pk_u8_f32(a, 0, w); w = __builtin_amdgcn_cvt_pk_u8_f32(b, 1, w); w = __builtin_amdgcn_cvt_pk_u8_f32(c, 2, w); return __builtin_amdgcn_cvt_pk_u8_f32(d, 3, w); }
DEVI float bflo(unsigned w) { return __uint_as_float(w << 16); }
DEVI float bfhi(unsigned w) { return __uint_as_float(w & 0xFFFF0000u); }
DEVI float fast_sigmoid(float v) { return __builtin_amdgcn_rcpf(1.0f + __expf(-v)); }

struct Params {
    const float *x, *attn_norm, *w_in, *kv_norm, *w_uk, *w_uv, *rel_bias, *w_a, *w_b, *w_out, *ffn_norm, *w_rg, *b_rg, *w_re, *b_re, *w_gate, *w_up, *w_down, *final_norm;
    float* out; char* ws;
};

DEVI void tr_tile(const float* src, int lds_, int ncols_valid, bf16_t* dst, int ldd, const float* rs, LAS3 float* tile) {
    const int tid = opaque_tid();
    { const int c = tid & 63, cs = c < ncols_valid ? c : 0; float v[8], sc[8];
#pragma unroll
      for (int i = 0; i < 8; ++i) { const int r = (tid >> 6) + 8 * i; v[i] = src[(size_t)r * lds_ + cs]; sc[i] = rs ? rs[r] : 1.0f; }
#pragma unroll
      for (int i = 0; i < 8; ++i) tile[((tid >> 6) + 8 * i) * 65 + c] = c < ncols_valid ? v[i] * sc[i] : 0.f; }
    __syncthreads();
    { const int c = tid >> 3, r0 = (tid & 7) * 8;
      u32x4 w;
#pragma unroll
      for (int q = 0; q < 4; ++q) w[q] = cvt_pk_bf16(tile[(r0 + 2 * q) * 65 + c], tile[(r0 + 2 * q + 1) * 65 + c]);
      *(u32x4*)(dst + (size_t)c * ldd + r0) = w; }
    __syncthreads();
}

DEVI void tr_tile8(const float* src, int lds_, unsigned char* dst, int ldd, float scale, LAS3 float* tile, int ncols_valid = 64) {
    const int tid = opaque_tid();
    { const int c = tid & 63, cs = c < ncols_valid ? c : 0; float v[8];
#pragma unroll
      for (int i = 0; i < 8; ++i) v[i] = src[(size_t)((tid >> 6) + 8 * i) * lds_ + cs];
#pragma unroll
      for (int i = 0; i < 8; ++i) tile[((tid >> 6) + 8 * i) * 65 + c] = c < ncols_valid ? v[i] * scale : 0.f; }
    __syncthreads();
    { const int c = tid >> 3, r0 = (tid & 7) * 8; u32x2 w;
      w.x = pk4_fp8(tile[(r0 + 0) * 65 + c], tile[(r0 + 1) * 65 + c], tile[(r0 + 2) * 65 + c], tile[(r0 + 3) * 65 + c]);
      w.y = pk4_fp8(tile[(r0 + 4) * 65 + c], tile[(r0 + 5) * 65 + c], tile[(r0 + 6) * 65 + c], tile[(r0 + 7) * 65 + c]);
      *(u32x2*)(dst + (size_t)c * ldd + r0) = w; }
    __syncthreads();
}

DEVI void phase_prologue(const Params& p, LAS3 unsigned char* lds) {
    LAS3 float* tile = (LAS3 float*)lds;
    const int G = gridDim.x, c = blockIdx.x;
    for (int t = c; t < 88 * 16; t += G) {
        const int nt = t >> 4, kt = t & 15, n0 = nt * 64;
        int sc, nv;
        if (n0 < 1088) { sc = n0; nv = 64; } else if (n0 == 1088) { sc = 1088; nv = 4; } else if (n0 < 1280) { sc = 0; nv = 0; }
        else if (n0 < 3584) { sc = 1092 + (n0 - 1280); nv = 64; } else { sc = 3396 + (n0 - 3584); nv = 64; }
        tr_tile8(p.w_in + (size_t)kt * 64 * IN_COLS + sc, IN_COLS, (unsigned char*)(p.ws + OFF_WT8) + (size_t)n0 * 1024 + kt * 64, 1024, W8_SCALE, tile, nv);
    }
    for (int t = c; t < 16 * 4; t += G) {
        const int which = t >> 5, h = (t >> 2) & 7, kt = t & 3; const float* W = which ? p.w_uv : p.w_uk;
        tr_tile(W + ((size_t)h * 256 + kt * 64) * 64, 64, 64, (bf16_t*)(p.ws + OFF_WKV) + (size_t)(which * 512 + h * 64) * 256 + kt * 64, 256, p.kv_norm + kt * 64, tile);
    }
    for (int t = c; t < 16 * 12 * 2; t += G) {
        const int half = t / 192, r = t % 192, nt = r / 12, kt = r % 12; const bool real = half == 0 ? kt < 8 : kt >= 8;
        const float* src = half == 0 ? p.w_a + (size_t)kt * 64 * 1024 + nt * 64 : p.w_b + (size_t)(kt - 8) * 64 * 1024 + nt * 64;
        tr_tile8(real ? src : p.w_a, 1024, (unsigned char*)(p.ws + OFF_WAB) + (size_t)((nt >> 1) * 256 + half * 128 + (nt & 1) * 64) * YAB_LD + kt * 64, YAB_LD, W8_SCALE, tile, real ? 64 : 0);
    }
    for (int t = c; t < 16 * 16; t += G) { const int nt = t >> 4, kt = t & 15; tr_tile8(p.w_out + (size_t)kt * 64 * 1024 + nt * 64, 1024, (unsigned char*)(p.ws + OFF_WOT) + (size_t)nt * 64 * 1024 + kt * 64, 1024, W8_SCALE, tile); }
    const int lane = opaque_tid() & 63, wv = opaque_tid() >> 6;
    f32x4 gn[4];
#pragma unroll
    for (int q = 0; q < 4; ++q) gn[q] = *(const f32x4*)(p.attn_norm + q * 256 + 4 * lane);
    {
        const int st = G * 8; int tok = c * 8 + wv; f32x4 nx[2][4];
#pragma unroll
        for (int k = 0; k < 2; ++k) if (tok + k * st < NTOK) {
#pragma unroll
            for (int q = 0; q < 4; ++q) nx[k][q] = *(const f32x4*)(p.x + (size_t)(tok + k * st) * 1024 + q * 256 + 4 * lane);
        }
#pragma unroll 1
        for (; tok < NTOK; tok += 2 * st) {
            f32x4 v[2][4];
#pragma unroll
            for (int k = 0; k < 2; ++k)
#pragma unroll
                for (int q = 0; q < 4; ++q) v[k][q] = nx[k][q];
#pragma unroll
            for (int k = 0; k < 2; ++k) if (tok + (2 + k) * st < NTOK) {
#pragma unroll
                for (int q = 0; q < 4; ++q) nx[k][q] = *(const f32x4*)(p.x + (size_t)(tok + (2 + k) * st) * 1024 + q * 256 + 4 * lane);
            }
#pragma unroll
            for (int k = 0; k < 2; ++k) if (tok + k * st < NTOK) {
                float ss = 0.f;
#pragma unroll
                for (int q = 0; q < 4; ++q) ss += v[k][q][0] * v[k][q][0] + v[k][q][1] * v[k][q][1] + v[k][q][2] * v[k][q][2] + v[k][q][3] * v[k][q][3];
#pragma unroll
                for (int o = 32; o > 0; o >>= 1) ss += __shfl_xor(ss, o);
                const float rinv = rsqrtf(ss * (1.0f / 1024.0f) + RMS_EPS);
#pragma unroll
                for (int q = 0; q < 4; ++q)
                    *(unsigned*)((unsigned char*)(p.ws + OFF_U8) + (size_t)(tok + k * st) * 1024 + q * 256 + 4 * lane) = pk4_fp8(v[k][q][0] * rinv * gn[q][0], v[k][q][1] * rinv * gn[q][1], v[k][q][2] * rinv * gn[q][2], v[k][q][3] * rinv * gn[q][3]);
            }
        }
    }
}

DEVI void phase_expert_weights(const Params& p, LAS3 unsigned char* lds) {
    LAS3 float* tile = (LAS3 float*)lds;
    const int G = gridDim.x, c = blockIdx.x, tid = opaque_tid();
    constexpr int NT = NEXP * 256 + NEXP * 128, TB = 4, TSZ = 64 * 65;
#pragma unroll 1
    for (int t0 = c * TB; t0 < NT; t0 += G * TB) {
        const float* src[TB]; int ld[TB]; unsigned char* dst[TB]; int ldd[TB]; float rg[TB][8];
#pragma unroll
        for (int q = 0; q < TB; ++q) {
            const int t = t0 + q;
            if (t < NEXP * 256) { const int e = t >> 8, r = t & 255, half = r >> 7, ft = (r >> 4) & 7, kt = r & 15, pnl = ft >> 1, n = pnl * 256 + half * 128 + (ft & 1) * 64;
                src[q] = (half ? p.w_up : p.w_gate) + (size_t)e * 1024 * 512 + (size_t)kt * 64 * 512 + ft * 64; ld[q] = 512;
                dst[q] = (unsigned char*)(p.ws + OFF_WEXP) + ((size_t)e * 1024 + n) * 1024 + kt * 64; ldd[q] = 1024; }
            else { const int t2 = t - NEXP * 256, e = t2 >> 7, nt = (t2 >> 3) & 15, kt = t2 & 7;
                src[q] = p.w_down + (size_t)e * 512 * 1024 + (size_t)kt * 64 * 1024 + nt * 64; ld[q] = 1024;
                dst[q] = (unsigned char*)(p.ws + OFF_WDN) + ((size_t)e * 1024 + nt * 64) * 512 + kt * 64; ldd[q] = 512; }
#pragma unroll
            for (int i = 0; i < 8; ++i) rg[q][i] = src[q][(size_t)((tid >> 6) + 8 * i) * ld[q] + (tid & 63)];
        }
#pragma unroll
        for (int q = 0; q < TB; ++q)
#pragma unroll
            for (int i = 0; i < 8; ++i) tile[q * TSZ + ((tid >> 6) + 8 * i) * 65 + (tid & 63)] = rg[q][i] * W8_SCALE;
        __syncthreads();
#pragma unroll
        for (int q = 0; q < TB; ++q) { const int cc = tid >> 3, r0 = (tid & 7) * 8; const LAS3 float* tq = tile + q * TSZ; u32x2 w;
            w.x = pk4_fp8(tq[(r0 + 0) * 65 + cc], tq[(r0 + 1) * 65 + cc], tq[(r0 + 2) * 65 + cc], tq[(r0 + 3) * 65 + cc]);
            w.y = pk4_fp8(tq[(r0 + 4) * 65 + cc], tq[(r0 + 5) * 65 + cc], tq[(r0 + 6) * 65 + cc], tq[(r0 + 7) * 65 + cc]);
            *(u32x2*)(dst[q] + (size_t)cc * ldd[q] + r0) = w; }
        __syncthreads();
    }
}

namespace pg {
constexpr int BM = 256, BK = 64, HALF = 128, HTB = HALF * BK * 2, STAGE_BYTES = 8 * HTB, NXCD = 8, WGM = 8;
__host__ __device__ __forceinline__ int lds_byte(int r, int c) { const int st = (r >> 4) * 2 + (c >> 5), rr = r & 15, cc = c & 31, ob = rr * 64 + cc * 2; return st * 1024 + (ob ^ (((ob >> 9) & 1) << 5)); }
__host__ __device__ __forceinline__ void stage_rc(int b, int& R, int& C) { const int st = b / 1024, sb = b % 1024, swz = sb ^ (((sb >> 9) & 1) << 5); R = (st >> 1) * 16 + swz / 64; C = (st & 1) * 32 + (swz % 64) / 2; }
__host__ __device__ __forceinline__ int perm32(int rho) { const int n = rho >> 4, i = rho & 15; return 8 * (i >> 2) + 4 * n + (i & 3); }

struct Unit { int pm, pn, pb, lbase, nvalid; };
struct Gemm { const bf16_t* A; const bf16_t* Bt; int K; const int* list; };

struct StaticOrder {
    int nM, nN, nwg, G, c, pnoff, skip0, skipn;
    __device__ void init(int M, int N, int G_, int c_, int pnoff_ = 0, int skip0_ = 1 << 30, int skipn_ = 0) { nM = M / BM; nN = N / BM; nwg = nM * nN; G = G_; c = c_; pnoff = pnoff_; skip0 = skip0_; skipn = skipn_; }
    __device__ bool next(int i, Unit& u) const {
        const long L = (long)i * G + c; if (L >= nwg) return false;
        int wgid = (int)L; { const int q = nwg / NXCD, r = nwg % NXCD, xcd = wgid % NXCD, off = wgid / NXCD; wgid = (xcd < r ? xcd * (q + 1) : r * (q + 1) + (xcd - r) * q) + off; }
        const int nig = WGM * nN, gid = wgid / nig, fm = gid * WGM, gsz = (nM - fm) < WGM ? (nM - fm) : WGM;
        u.pm = fm + ((wgid % nig) % gsz); u.pb = (wgid % nig) / gsz; u.pn = u.pb + pnoff + (u.pb >= skip0 ? skipn : 0); u.lbase = 0; u.nvalid = 0; return true;
    }
};
struct RowOrder {
    int nM, nN, G, c;
    __device__ bool next(int i, Unit& u) const { const int rt = c + (i / nN) * G; if (rt >= nM) return false; u.pm = rt; u.pb = i % nN; u.pn = u.pb; u.lbase = 0; u.nvalid = 0; return true; }
};
struct GroupedOrder {
    const LAS3 int* tb; const LAS3 int* cnt; int G, c; mutable int ecur = 0;
    __device__ bool next(int i, Unit& u) const {
        const int L = i * G + c; const int T = tb[32]; if (L >= T * 4) return false;
        const int t = L >> 2; int e = ecur;
#pragma unroll 1
        while (tb[e + 1] <= t) ++e;
        ecur = e;
        const int ti = t - tb[e];
        u.pm = t; u.pn = e * 4 + (L & 3); u.pb = u.pn; u.lbase = e * 65536 + ti * 256; u.nvalid = cnt[e] - ti * 256; return true;
    }
};

typedef int v8i_t __attribute__((ext_vector_type(8)));
typedef int v4i_t __attribute__((ext_vector_type(4)));
template <bool F8> struct Frag;
template <> struct Frag<false> { bf16x8 v[2]; };
template <> struct Frag<true>  { v8i_t v; };
__device__ __forceinline__ void frag_load(Frag<false>& f, const LAS3 unsigned char* p) { f.v[0] = *(const LAS3 bf16x8*)p; f.v[1] = *(const LAS3 bf16x8*)(p + 1024); }
__device__ __forceinline__ void frag_load(Frag<true>& f, const LAS3 unsigned char* p) { f.v.lo = *(const LAS3 v4i_t*)p; f.v.hi = *(const LAS3 v4i_t*)(p + 1024); }
__device__ __forceinline__ f32x4 frag_mma(const Frag<false>& b, const Frag<false>& a, f32x4 c) { c = __builtin_amdgcn_mfma_f32_16x16x32_bf16(b.v[0], a.v[0], c, 0, 0, 0); return __builtin_amdgcn_mfma_f32_16x16x32_bf16(b.v[1], a.v[1], c, 0, 0, 0); }
__device__ __forceinline__ f32x4 frag_mma(const Frag<true>& b, const Frag<true>& a, f32x4 c) {
    asm volatile("v_mfma_f32_16x16x128_f8f6f4 %0, %1, %2, %0" : "+v"(c) : "v"(b.v), "v"(a.v));
    return c;
}

template <class Epi, class Sched, bool GATHER, bool F8 = false, int TSPLIT = 0>
__device__ __forceinline__ void gemm_phase(LAS3 unsigned char* lds, const Gemm g, const Sched& S, const Epi& E) {
    const int tid = opaque_tid(), wid = __builtin_amdgcn_readfirstlane(tid >> 6), lane = tid & 63, wr = wid >> 2, wc = wid & 3, fr = lane & 15, fq = lane >> 4;
    const int K = F8 ? g.K : g.K * 2, nt = K / (BK * 2);
    unsigned voffA[2], voffB[2]; int Rr[2], Cc[2];
#pragma unroll
    for (int i = 0; i < 2; ++i) { int R, C; stage_rc(tid * 16 + i * 8192, R, C); const int Rb = Epi::PERM ? ((R & ~31) + perm32(R & 31)) : R; Rr[i] = R; Cc[i] = C;
        voffA[i] = (unsigned)(R * K + C * 2); voffB[i] = (unsigned)(Rb * K + C * 2); }
    const size_t kstep = (size_t)(BK * 2);
    const size_t hstep = (size_t)HALF * K;
    const size_t tstep = 2 * hstep;
    const unsigned ldsw = (unsigned)wid * 1024u;
    const int aoff = lds_byte(wr * 64 + fr, fq * 8), boff = lds_byte(wc * 32 + fr, fq * 8);
#define PG_SA(b, h) (((b) * 2 + (h)) * HTB)
#define PG_SB(b, h) ((4 + (b) * 2 + (h)) * HTB)
#define PG_STAGE(bufoff, gbase, voff) do { _Pragma("unroll") for (int _i = 0; _i < 2; ++_i) \
        __builtin_amdgcn_global_load_lds((const unsigned*)((const char*)(gbase) + (voff)[_i]), (LAS3 unsigned*)(lds + (bufoff) + ldsw + _i * 8192), 16, 0, 0); } while (0)
#define PG_STAGE2(bufoff, gbase, o0, o1) do { \
        __builtin_amdgcn_global_load_lds((const unsigned*)((const char*)(gbase) + (o0)), (LAS3 unsigned*)(lds + (bufoff) + ldsw), 16, 0, 0); \
        __builtin_amdgcn_global_load_lds((const unsigned*)((const char*)(gbase) + (o1)), (LAS3 unsigned*)(lds + (bufoff) + ldsw + 8192), 16, 0, 0); } while (0)
#define PG_LDA(dst, b, h) do { _Pragma("unroll") for (int m = 0; m < 4; ++m) frag_load(dst[m], lds + PG_SA(b, h) + aoff + m * 2048); } while (0)
#define PG_LDB(dst, b, h) do { _Pragma("unroll") for (int n = 0; n < 2; ++n) frag_load(dst[n], lds + PG_SB(b, h) + boff + n * 2048); } while (0)
#define PG_MMA(ai, bj, At, Bt) do { __builtin_amdgcn_s_setprio(1); _Pragma("unroll") for (int m = 0; m < 4; ++m) _Pragma("unroll") for (int n = 0; n < 2; ++n) \
        acc[ai][bj][m][n] = frag_mma(Bt[n], At[m], acc[ai][bj][m][n]); __builtin_amdgcn_s_setprio(0); } while (0)
#define PG_WAIT_V(n) asm volatile("s_waitcnt vmcnt(" #n ")" ::: "memory")
#define PG_WAIT_L(n) asm volatile("s_waitcnt lgkmcnt(" #n ")" ::: "memory")
#define PG_BAR __builtin_amdgcn_s_barrier()
#define PG_SCHED __builtin_amdgcn_sched_barrier(0)
    Unit cur, nxt; int ui = 0;
    if (!S.next(0, cur)) return;
    f32x4 acc[2][2][4][2];
#pragma unroll
    for (int a = 0; a < 2; ++a)
#pragma unroll
        for (int b = 0; b < 2; ++b)
#pragma unroll
            for (int m = 0; m < 4; ++m)
#pragma unroll
                for (int n = 0; n < 2; ++n) acc[a][b][m][n] = (f32x4){0.f, 0.f, 0.f, 0.f};
    Frag<F8> At[4], B0[2], B1[2];
    unsigned gc[2][2] = {{0u, 0u}, {0u, 0u}}, gn[2][2] = {{0u, 0u}, {0u, 0u}};
    auto load_go = [&](const Unit& u, unsigned (&go)[2][2]) {
#pragma unroll
        for (int h = 0; h < 2; ++h)
#pragma unroll
            for (int i = 0; i < 2; ++i) { int r = h * HALF + Rr[i]; r = r < u.nvalid ? r : u.nvalid - 1; const int tok = g.list[u.lbase + r]; go[h][i] = (unsigned)tok * (unsigned)K + (unsigned)(Cc[i] * 2); }
    };
    const char* cA = GATHER ? (const char*)g.A : (const char*)g.A + (size_t)cur.pm * tstep; const char* cB = (const char*)g.Bt + (size_t)cur.pb * tstep;
    if (GATHER) {
        load_go(cur, gc);
#pragma unroll
        for (int h = 0; h < 2; ++h)
#pragma unroll
            for (int i = 0; i < 2; ++i) gn[h][i] = gc[h][i];
        PG_STAGE(PG_SB(0, 0), cB, voffB); PG_STAGE2(PG_SA(0, 0), cA, gc[0][0], gc[0][1]); PG_STAGE(PG_SB(0, 1), cB + hstep, voffB); PG_STAGE2(PG_SA(0, 1), cA, gc[1][0], gc[1][1]);
        if (wr == 1) PG_BAR;
        PG_WAIT_V(4); PG_BAR;
        PG_STAGE(PG_SB(1, 0), cB + kstep, voffB); PG_STAGE2(PG_SA(1, 0), cA + kstep, gc[0][0], gc[0][1]); PG_STAGE(PG_SB(1, 1), cB + hstep + kstep, voffB);
        PG_WAIT_V(6); PG_BAR;
    } else {
        PG_STAGE(PG_SB(0, 0), cB, voffB); PG_STAGE(PG_SA(0, 0), cA, voffA); PG_STAGE(PG_SB(0, 1), cB + hstep, voffB); PG_STAGE(PG_SA(0, 1), cA + hstep, voffA);
        if (wr == 1) PG_BAR;
        PG_WAIT_V(4); PG_BAR;
        PG_STAGE(PG_SB(1, 0), cB + kstep, voffB); PG_STAGE(PG_SA(1, 0), cA + kstep, voffA); PG_STAGE(PG_SB(1, 1), cB + hstep + kstep, voffB);
        PG_WAIT_V(6); PG_BAR;
    }
    for (;;) {
        const bool has_next = S.next(ui + 1, nxt);
        const char* nA = GATHER ? cA : (has_next ? (const char*)g.A + (size_t)nxt.pm * tstep : cA); const char* nB = has_next ? (const char*)g.Bt + (size_t)nxt.pb * tstep : cB;
#pragma unroll 1
        for (int t = 0; t < nt; t += 2) {
            const bool last = (t == nt - 2);
            if (GATHER) { if (last && has_next) load_go(nxt, gn); }
            const char* a1 = cA + (size_t)(t + 1) * kstep;
            const char* a2 = last ? nA : cA + (size_t)(t + 2) * kstep; const char* b2 = last ? nB : cB + (size_t)(t + 2) * kstep;
            const char* a3 = a2 + kstep; const char* b3 = b2 + kstep;
            const bool sel0 = t < TSPLIT;
            PG_LDB(B0, 0, 0); PG_SCHED; PG_LDA(At, 0, 0);
            if (GATHER) PG_STAGE2(PG_SA(1, 1), a1, gc[1][0], gc[1][1]); else PG_STAGE(PG_SA(1, 1), a1 + hstep, voffA);
            PG_WAIT_L(8); PG_BAR; PG_WAIT_L(0); if (!TSPLIT || sel0) PG_MMA(0, 0, At, B0); PG_BAR; PG_SCHED;
            PG_LDB(B1, 0, 1); PG_STAGE(PG_SB(0, 0), b2, voffB);
            PG_BAR; PG_WAIT_L(0); if (!TSPLIT || !sel0) PG_MMA(0, 1, At, B1); PG_BAR;
            PG_LDA(At, 0, 1);
            if (GATHER) PG_STAGE2(PG_SA(0, 0), a2, last ? gn[0][0] : gc[0][0], last ? gn[0][1] : gc[0][1]); else PG_STAGE(PG_SA(0, 0), a2, voffA);
            PG_BAR; PG_WAIT_L(0); if (!TSPLIT || sel0) PG_MMA(1, 0, At, B0); PG_BAR; PG_SCHED;
            PG_STAGE(PG_SB(0, 1), b2 + hstep, voffB);
            PG_WAIT_V(6); PG_BAR; if (!TSPLIT || !sel0) PG_MMA(1, 1, At, B1); PG_BAR;
            PG_LDB(B0, 1, 0); PG_SCHED; PG_LDA(At, 1, 0);
            if (GATHER) PG_STAGE2(PG_SA(0, 1), a2, last ? gn[1][0] : gc[1][0], last ? gn[1][1] : gc[1][1]); else PG_STAGE(PG_SA(0, 1), a2 + hstep, voffA);
            PG_WAIT_L(8); PG_BAR; PG_WAIT_L(0); if (!TSPLIT || sel0) PG_MMA(0, 0, At, B0); PG_BAR; PG_SCHED;
            PG_LDB(B1, 1, 1); PG_STAGE(PG_SB(1, 0), b3, voffB);
            PG_BAR; PG_WAIT_L(0); if (!TSPLIT || !sel0) PG_MMA(0, 1, At, B1); PG_BAR;
            PG_LDA(At, 1, 1);
            if (GATHER) PG_STAGE2(PG_SA(1, 0), a3, last ? gn[0][0] : gc[0][0], last ? gn[0][1] : gc[0][1]); else PG_STAGE(PG_SA(1, 0), a3, voffA);
            PG_BAR; PG_WAIT_L(0); if (!TSPLIT || sel0) PG_MMA(1, 0, At, B0); PG_BAR; PG_SCHED;
            PG_STAGE(PG_SB(1, 1), b3 + hstep, voffB);
            PG_WAIT_V(6); PG_BAR; if (!TSPLIT || !sel0) PG_MMA(1, 1, At, B1); PG_BAR;
        }
        if constexpr (F8) asm volatile("s_nop 15\n\ts_nop 15" ::: "memory");
        E(acc, cur, wr, wc, fr, fq);
        if (!has_next) break;
#pragma unroll
        for (int a = 0; a < 2; ++a)
#pragma unroll
            for (int b = 0; b < 2; ++b)
#pragma unroll
                for (int m = 0; m < 4; ++m)
#pragma unroll
                    for (int n = 0; n < 2; ++n) acc[a][b][m][n] = (f32x4){0.f, 0.f, 0.f, 0.f};
        cur = nxt; cA = nA; cB = nB; ++ui;
        if (GATHER) {
#pragma unroll
            for (int h = 0; h < 2; ++h)
#pragma unroll
                for (int i = 0; i < 2; ++i) gc[h][i] = gn[h][i];
        }
    }
    PG_WAIT_V(0);
    if (wr == 0) PG_BAR;
    PG_BAR;
#undef PG_SA
#undef PG_SB
#undef PG_STAGE
#undef PG_STAGE2
#undef PG_LDA
#undef PG_LDB
#undef PG_MMA
#undef PG_WAIT_V
#undef PG_WAIT_L
#undef PG_BAR
#undef PG_SCHED
}
}

template <class F> __device__ __forceinline__ void epi_rows(int row0, F f) {
#pragma unroll
    for (int ai = 0; ai < 2; ++ai)
#pragma unroll
        for (int m = 0; m < 4; ++m) f(ai, m, row0 + ai * 128 + m * 16);
}
struct EpiProj {
    static constexpr bool PERM = true; char* ws;
    __device__ __forceinline__ void operator()(const f32x4 (&acc)[2][2][4][2], const pg::Unit& u, int wr, int wc, int fr, int fq) const {
        const int row0 = u.pm * 256 + wr * 64 + fr, pn = u.pn, cw = wc * 32 + 8 * fq;
        if (pn < 2) {
            unsigned char* QA = (unsigned char*)(ws + OFF_QA);
            epi_rows(row0, [&](int ai, int m, int tok) { const int b = tok >> 11, s = tok & 2047;
#pragma unroll
                for (int bj = 0; bj < 2; ++bj) { const int col = pn * 256 + bj * 128 + cw, h = col >> 6, d = col & 63;
                    const f32x4 a = acc[ai][bj][m][0] * (QSCALE * W8_INV * D8_SCALE), c = acc[ai][bj][m][1] * (QSCALE * W8_INV * D8_SCALE); u32x2 w; w.x = pk4_fp8(a[0], a[1], a[2], a[3]); w.y = pk4_fp8(c[0], c[1], c[2], c[3]);
                    *(u32x2*)(QA + ((size_t)(b * 8 + h) * SEQ + s) * 64 + d) = w; } });
        } else if (pn == 2) {
            bf16_t* CR = (bf16_t*)(ws + OFF_CR); float* SSQ = (float*)(ws + OFF_SSQ);
            epi_rows(row0, [&](int ai, int m, int tok) { float ss = 0.f;
#pragma unroll
                for (int bj = 0; bj < 2; ++bj) { const f32x4 a = acc[ai][bj][m][0] * W8_INV, b = acc[ai][bj][m][1] * W8_INV;
                    ss += a[0] * a[0] + a[1] * a[1] + a[2] * a[2] + a[3] * a[3] + b[0] * b[0] + b[1] * b[1] + b[2] * b[2] + b[3] * b[3];
                    *(u32x4*)(CR + (size_t)tok * 256 + bj * 128 + cw) = pack8(a, b); }
                ss += __shfl_xor(ss, 16); ss += __shfl_xor(ss, 32);
                if (fq == 0) SSQ[(size_t)tok * 4 + wc] = ss; });
        } else if (pn == 3) {
            bf16_t* QI = (bf16_t*)(ws + OFF_QI);
            epi_rows(row0, [&](int ai, int m, int tok) {
#pragma unroll
                for (int bj = 0; bj < 2; ++bj) *(u32x4*)(QI + (size_t)tok * 256 + bj * 128 + cw) = pack8(acc[ai][bj][m][0] * W8_INV, acc[ai][bj][m][1] * W8_INV); });
        } else if (pn == 4) {
            bf16_t* KI = (bf16_t*)(ws + OFF_KI); float* WI = (float*)(ws + OFF_WI);
            epi_rows(row0, [&](int ai, int m, int tok) { if (cw < 64) *(u32x4*)(KI + (size_t)tok * 64 + cw) = pack8(acc[ai][0][m][0] * W8_INV, acc[ai][0][m][1] * W8_INV);
                       else if (cw == 64) *(f32x4*)(WI + (size_t)tok * 4) = acc[ai][0][m][0] * W8_INV; });
        } else if (pn < 14) {
            const int t9 = pn - 5, qkv = t9 / 3, g = t9 % 3, r = dil_r(g), ls = SEQ / r;
            unsigned char* base = (unsigned char*)(ws + OFF_DIL) + (size_t)qkv * DIL_SZ; const float sc = (qkv == 0 ? QSCALE : 1.0f) * W8_INV * D8_SCALE;
            epi_rows(row0, [&](int ai, int m, int tok) { const int b = tok >> 11, s = tok & 2047, pp = (s % r) * ls + s / r;
#pragma unroll
                for (int bj = 0; bj < 2; ++bj) { const int col = bj * 128 + cw, j = col >> 6, d = col & 63;
                    const f32x4 a = acc[ai][bj][m][0] * sc, c = acc[ai][bj][m][1] * sc; u32x2 w; w.x = pk4_fp8(a[0], a[1], a[2], a[3]); w.y = pk4_fp8(c[0], c[1], c[2], c[3]);
                    *(u32x2*)(base + (((size_t)(g * 4 + j) * BATCH + b) * SEQ + pp) * 64 + d) = w; } });
        } else {
            unsigned char* G = (unsigned char*)(ws + OFF_G);
            epi_rows(row0, [&](int ai, int m, int tok) {
#pragma unroll
                for (int bj = 0; bj < 2; ++bj) { f32x4 a = acc[ai][bj][m][0], b = acc[ai][bj][m][1];
#pragma unroll
                    for (int q = 0; q < 4; ++q) { a[q] = fast_sigmoid(a[q] * W8_INV) * 255.0f; b[q] = fast_sigmoid(b[q] * W8_INV) * 255.0f; }
                    u32x2 w; w.x = pk4_u8(a[0], a[1], a[2], a[3]); w.y = pk4_u8(b[0], b[1], b[2], b[3]);
                    *(u32x2*)(G + (size_t)tok * 2048 + (pn - 14) * 256 + bj * 128 + cw) = w; } });
        }
    }
};
struct EpiKV {
    static constexpr bool PERM = true; char* ws;
    __device__ __forceinline__ void operator()(const f32x4 (&acc)[2][2][4][2], const pg::Unit& u, int wr, int wc, int fr, int fq) const {
        const int row0 = u.pm * 256 + wr * 64 + fr, pn = u.pn, cw = wc * 32 + 8 * fq;
        unsigned char* O = (unsigned char*)(ws + OFF_R1) + (size_t)(pn >> 1) * NTOK * 512; const float* SSQ = (const float*)(ws + OFF_SSQ);
        f32x4 sqv[2][4];
        epi_rows(row0, [&](int ai, int m, int tok) { sqv[ai][m] = *(const f32x4*)(SSQ + (size_t)tok * 4); });
        epi_rows(row0, [&](int ai, int m, int tok) { const int b = tok >> 11, s = tok & 2047; const f32x4 sq = sqv[ai][m]; const float rinv = rsqrtf(((sq[0] + sq[1]) + (sq[2] + sq[3])) * (1.0f / 256.0f) + RMS_EPS);
#pragma unroll
            for (int bj = 0; bj < 2; ++bj) { const int col = (pn & 1) * 256 + bj * 128 + cw, h = col >> 6, d = col & 63;
                const f32x4 a = acc[ai][bj][m][0] * (rinv * D8_SCALE), c = acc[ai][bj][m][1] * (rinv * D8_SCALE); u32x2 w; w.x = pk4_fp8(a[0], a[1], a[2], a[3]); w.y = pk4_fp8(c[0], c[1], c[2], c[3]);
                *(u32x2*)(O + ((size_t)(b * 8 + h) * SEQ + s) * 64 + d) = w; } });
    }
};
struct EpiMix2 {
    static constexpr bool PERM = true; char* ws;
    __device__ __forceinline__ void operator()(const f32x4 (&acc)[2][2][4][2], const pg::Unit& u, int wr, int wc, int fr, int fq) const {
        const int row0 = u.pm * 256 + wr * 64 + fr, col = u.pn * 128 + wc * 32 + 8 * fq;
        unsigned char* MIX = (unsigned char*)(ws + OFF_MIX); const unsigned char* G = (const unsigned char*)(ws + OFF_G); constexpr float I255 = 1.0f / 255.0f;
        u32x2 gav[2][4], gbv[2][4];
        epi_rows(row0, [&](int ai, int m, int tok) { gav[ai][m] = *(const u32x2*)(G + (size_t)tok * 2048 + col); gbv[ai][m] = *(const u32x2*)(G + (size_t)tok * 2048 + 1024 + col); });
        epi_rows(row0, [&](int ai, int m, int tok) {
            const u32x2 ga = gav[ai][m], gb = gbv[ai][m];
            f32x4 a = acc[ai][0][m][0], b = acc[ai][0][m][1]; const f32x4 c = acc[ai][1][m][0], d = acc[ai][1][m][1];
            a[0] = a[0] * (float)(ga.x & 255u) + c[0] * (float)(gb.x & 255u); a[1] = a[1] * (float)((ga.x >> 8) & 255u) + c[1] * (float)((gb.x >> 8) & 255u);
            a[2] = a[2] * (float)((ga.x >> 16) & 255u) + c[2] * (float)((gb.x >> 16) & 255u); a[3] = a[3] * (float)(ga.x >> 24) + c[3] * (float)(gb.x >> 24);
            b[0] = b[0] * (float)(ga.y & 255u) + d[0] * (float)(gb.y & 255u); b[1] = b[1] * (float)((ga.y >> 8) & 255u) + d[1] * (float)((gb.y >> 8) & 255u);
            b[2] = b[2] * (float)((ga.y >> 16) & 255u) + d[2] * (float)((gb.y >> 16) & 255u); b[3] = b[3] * (float)(ga.y >> 24) + d[3] * (float)(gb.y >> 24);
            a = a * (I255 * W8_INV / 16.0f); b = b * (I255 * W8_INV / 16.0f);
            u32x2 w; w.x = pk4_fp8(a[0], a[1], a[2], a[3]); w.y = pk4_fp8(b[0], b[1], b[2], b[3]);
            *(u32x2*)(MIX + (size_t)tok * 1024 + col) = w; });
    }
};
struct EpiOut {
    static constexpr bool PERM = true; char* ws; const float* x;
    __device__ __forceinline__ void operator()(const f32x4 (&acc)[2][2][4][2], const pg::Unit& u, int wr, int wc, int fr, int fq) const {
        const int row0 = u.pm * 256 + wr * 64 + fr, cw = wc * 32 + 8 * fq; bf16_t* D = (bf16_t*)(ws + OFF_H);
        epi_rows(row0, [&](int ai, int m, int tok) {
#pragma unroll
            for (int bj = 0; bj < 2; ++bj) *(u32x4*)(D + (size_t)tok * 1024 + u.pn * 256 + bj * 128 + cw) = pack8(acc[ai][bj][m][0] * W8_INV, acc[ai][bj][m][1] * W8_INV); });
    }
};
struct EpiGU {
    static constexpr bool PERM = true; char* ws;
    __device__ __forceinline__ void operator()(const f32x4 (&acc)[2][2][4][2], const pg::Unit& u, int wr, int wc, int fr, int fq) const {
        const int row0 = u.pm * 256 + wr * 64 + fr, cw = wc * 32 + 8 * fq; unsigned char* HID = (unsigned char*)(ws + OFF_HID);
        epi_rows(row0, [&](int ai, int m, int tok) { f32x4 a = acc[ai][0][m][0] * W8_INV, b = acc[ai][0][m][1] * W8_INV; const f32x4 ua = acc[ai][1][m][0] * W8_INV, ub = acc[ai][1][m][1] * W8_INV;
#pragma unroll
            for (int q = 0; q < 4; ++q) { a[q] = a[q] * fast_sigmoid(a[q]) * ua[q]; b[q] = b[q] * fast_sigmoid(b[q]) * ub[q]; }
            u32x2 w; w.x = pk4_fp8(a[0], a[1], a[2], a[3]); w.y = pk4_fp8(b[0], b[1], b[2], b[3]);
            *(u32x2*)(HID + (size_t)tok * 512 + (u.pn & 3) * 128 + cw) = w; });
    }
};
struct EpiDown {
    static constexpr bool PERM = true; char* ws;
    __device__ __forceinline__ void operator()(const f32x4 (&acc)[2][2][4][2], const pg::Unit& u, int wr, int wc, int fr, int fq) const {
        const int row0 = u.pm * 256 + wr * 64 + fr, cw = wc * 32 + 8 * fq; unsigned char* EO = (unsigned char*)(ws + OFF_EO);
        epi_rows(row0, [&](int ai, int m, int tok) {
#pragma unroll
            for (int bj = 0; bj < 2; ++bj) { const f32x4 a = acc[ai][bj][m][0] * W8_INV, b = acc[ai][bj][m][1] * W8_INV; u32x2 w; w.x = pk4_fp8(a[0], a[1], a[2], a[3]); w.y = pk4_fp8(b[0], b[1], b[2], b[3]);
                *(u32x2*)(EO + (size_t)tok * 1024 + (u.pn & 3) * 256 + bj * 128 + cw) = w; } });
    }
};

DEVI void phase_proj(const Params& p, LAS3 unsigned char* lds) {
    pg::StaticOrder S; S.init(NTOK, 5632, gridDim.x, blockIdx.x);
    pg::gemm_phase<EpiProj, pg::StaticOrder, false, true>(lds, pg::Gemm{(const bf16_t*)(p.ws + OFF_U8), (const bf16_t*)(p.ws + OFF_WT8), 1024, nullptr}, S, EpiProj{p.ws});
}
DEVI void phase_kv(const Params& p, LAS3 unsigned char* lds) {
    pg::StaticOrder S; S.init(NTOK, 1024, gridDim.x, blockIdx.x);
    pg::gemm_phase<EpiKV, pg::StaticOrder, false>(lds, pg::Gemm{(const bf16_t*)(p.ws + OFF_CR), (const bf16_t*)(p.ws + OFF_WKV), 256, nullptr}, S, EpiKV{p.ws});
}
DEVI void phase_mix(const Params& p, LAS3 unsigned char* lds) {
    pg::RowOrder S{NTOK / 256, 8, (int)gridDim.x, (int)blockIdx.x};
    pg::gemm_phase<EpiMix2, pg::RowOrder, false, true, 4>(lds, pg::Gemm{(const bf16_t*)(p.ws + OFF_YA), (const bf16_t*)(p.ws + OFF_WAB), YAB_LD, nullptr}, S, EpiMix2{p.ws});
}
DEVI void phase_out(const Params& p, LAS3 unsigned char* lds) {
    pg::RowOrder S{NTOK / 256, 4, (int)gridDim.x, (int)blockIdx.x};
    pg::gemm_phase<EpiOut, pg::RowOrder, false, true>(lds, pg::Gemm{(const bf16_t*)(p.ws + OFF_MIX), (const bf16_t*)(p.ws + OFF_WOT), 1024, nullptr}, S, EpiOut{p.ws, p.x});
}

DEVI void build_expert_tables(const Params& p, LAS3 unsigned char* lds) {
    LAS3 int* tb = (LAS3 int*)(lds + LDS_TAB); LAS3 int* cnt = tb + 64;
    if (opaque_tid() < 64) {
        const int lane = opaque_tid(); const int c = lane < 32 ? __hip_atomic_load((const int*)(p.ws + OFF_ECNT) + lane, __ATOMIC_RELAXED, __HIP_MEMORY_SCOPE_AGENT) : 0;
        int t = (c + 255) >> 8, incl = t;
#pragma unroll
        for (int o = 1; o < 32; o <<= 1) { const int v = __shfl_up(incl, o); if (lane >= o) incl += v; }
        if (lane < 32) { cnt[lane] = c; tb[lane + 1] = incl; }
        if (lane == 0) tb[0] = 0;
    }
    __syncthreads();
}
DEVI void phase_gu(const Params& p, LAS3 unsigned char* lds) {
    pg::GroupedOrder S; S.tb = (const LAS3 int*)(lds + LDS_TAB); S.cnt = S.tb + 64; S.G = gridDim.x; S.c = blockIdx.x;
    pg::gemm_phase<EpiGU, pg::GroupedOrder, true, true>(lds, pg::Gemm{(const bf16_t*)(p.ws + OFF_TT), (const bf16_t*)(p.ws + OFF_WEXP), 1024, (const int*)(p.ws + OFF_LIST)}, S, EpiGU{p.ws});
}
DEVI void phase_down(const Params& p, LAS3 unsigned char* lds) {
    pg::GroupedOrder S; S.tb = (const LAS3 int*)(lds + LDS_TAB); S.cnt = S.tb + 64; S.G = gridDim.x; S.c = blockIdx.x;
    pg::gemm_phase<EpiDown, pg::GroupedOrder, false, true>(lds, pg::Gemm{(const bf16_t*)(p.ws + OFF_HID), (const bf16_t*)(p.ws + OFF_WDN), 512, nullptr}, S, EpiDown{p.ws});
}

constexpr int LDS_RW   = 0;
constexpr int LDS_LG   = 147456;
constexpr int LDS_LC   = LDS_LG + 8 * 8 * 37 * 4;
constexpr int LDS_RTK  = LDS_LC + 256;
static_assert(LDS_RTK + 256 * 6 * 4 <= LDS_XB, "route phase LDS overflow");
DEVI void phase_route(const Params& p, LAS3 unsigned char* lds) {
    const int tid = opaque_tid(), lane = tid & 63, wv = tid >> 6, G = gridDim.x;
    LAS3 float* rw = (LAS3 float*)(lds + LDS_RW); LAS3 float* lg = (LAS3 float*)(lds + LDS_LG) + wv * 8 * 37;
    LAS3 int* lcnt = (LAS3 int*)(lds + LDS_LC); LAS3 int* gbase = lcnt + 32; LAS3 unsigned* rtk = (LAS3 unsigned*)(lds + LDS_RTK);
    for (int k = tid; k < 1024; k += 512) { const f32x4 v = *(const f32x4*)(p.w_rg + (size_t)k * 4); rw[k] = v[0]; rw[1024 + k] = v[1]; rw[2048 + k] = v[2]; rw[3072 + k] = v[3]; }
#pragma unroll 1
    for (int base = 0; base < 8192; base += 4096) {
        f32x4 t[8];
#pragma unroll
        for (int j = 0; j < 8; ++j) t[j] = *(const f32x4*)(p.w_re + (size_t)(base + j * 512 + tid) * 4);
#pragma unroll
        for (int j = 0; j < 8; ++j) { const int idx = base + j * 512 + tid, row = idx >> 1, g = row >> 10, k = row & 1023, o0 = 4 + g * 8 + (idx & 1) * 4;
#pragma unroll
            for (int e = 0; e < 4; ++e) rw[(o0 + e) * 1024 + k] = t[j][e]; }
    }
    if (tid < 32) lcnt[tid] = 0;
    f32x4 gn[4];
#pragma unroll
    for (int q = 0; q < 4; ++q) gn[q] = *(const f32x4*)(p.ffn_norm + q * 256 + 4 * lane);
    __syncthreads();
    const bf16_t* H = (const bf16_t*)(p.ws + OFF_H); bf16_t* Hw = (bf16_t*)(p.ws + OFF_H); unsigned char* TT = (unsigned char*)(p.ws + OFF_TT);
    for (int chunk = blockIdx.x; chunk < NTOK / 256; chunk += G) {
        const int tokw = chunk * 256 + wv * 32;
        f32x4 nxv[4]; u32x2 ndv[4];
#pragma unroll
        for (int q = 0; q < 4; ++q) { nxv[q] = *(const f32x4*)(p.x + (size_t)tokw * 1024 + q * 256 + 4 * lane); ndv[q] = *(const u32x2*)(H + (size_t)tokw * 1024 + q * 256 + 4 * lane); }
#pragma unroll 1
        for (int sub = 0; sub < 4; ++sub) {
#pragma unroll 1
            for (int tk = 0; tk < 8; ++tk) {
                const int tok = tokw + sub * 8 + tk;
                f32x4 v[4]; float ss = 0.f; u32x2 dcur[4];
#pragma unroll
                for (int q = 0; q < 4; ++q) { v[q] = nxv[q]; dcur[q] = ndv[q]; }
                if (sub * 8 + tk < 31) {
#pragma unroll
                    for (int q = 0; q < 4; ++q) { nxv[q] = *(const f32x4*)(p.x + (size_t)(tok + 1) * 1024 + q * 256 + 4 * lane); ndv[q] = *(const u32x2*)(H + (size_t)(tok + 1) * 1024 + q * 256 + 4 * lane); }
                }
#pragma unroll
                for (int q = 0; q < 4; ++q) { const u32x2 dd = dcur[q];
                    v[q][0] += bflo(dd.x); v[q][1] += bfhi(dd.x); v[q][2] += bflo(dd.y); v[q][3] += bfhi(dd.y); ss += v[q][0] * v[q][0] + v[q][1] * v[q][1] + v[q][2] * v[q][2] + v[q][3] * v[q][3];
                    u32x2 hh; hh.x = cvt_pk_bf16(v[q][0], v[q][1]); hh.y = cvt_pk_bf16(v[q][2], v[q][3]); *(u32x2*)(Hw + (size_t)tok * 1024 + q * 256 + 4 * lane) = hh; }
#pragma unroll
                for (int o = 32; o > 0; o >>= 1) ss += __shfl_xor(ss, o);
                const float rinv = rsqrtf(ss * (1.0f / 1024.0f) + RMS_EPS);
#pragma unroll
                for (int q = 0; q < 4; ++q) { v[q] = v[q] * rinv * gn[q]; *(unsigned*)(TT + (size_t)tok * 1024 + q * 256 + 4 * lane) = pk4_fp8(v[q][0], v[q][1], v[q][2], v[q][3]); }
                float a[36];
#pragma unroll
                for (int o = 0; o < 36; ++o) { float s = 0.f;
#pragma unroll
                    for (int q = 0; q < 4; ++q) { const f32x4 w = *(const LAS3 f32x4*)(rw + o * 1024 + q * 256 + 4 * lane); s += v[q][0] * w[0] + v[q][1] * w[1] + v[q][2] * w[2] + v[q][3] * w[3]; }
                    a[o] = s; }
#pragma unroll
                for (int st = 0; st < 5; ++st) { const int msk = 32 >> st, half = 16 >> st; const bool up = (lane & msk) != 0;
#pragma unroll
                    for (int i = 0; i < half; ++i) { const float lo = a[i], hi = a[i + half]; const float send = up ? lo : hi, keep = up ? hi : lo; a[i] = keep + __shfl_xor(send, msk); } }
                a[0] += __shfl_xor(a[0], 1);
#pragma unroll
                for (int e = 32; e < 36; ++e) {
#pragma unroll
                    for (int o = 32; o > 0; o >>= 1) a[e] += __shfl_xor(a[e], o); }
                if ((lane & 1) == 0) lg[tk * 37 + (lane >> 1)] = a[0];
                if (lane < 4) lg[tk * 37 + 32 + lane] = lane == 0 ? a[32] : (lane == 1 ? a[33] : (lane == 2 ? a[34] : a[35]));
            }
            asm volatile("s_waitcnt lgkmcnt(0)" ::: "memory");
            if (lane < 8) {
                const LAS3 float* l = lg + lane * 37; float gl[4];
#pragma unroll
                for (int g = 0; g < 4; ++g) gl[g] = l[g] + p.b_rg[g];
                int gs = 0;
#pragma unroll
                for (int g = 1; g < 4; ++g) if (gl[g] > gl[gs]) gs = g;
                float den = 0.f;
#pragma unroll
                for (int g = 0; g < 4; ++g) den += expf(gl[g] - gl[gs]);
                const float pg_ = 1.0f / den; float el[8];
#pragma unroll
                for (int e = 0; e < 8; ++e) el[e] = l[4 + gs * 8 + e] + p.b_re[gs * 8 + e];
                int i0 = 0;
#pragma unroll
                for (int e = 1; e < 8; ++e) if (el[e] > el[i0]) i0 = e;
                int i1 = i0 == 0 ? 1 : 0;
#pragma unroll
                for (int e = 0; e < 8; ++e) if (e != i0 && el[e] > el[i1]) i1 = e;
                const float e1 = expf(el[i1] - el[i0]), w0 = pg_ / (1.0f + e1), w1 = pg_ * e1 / (1.0f + e1);
                const int E0 = gs * 8 + i0, E1 = gs * 8 + i1;
                const int s0 = __hip_atomic_fetch_add(lcnt + E0, 1, __ATOMIC_RELAXED, __HIP_MEMORY_SCOPE_WORKGROUP), s1 = __hip_atomic_fetch_add(lcnt + E1, 1, __ATOMIC_RELAXED, __HIP_MEMORY_SCOPE_WORKGROUP);
                LAS3 unsigned* r = rtk + (wv * 32 + sub * 8 + lane) * 6;
                r[0] = (unsigned)E0; r[1] = (unsigned)s0; r[2] = __float_as_uint(w0); r[3] = (unsigned)E1; r[4] = (unsigned)s1; r[5] = __float_as_uint(w1);
            }
        }
        __syncthreads();
        if (tid < 32) { const int n = lcnt[tid]; gbase[tid] = n ? atomicAdd((int*)(p.ws + OFF_ECNT) + tid, n) : 0; lcnt[tid] = 0; }
        __syncthreads();
        if (tid < 256) {
            const int tok = chunk * 256 + tid; const LAS3 unsigned* r = rtk + tid * 6;
            const int E0 = (int)r[0], E1 = (int)r[3], s0 = gbase[E0] + (int)r[1], s1 = gbase[E1] + (int)r[4];
            u32x4 w0; w0.x = (unsigned)E0; w0.y = (unsigned)s0; w0.z = r[2]; w0.w = 0u; u32x4 w1; w1.x = (unsigned)E1; w1.y = (unsigned)s1; w1.z = r[5]; w1.w = 0u;
            unsigned* RT = (unsigned*)(p.ws + OFF_RT) + (size_t)tok * 8; *(u32x4*)RT = w0; *(u32x4*)(RT + 4) = w1;
            int* LIST = (int*)(p.ws + OFF_LIST); LIST[(size_t)E0 * 65536 + s0] = tok; LIST[(size_t)E1 * 65536 + s1] = tok;
        }
        __syncthreads();
    }
}

DEVI void phase_final(const Params& p, LAS3 unsigned char* lds) {
    const LAS3 int* tb = (const LAS3 int*)(lds + LDS_TAB);
    const int lane = opaque_tid() & 63, wv = opaque_tid() >> 6, G = gridDim.x;
    f32x4 gn[4];
#pragma unroll
    for (int q = 0; q < 4; ++q) gn[q] = *(const f32x4*)(p.final_norm + q * 256 + 4 * lane);
    const bf16_t* H = (const bf16_t*)(p.ws + OFF_H); const unsigned char* EO = (const unsigned char*)(p.ws + OFF_EO); const unsigned* RT = (const unsigned*)(p.ws + OFF_RT);
    const int st = G * 8; int tok = blockIdx.x * 8 + wv;
    u32x4 ra[2], rb[2], na[2], nb[2]; u32x2 dv[2][4]; unsigned ea[2][4], eb[2][4];
#pragma unroll
    for (int k = 0; k < 2; ++k) { ra[k] = (u32x4){0, 0, 0, 0}; rb[k] = ra[k]; na[k] = ra[k]; nb[k] = ra[k]; }
#define FIN_LOADR(t_, a_, b_) do { a_ = *(const u32x4*)(RT + (size_t)(t_) * 8); b_ = *(const u32x4*)(RT + (size_t)(t_) * 8 + 4); } while (0)
#define FIN_LOADD(k_, t_, a_, b_) do { const size_t r0_ = (size_t)tb[a_.x] * 256 + a_.y, r1_ = (size_t)tb[b_.x] * 256 + b_.y; \
        _Pragma("unroll") for (int q = 0; q < 4; ++q) { dv[k_][q] = *(const u32x2*)(H + (size_t)(t_) * 1024 + q * 256 + 4 * lane); \
            ea[k_][q] = *(const unsigned*)(EO + r0_ * 1024 + q * 256 + 4 * lane); eb[k_][q] = *(const unsigned*)(EO + r1_ * 1024 + q * 256 + 4 * lane); } } while (0)
#pragma unroll
    for (int k = 0; k < 2; ++k) if (tok + k * st < NTOK) FIN_LOADR(tok + k * st, ra[k], rb[k]);
#pragma unroll
    for (int k = 0; k < 2; ++k) if (tok + k * st < NTOK) { FIN_LOADD(k, tok + k * st, ra[k], rb[k]); if (tok + (2 + k) * st < NTOK) FIN_LOADR(tok + (2 + k) * st, na[k], nb[k]); }
#pragma unroll 1
    for (; tok < NTOK; tok += 2 * st) {
        f32x4 v[2][4]; float ss[2];
#pragma unroll
        for (int k = 0; k < 2; ++k) {
            const float w0 = __uint_as_float(ra[k].z), w1 = __uint_as_float(rb[k].z); ss[k] = 0.f;
#pragma unroll
            for (int q = 0; q < 4; ++q) {
                const f32x2 a01 = __builtin_amdgcn_cvt_pk_f32_fp8(ea[k][q], false), a23 = __builtin_amdgcn_cvt_pk_f32_fp8(ea[k][q], true), b01 = __builtin_amdgcn_cvt_pk_f32_fp8(eb[k][q], false), b23 = __builtin_amdgcn_cvt_pk_f32_fp8(eb[k][q], true);
                v[k][q][0] = bflo(dv[k][q].x) + w0 * a01[0] + w1 * b01[0]; v[k][q][1] = bfhi(dv[k][q].x) + w0 * a01[1] + w1 * b01[1];
                v[k][q][2] = bflo(dv[k][q].y) + w0 * a23[0] + w1 * b23[0]; v[k][q][3] = bfhi(dv[k][q].y) + w0 * a23[1] + w1 * b23[1];
                ss[k] += v[k][q][0] * v[k][q][0] + v[k][q][1] * v[k][q][1] + v[k][q][2] * v[k][q][2] + v[k][q][3] * v[k][q][3];
            }
        }
#pragma unroll
        for (int k = 0; k < 2; ++k) if (tok + (2 + k) * st < NTOK) { ra[k] = na[k]; rb[k] = nb[k]; FIN_LOADD(k, tok + (2 + k) * st, ra[k], rb[k]); if (tok + (4 + k) * st < NTOK) FIN_LOADR(tok + (4 + k) * st, na[k], nb[k]); }
#pragma unroll
        for (int k = 0; k < 2; ++k) if (tok + k * st < NTOK) {
            float s1 = ss[k];
#pragma unroll
            for (int o = 32; o > 0; o >>= 1) s1 += __shfl_xor(s1, o);
            const float rinv = rsqrtf(s1 * (1.0f / 1024.0f) + RMS_EPS);
#pragma unroll
            for (int q = 0; q < 4; ++q) *(f32x4*)(p.out + (size_t)(tok + k * st) * 1024 + q * 256 + 4 * lane) = v[k][q] * rinv * gn[q];
        }
    }
#undef FIN_LOADR
#undef FIN_LOADD
}


typedef float f32x16 __attribute__((ext_vector_type(16)));
typedef short s16x4 __attribute__((ext_vector_type(4)));
#define MFMA32(a, b, c) __builtin_amdgcn_mfma_f32_32x32x16_bf16(a, b, c, 0, 0, 0)
#define MFMA16(a, b, c) __builtin_amdgcn_mfma_f32_16x16x32_bf16(a, b, c, 0, 0, 0)
constexpr float NEGB = -1e30f;
DEVI s16x4 vtr(const LAS3 unsigned char* p) { return __builtin_bit_cast(s16x4, __builtin_amdgcn_ds_read_tr16_b64_v4i16((LAS3 s16x4*)p)); }
DEVI float max3f(float a, float b, float c) { return __builtin_fmaxf(__builtin_fmaxf(a, b), c); }

constexpr int TK_STRIDE = 2052;
DEVI unsigned fkey(float f) { const unsigned u = __float_as_uint(f); return u ^ ((u >> 31) ? 0xFFFFFFFFu : 0x80000000u); }
DEVI int wave_sum_pair(int a, int b, int& sumb) {
    int v = a | (b << 16);
    v += __builtin_amdgcn_update_dpp(0, v, 0xB1, 0xF, 0xF, true);
    v += __builtin_amdgcn_update_dpp(0, v, 0x4E, 0xF, 0xF, true);
    v += __builtin_amdgcn_update_dpp(0, v, 0x141, 0xF, 0xF, true);
    v += __builtin_amdgcn_update_dpp(0, v, 0x140, 0xF, 0xF, true);
    const int t = __builtin_amdgcn_readlane(v, 0) + __builtin_amdgcn_readlane(v, 16) + __builtin_amdgcn_readlane(v, 32) + __builtin_amdgcn_readlane(v, 48);
    sumb = (int)((unsigned)t >> 16); return t & 0xFFFF;
}
DEVI void phase_topk(const Params& p, LAS3 unsigned char* lds) {
    LAS3 float* sc = (LAS3 float*)lds;
    const int tid = opaque_tid(), lane = tid & 63, wv = __builtin_amdgcn_readfirstlane(tid >> 6), r16 = lane & 15, g4 = lane >> 4;
    const bf16_t* QI = (const bf16_t*)(p.ws + OFF_QI); const bf16_t* KI = (const bf16_t*)(p.ws + OFF_KI); const float* WI = (const float*)(p.ws + OFF_WI);
    unsigned* SEL = (unsigned*)(p.ws + OFF_SEL);
#define TK_UNIT(u_, b_, t0_) do { b_ = (u_) >> 7; t0_ = ((((u_) & 127) + 8 * ((u_) >> 8)) & 127) * 16; } while (0)
#define TK_LOADQ(b_, t0_) do { const bf16_t* qrow = QI + (size_t)((b_) * SEQ + (t0_) + r16) * 256 + 8 * g4; \
        _Pragma("unroll") for (int h = 0; h < 4; ++h) { qf[h][0] = *(const bf16x8*)(qrow + h * 64); qf[h][1] = *(const bf16x8*)(qrow + h * 64 + 32); } \
        w4 = *(const f32x4*)(WI + (size_t)((b_) * SEQ + (t0_) + r16) * 4); } while (0)
#define TK_LOADK(dst, kb_, gi_) do { const bf16_t* kp_ = (kb_) + (size_t)(gi_) * 4096; \
        _Pragma("unroll") for (int j = 0; j < 4; ++j) { dst[j][0] = *(const bf16x8*)(kp_ + j * 1024); dst[j][1] = *(const bf16x8*)(kp_ + j * 1024 + 32); } } while (0)
    bf16x8 qf[4][2]; f32x4 w4; bf16x8 kf[4][2];
    int u = blockIdx.x, b = 0, t0 = 0;
    if (u < NTOK / 16) { TK_UNIT(u, b, t0); TK_LOADQ(b, t0); if (wv * 64 < t0 + 16) TK_LOADK(kf, KI + (size_t)(b * SEQ + r16) * 64 + 8 * g4, wv); }
    for (; u < NTOK / 16; u += gridDim.x) {
        const int tokb = b * SEQ, nkey = t0 + 16;
        const bf16_t* kbase = KI + (size_t)(tokb + r16) * 64 + 8 * g4;
        const float wq[4] = {w4[0], w4[1], w4[2], w4[3]};
#pragma unroll 1
        for (int gi = wv; gi * 64 < nkey; gi += 8) {
            bf16x8 cf[4][2];
#pragma unroll
            for (int j = 0; j < 4; ++j) { cf[j][0] = kf[j][0]; cf[j][1] = kf[j][1]; }
            if ((gi + 8) * 64 < nkey) TK_LOADK(kf, kbase, gi + 8);
#pragma unroll
            for (int j = 0; j < 4; ++j) {
                f32x4 s = (f32x4){0.f, 0.f, 0.f, 0.f};
#pragma unroll
                for (int h = 0; h < 4; ++h) { f32x4 a = (f32x4){0.f, 0.f, 0.f, 0.f}; a = MFMA16(cf[j][0], qf[h][0], a); a = MFMA16(cf[j][1], qf[h][1], a);
#pragma unroll
                    for (int e = 0; e < 4; ++e) s[e] += wq[h] * __builtin_fmaxf(a[e], 0.f); }
#pragma unroll
                for (int e = 0; e < 4; ++e) s[e] = (s[e] == 0.f) ? 0.f : s[e];
                *(LAS3 f32x4*)(sc + r16 * TK_STRIDE + gi * 64 + j * 16 + 4 * g4) = s;
            }
        }
        const int un = u + gridDim.x; int bn = 0, t0n = 0;
        if (un < NTOK / 16) { TK_UNIT(un, bn, t0n); TK_LOADQ(bn, t0n); if (wv * 64 < t0n + 16) TK_LOADK(kf, KI + (size_t)(bn * SEQ + r16) * 64 + 8 * g4, wv); }
        __syncthreads();
#pragma unroll 1
        for (int qq = 0; qq < 2; ++qq) {
            const int q = 2 * wv + qq, t = t0 + q, n = t + 1; const LAS3 float* row = sc + q * TK_STRIDE;
            const int nv = (n - lane + 63) >> 6; const unsigned valid = nv >= 32 ? 0xFFFFFFFFu : (nv <= 0 ? 0u : ((1u << nv) - 1u));
            unsigned sel = valid;
            if (n > 256) {
                unsigned a[32];
#pragma unroll
                for (int i = 0; i < 32; ++i) a[i] = __float_as_uint(row[i * 64 + lane]);
#pragma unroll
                for (int k = 0; k < 16; ++k) { const unsigned x = a[k], y = a[k + 16]; a[k] = __builtin_amdgcn_perm(y, x, 0x05040100u); a[k + 16] = __builtin_amdgcn_perm(y, x, 0x07060302u); }
#pragma unroll
                for (int k = 0; k < 32; ++k) if (!(k & 8)) { const unsigned x = a[k], y = a[k + 8]; a[k] = __builtin_amdgcn_perm(y, x, 0x06020400u); a[k + 8] = __builtin_amdgcn_perm(y, x, 0x07030501u); }
#pragma unroll
                for (int k = 0; k < 32; ++k) if (!(k & 4)) { const unsigned x = a[k], y = a[k + 4]; a[k] = (x & 0x0F0F0F0Fu) | ((y << 4) & 0xF0F0F0F0u); a[k + 4] = ((x >> 4) & 0x0F0F0F0Fu) | (y & 0xF0F0F0F0u); }
#pragma unroll
                for (int k = 0; k < 32; ++k) if (!(k & 2)) { const unsigned x = a[k], y = a[k + 2]; a[k] = (x & 0x33333333u) | ((y << 2) & 0xCCCCCCCCu); a[k + 2] = ((x >> 2) & 0x33333333u) | (y & 0xCCCCCCCCu); }
#pragma unroll
                for (int k = 0; k < 32; ++k) if (!(k & 1)) { const unsigned x = a[k], y = a[k + 1]; a[k] = (x & 0x55555555u) | ((y << 1) & 0xAAAAAAAAu); a[k + 1] = ((x >> 1) & 0x55555555u) | (y & 0xAAAAAAAAu); }
                { const unsigned sg = a[31];
#pragma unroll
                  for (int bb = 0; bb < 31; ++bb) a[bb] ^= sg;
                  a[31] = ~sg; }
                unsigned alive = valid, gt = 0u; int above = 0; bool exact = false;
#pragma unroll
                for (int bb = 31; bb >= 0; --bb) {
                    if (!exact) {
                        const unsigned ones = alive & a[bb];
                        int dummy; const int c = wave_sum_pair(__builtin_popcount(ones), 0, dummy);
                        if (above + c >= 256) { alive = ones; if (above + c == 256) exact = true; }
                        else { above += c; gt |= ones; alive &= ~a[bb]; }
                    }
                }
                sel = gt | alive;
                if (!exact) {
                    int need = 256 - above; unsigned tsel = 0u;
#pragma unroll 1
                    for (int i = 0; i < 32 && need > 0; ++i) {
                        unsigned long long m = __ballot((alive >> i) & 1u); const int c = __builtin_popcountll(m);
                        if (c <= need) { need -= c; }
                        else { unsigned long long keep = 0ull; for (int k2 = 0; k2 < need; ++k2) { const unsigned long long low = m & (~m + 1ull); keep |= low; m ^= low; } m = keep; need = 0; }
                        if ((m >> lane) & 1ull) tsel |= 1u << i;
                    }
                    sel = gt | tsel;
                }
            }
            unsigned long long mine = 0ull;
#pragma unroll
            for (int i = 0; i < 32; ++i) { const unsigned long long m = __ballot((sel >> i) & 1u); mine = (lane == i) ? m : mine; }
            if (lane < 32) *(unsigned long long*)(SEL + (size_t)(tokb + t) * 64 + 2 * lane) = mine;
        }
        __syncthreads();
        b = bn; t0 = t0n;
    }
#undef TK_UNIT
#undef TK_LOADQ
#undef TK_LOADK
}

struct AttnState { f32x16 o0, o1; float m, l, mx; };
struct AttnState8 { f32x16 o0, o1, ol; float m, mx, l; };
DEVI int crow16(int r) { return (r & 3) + 8 * (r >> 2); }
typedef __bf16 bf16x2v __attribute__((ext_vector_type(2)));
#define BFE1(w_, P_) ({ unsigned r_; asm("v_bfe_i32 %0, %1, " #P_ ", 1" : "=v"(r_) : "v"(w_)); r_; })
template <bool TAB4>
DEVI void attn_tile(AttnState& st, bool& zref, const bf16x8 (&qr)[4], const LAS3 unsigned char* kp  , const LAS3 unsigned char* vp  ,
                    const LAS3 float* tq, unsigned w0, unsigned w1  ) {
    f32x16 s0, s1;
    if constexpr (TAB4) {
#pragma unroll
        for (int g = 0; g < 4; ++g) { const f32x4 a = *(const LAS3 f32x4*)(tq + 8 * g), b = *(const LAS3 f32x4*)(tq + 32 + 8 * g);
#pragma unroll
            for (int e = 0; e < 4; ++e) { s0[4 * g + e] = a[e]; s1[4 * g + e] = b[e]; } }
    } else {
#pragma unroll
        for (int r = 0; r < 16; ++r) { s0[r] = tq[63 - crow16(r)]; s1[r] = tq[31 - crow16(r)]; }
    }
    bf16x8 kf[8];
#pragma unroll
    for (int d0 = 0; d0 < 4; ++d0) { kf[2 * d0] = *(const LAS3 bf16x8*)(kp + d0 * 2048); kf[2 * d0 + 1] = *(const LAS3 bf16x8*)(kp + d0 * 2048 + 512); }
#pragma unroll
    for (int d0 = 0; d0 < 4; ++d0) { s0 = MFMA32(kf[2 * d0], qr[d0], s0); s1 = MFMA32(kf[2 * d0 + 1], qr[d0], s1); }
    s16x4 vq[16];
#pragma unroll
    for (int s = 0; s < 4; ++s) { vq[4 * s] = vtr(vp + s * 1024); vq[4 * s + 1] = vtr(vp + s * 1024 + 512); vq[4 * s + 2] = vtr(vp + 4096 + s * 1024); vq[4 * s + 3] = vtr(vp + 4096 + s * 1024 + 512); }
    float mx = max3f(s0[0], s0[1], s1[0]);
#pragma unroll
    for (int r = 1; r < 16; r += 2) mx = max3f(mx, s0[r], r + 1 < 16 ? s0[r + 1] : s0[r]);
#pragma unroll
    for (int r = 1; r < 16; r += 2) mx = max3f(mx, s1[r], r + 1 < 16 ? s1[r + 1] : s1[r]);
    { auto rr = __builtin_amdgcn_permlane32_swap(__float_as_uint(mx), __float_as_uint(mx), false, false); mx = __builtin_fmaxf(__uint_as_float(rr[0]), __uint_as_float(rr[1])); }
    const float runmx = __builtin_fmaxf(st.mx, mx), refm = st.m, dlt = runmx - refm; st.mx = runmx;
    float mref = refm;
    if (__any(dlt > 40.f || (dlt < -80.f && runmx > -1e29f))) {
        const bool mv = dlt > 40.f || (dlt < -80.f && runmx > -1e29f); const float alpha = mv ? __builtin_amdgcn_exp2f(refm - runmx) : 1.0f;
        mref = mv ? runmx : refm; st.m = mref; st.l *= alpha; zref = false;
#pragma unroll
        for (int r = 0; r < 16; ++r) { st.o0[r] *= alpha; st.o1[r] *= alpha; }
    }
    if (zref) {
#pragma unroll
        for (int r = 0; r < 16; ++r) { s0[r] = __builtin_amdgcn_exp2f(s0[r]); s1[r] = __builtin_amdgcn_exp2f(s1[r]); }
    } else {
#pragma unroll
        for (int r = 0; r < 16; ++r) { s0[r] = __builtin_amdgcn_exp2f(s0[r] - mref); s1[r] = __builtin_amdgcn_exp2f(s1[r] - mref); }
    }
#define MSK1(S_, r_, w_, P_) S_[r_] = __uint_as_float(__float_as_uint(S_[r_]) & BFE1(w_, P_))
    MSK1(s0, 0, w0, 0); MSK1(s0, 1, w0, 1); MSK1(s0, 2, w0, 2); MSK1(s0, 3, w0, 3); MSK1(s0, 4, w0, 8); MSK1(s0, 5, w0, 9); MSK1(s0, 6, w0, 10); MSK1(s0, 7, w0, 11); MSK1(s0, 8, w0, 16); MSK1(s0, 9, w0, 17); MSK1(s0, 10, w0, 18); MSK1(s0, 11, w0, 19); MSK1(s0, 12, w0, 24); MSK1(s0, 13, w0, 25); MSK1(s0, 14, w0, 26); MSK1(s0, 15, w0, 27);
    MSK1(s1, 0, w1, 0); MSK1(s1, 1, w1, 1); MSK1(s1, 2, w1, 2); MSK1(s1, 3, w1, 3); MSK1(s1, 4, w1, 8); MSK1(s1, 5, w1, 9); MSK1(s1, 6, w1, 10); MSK1(s1, 7, w1, 11); MSK1(s1, 8, w1, 16); MSK1(s1, 9, w1, 17); MSK1(s1, 10, w1, 18); MSK1(s1, 11, w1, 19); MSK1(s1, 12, w1, 24); MSK1(s1, 13, w1, 25); MSK1(s1, 14, w1, 26); MSK1(s1, 15, w1, 27);
#undef MSK1
    u32x4 pw[4];
#pragma unroll
    for (int q = 0; q < 4; ++q) { pw[0][q] = cvt_pk_bf16(s0[2 * q], s0[2 * q + 1]); pw[1][q] = cvt_pk_bf16(s0[8 + 2 * q], s0[8 + 2 * q + 1]);
                                  pw[2][q] = cvt_pk_bf16(s1[2 * q], s1[2 * q + 1]); pw[3][q] = cvt_pk_bf16(s1[8 + 2 * q], s1[8 + 2 * q + 1]); }
    { float l0 = st.l, l1 = 0.f, l2 = 0.f, l3 = 0.f;
#pragma unroll
      for (int r = 0; r < 16; r += 2) { l0 = fadd1(l0, s0[r]); l1 = fadd1(l1, s0[r + 1]); l2 = fadd1(l2, s1[r]); l3 = fadd1(l3, s1[r + 1]); }
      st.l = fadd1(fadd1(l0, l1), fadd1(l2, l3)); }
#pragma unroll
    for (int s = 0; s < 4; ++s) {
        const s16x4 a0 = vq[4 * s], a1 = vq[4 * s + 1], c0 = vq[4 * s + 2], c1 = vq[4 * s + 3];
        const bf16x8 v0 = (bf16x8){a0[0], a0[1], a0[2], a0[3], a1[0], a1[1], a1[2], a1[3]}, v1 = (bf16x8){c0[0], c0[1], c0[2], c0[3], c1[0], c1[1], c1[2], c1[3]};
        const bf16x8 pf = __builtin_bit_cast(bf16x8, pw[s]);
        st.o0 = MFMA32(v0, pf, st.o0); st.o1 = MFMA32(v1, pf, st.o1);
    }
}
template <bool TAB4, int MASK = 2, bool OLM = true>
DEVI void attn_tile8(AttnState8& st, bool& zref, const pg::v8i_t& q8, const LAS3 unsigned char* kp  , const LAS3 unsigned char* vp  ,
                    const LAS3 float* tq, unsigned w0, unsigned w1  , const LAS3 unsigned char* lut = nullptr) {
    f32x16 s0, s1;
    if constexpr (TAB4) {
#pragma unroll
        for (int g = 0; g < 4; ++g) { const f32x4 a = *(const LAS3 f32x4*)(tq + 8 * g), b = *(const LAS3 f32x4*)(tq + 32 + 8 * g);
#pragma unroll
            for (int e = 0; e < 4; ++e) { s0[4 * g + e] = a[e]; s1[4 * g + e] = b[e]; } }
    } else {
#pragma unroll
        for (int r = 0; r < 16; ++r) { s0[r] = tq[63 - crow16(r)]; s1[r] = tq[31 - crow16(r)]; }
    }
    pg::v8i_t kA, kB;
    kA.lo = *(const LAS3 pg::v4i_t*)kp; kA.hi = *(const LAS3 pg::v4i_t*)(kp + 1024); kB.lo = *(const LAS3 pg::v4i_t*)(kp + 512); kB.hi = *(const LAS3 pg::v4i_t*)(kp + 1024 + 512);
    s0 = __builtin_amdgcn_mfma_scale_f32_32x32x64_f8f6f4(kA, q8, s0, 0, 0, 0, 0x7C7C7C7C, 0, 0x7C7C7C7C);
    s1 = __builtin_amdgcn_mfma_scale_f32_32x32x64_f8f6f4(kB, q8, s1, 0, 0, 0, 0x7C7C7C7C, 0, 0x7C7C7C7C);
    s16x4 vq[16];
#pragma unroll
    for (int s = 0; s < 4; ++s) { vq[4 * s] = vtr(vp + s * 1024); vq[4 * s + 1] = vtr(vp + s * 1024 + 512); vq[4 * s + 2] = vtr(vp + 4096 + s * 1024); vq[4 * s + 3] = vtr(vp + 4096 + s * 1024 + 512); }
    u32x2 pm[8];
    if constexpr (MASK == 2) {
#pragma unroll
        for (int j = 0; j < 4; ++j) { pm[j] = *(const LAS3 u32x2*)(lut + ((w0 >> (8 * j)) & 0xFFu) * 8); pm[4 + j] = *(const LAS3 u32x2*)(lut + ((w1 >> (8 * j)) & 0xFFu) * 8); }
    }
    float mx = max3f(s0[0], s0[1], s1[0]);
#pragma unroll
    for (int r = 1; r < 16; r += 2) mx = max3f(mx, s0[r], r + 1 < 16 ? s0[r + 1] : s0[r]);
#pragma unroll
    for (int r = 1; r < 16; r += 2) mx = max3f(mx, s1[r], r + 1 < 16 ? s1[r + 1] : s1[r]);
    { auto rr = __builtin_amdgcn_permlane32_swap(__float_as_uint(mx), __float_as_uint(mx), false, false); mx = __builtin_fmaxf(__uint_as_float(rr[0]), __uint_as_float(rr[1])); }
    const float runmx = __builtin_fmaxf(st.mx, mx), refm = st.m, dlt = runmx - refm; st.mx = runmx;
    float mref = refm;
    if (__any(dlt > 40.f || (dlt < -80.f && runmx > -1e29f))) {
        const bool mv = dlt > 40.f || (dlt < -80.f && runmx > -1e29f); const float alpha = mv ? __builtin_amdgcn_exp2f(refm - runmx) : 1.0f;
        mref = mv ? runmx : refm; st.m = mref; zref = false;
#pragma unroll
        for (int r = 0; r < 16; ++r) { st.o0[r] *= alpha; st.o1[r] *= alpha; if constexpr (OLM) st.ol[r] *= alpha; }
        if constexpr (!OLM) st.l *= alpha;
    }
    if (zref) {
#pragma unroll
        for (int r = 0; r < 16; ++r) { s0[r] = __builtin_amdgcn_exp2f(s0[r]); s1[r] = __builtin_amdgcn_exp2f(s1[r]); }
    } else {
#pragma unroll
        for (int r = 0; r < 16; ++r) { s0[r] = __builtin_amdgcn_exp2f(s0[r] - mref); s1[r] = __builtin_amdgcn_exp2f(s1[r] - mref); }
    }
#define MSK1(S_, r_, w_, P_) S_[r_] = __uint_as_float(__float_as_uint(S_[r_]) & BFE1(w_, P_))
    if constexpr (MASK == 1) {
    MSK1(s0, 0, w0, 0); MSK1(s0, 1, w0, 1); MSK1(s0, 2, w0, 2); MSK1(s0, 3, w0, 3); MSK1(s0, 4, w0, 8); MSK1(s0, 5, w0, 9); MSK1(s0, 6, w0, 10); MSK1(s0, 7, w0, 11); MSK1(s0, 8, w0, 16); MSK1(s0, 9, w0, 17); MSK1(s0, 10, w0, 18); MSK1(s0, 11, w0, 19); MSK1(s0, 12, w0, 24); MSK1(s0, 13, w0, 25); MSK1(s0, 14, w0, 26); MSK1(s0, 15, w0, 27);
    MSK1(s1, 0, w1, 0); MSK1(s1, 1, w1, 1); MSK1(s1, 2, w1, 2); MSK1(s1, 3, w1, 3); MSK1(s1, 4, w1, 8); MSK1(s1, 5, w1, 9); MSK1(s1, 6, w1, 10); MSK1(s1, 7, w1, 11); MSK1(s1, 8, w1, 16); MSK1(s1, 9, w1, 17); MSK1(s1, 10, w1, 18); MSK1(s1, 11, w1, 19); MSK1(s1, 12, w1, 24); MSK1(s1, 13, w1, 25); MSK1(s1, 14, w1, 26); MSK1(s1, 15, w1, 27);
    }
#undef MSK1
    u32x4 pw[4];
#pragma unroll
    for (int q = 0; q < 4; ++q) { pw[0][q] = cvt_pk_bf16(s0[2 * q], s0[2 * q + 1]); pw[1][q] = cvt_pk_bf16(s0[8 + 2 * q], s0[8 + 2 * q + 1]);
                                  pw[2][q] = cvt_pk_bf16(s1[2 * q], s1[2 * q + 1]); pw[3][q] = cvt_pk_bf16(s1[8 + 2 * q], s1[8 + 2 * q + 1]); }
    if constexpr (MASK == 2) {
#pragma unroll
        for (int t = 0; t < 4; ++t) { pw[t][0] &= pm[2 * t].x; pw[t][1] &= pm[2 * t].y; pw[t][2] &= pm[2 * t + 1].x; pw[t][3] &= pm[2 * t + 1].y; }
    }
    if constexpr (!OLM) { float l0 = st.l, l1 = 0.f, l2 = 0.f, l3 = 0.f;
#pragma unroll
      for (int r = 0; r < 16; r += 2) { l0 = fadd1(l0, s0[r]); l1 = fadd1(l1, s0[r + 1]); l2 = fadd1(l2, s1[r]); l3 = fadd1(l3, s1[r + 1]); }
      st.l = fadd1(fadd1(l0, l1), fadd1(l2, l3)); }
    const bf16x8 ones = (bf16x8){(short)0x3F80, (short)0x3F80, (short)0x3F80, (short)0x3F80, (short)0x3F80, (short)0x3F80, (short)0x3F80, (short)0x3F80};
#pragma unroll
    for (int s = 0; s < 4; ++s) {
        const s16x4 a0 = vq[4 * s], a1 = vq[4 * s + 1], c0 = vq[4 * s + 2], c1 = vq[4 * s + 3];
        const bf16x8 v0 = (bf16x8){a0[0], a0[1], a0[2], a0[3], a1[0], a1[1], a1[2], a1[3]}, v1 = (bf16x8){c0[0], c0[1], c0[2], c0[3], c1[0], c1[1], c1[2], c1[3]};
        const bf16x8 pf = __builtin_bit_cast(bf16x8, pw[s]);
        st.o0 = MFMA32(v0, pf, st.o0); st.o1 = MFMA32(v1, pf, st.o1); if constexpr (OLM) st.ol = MFMA32(ones, pf, st.ol);
    }
}
DEVI float attn_finish8l(AttnState8& st, float& lse2) {
    auto rr = __builtin_amdgcn_permlane32_swap(__float_as_uint(st.l), __float_as_uint(st.l), false, false);
    const float l = __uint_as_float(rr[0]) + __uint_as_float(rr[1]); lse2 = st.m + __builtin_amdgcn_logf(l);
    return __builtin_amdgcn_rcpf(l);
}
DEVI float attn_finish8(AttnState8& st, float& lse2) {
    const float l = st.ol[0]; lse2 = st.m + __builtin_amdgcn_logf(l);
    return __builtin_amdgcn_rcpf(l);
}
DEVI float attn_finish(AttnState& st, float& lse2) {
    auto rr = __builtin_amdgcn_permlane32_swap(__float_as_uint(st.l), __float_as_uint(st.l), false, false);
    const float l = __uint_as_float(rr[0]) + __uint_as_float(rr[1]); lse2 = st.m + __builtin_amdgcn_logf(l);
    return __builtin_amdgcn_rcpf(l);
}
template <class ST> DEVI void attn_store(const ST& st, float rl, bf16_t* rowp, int hi) {
#pragma unroll
    for (int g = 0; g < 4; ++g) {
        u32x2 a, b; a.x = cvt_pk_bf16(st.o0[4 * g] * rl, st.o0[4 * g + 1] * rl); a.y = cvt_pk_bf16(st.o0[4 * g + 2] * rl, st.o0[4 * g + 3] * rl);
        b.x = cvt_pk_bf16(st.o1[4 * g] * rl, st.o1[4 * g + 1] * rl); b.y = cvt_pk_bf16(st.o1[4 * g + 2] * rl, st.o1[4 * g + 3] * rl);
        *(u32x2*)(rowp + 8 * g + 4 * hi) = a; *(u32x2*)(rowp + 32 + 8 * g + 4 * hi) = b;
    }
}

constexpr float Y8_SCALE = 16.0f;
template <class ST> DEVI void attn_store8(const ST& st, float rl, unsigned char* rowp, int hi) {
    const float f = rl * Y8_SCALE;
#pragma unroll
    for (int g = 0; g < 4; ++g) {
        *(unsigned*)(rowp + 8 * g + 4 * hi) = pk4_fp8(st.o0[4 * g] * f, st.o0[4 * g + 1] * f, st.o0[4 * g + 2] * f, st.o0[4 * g + 3] * f);
        *(unsigned*)(rowp + 32 + 8 * g + 4 * hi) = pk4_fp8(st.o1[4 * g] * f, st.o1[4 * g + 1] * f, st.o1[4 * g + 2] * f, st.o1[4 * g + 3] * f);
    }
}

constexpr int DS_K = 0, DS_V = 32768, DS_TAB = 65536, DS_CS = 2128, DS_LUT = 100352;
DEVI void dsa_unit(const Params& p, LAS3 unsigned char* lds, int b, int h, int qb, bool build_tab) {
    const int tid = opaque_tid(), lane = tid & 63, wv = __builtin_amdgcn_readfirstlane(tid >> 6), r32 = lane & 31, hi = lane >> 5;
    const unsigned char* QA = (const unsigned char*)(p.ws + OFF_QA); const unsigned char* KA = (const unsigned char*)(p.ws + OFF_R1); const unsigned char* VA = KA + (size_t)NTOK * 512;
    const unsigned* SEL = (const unsigned*)(p.ws + OFF_SEL);
    LAS3 float* tab = (LAS3 float*)(lds + DS_TAB);
    __syncthreads();
    if (build_tab && tid < 256) { u32x2 e; e.x = ((tid & 1) ? 0xFFFFu : 0u) | ((tid & 2) ? 0xFFFF0000u : 0u); e.y = ((tid & 4) ? 0xFFFFu : 0u) | ((tid & 8) ? 0xFFFF0000u : 0u); *(LAS3 u32x2*)(lds + DS_LUT + tid * 8) = e; }
    if (build_tab)
    {   const float bb = p.rel_bias[(lane & 31) * 20 + h] * LOG2E;
        for (int i = tid; i < 4 * 2112 + 511; i += 512) { const int ii = i < 4 * 2112 ? i : 0, c = ii / 2112, j = ii % 2112, dist = (2111 - j) - 64; const float v = __shfl(bb, rel_bucket(dist < 0 ? 0 : dist));
            if (i < 4 * 2112) tab[c * DS_CS + j + c] = dist < 0 ? 0.f : v; } }
    const size_t hb = (size_t)(b * 8 + h) * SEQ; const int q0 = qb * 256, qw = q0 + 32 * wv, NT2 = 2 * qb + 2, mylast = 4 * qb + (wv >> 1);
    pg::v8i_t q8;
    q8.lo = *(const pg::v4i_t*)(QA + (hb + qw + r32) * 64 + 32 * hi); q8.hi = *(const pg::v4i_t*)(QA + (hb + qw + r32) * 64 + 32 * hi + 16);
    AttnState8 st; st.m = 0.f; st.mx = NEGB; bool zref = true;
#pragma unroll
    for (int r = 0; r < 16; ++r) { st.o0[r] = 0.f; st.o1[r] = 0.f; st.ol[r] = 0.f; }
    const unsigned char* ksrc = KA + (hb + (wv >> 2) * 64 + lane) * 64 + (wv & 3) * 16; const unsigned char* vsrc = VA + (hb + 16 * (wv & 3) + (lane >> 2)) * 64 + (wv >> 2) * 32 + (lane & 3) * 8;
    const int kdst = DS_K + (wv >> 2) * 4096 + (wv & 3) * 1024 + lane * 16, vdst = DS_V + (wv >> 2) * 4096 + (wv & 3) * 1024 + lane * 16;
    const LAS3 unsigned char* kp0 = lds + DS_K + 2 * hi * 1024 + r32 * 16;
    const LAS3 unsigned char* vp0 = lds + DS_V + ((lane >> 4) & 1) * 32 + (lane & 3) * 8 + (4 * hi + ((lane & 15) >> 2)) * 64;
    const unsigned* selrow = SEL + (size_t)(b * SEQ + qw + r32) * 64;
    const int jb = 2111 - (64 + qw + r32 - 4 * hi), cc = (4 - (jb & 3)) & 3;
    const LAS3 float* tqb = tab + cc * DS_CS + jb + cc;
    u32x4 kreg = *(const u32x4*)ksrc; u32x2 vreg0 = *(const u32x2*)vsrc, vreg1 = *(const u32x2*)(vsrc + 4096); u32x4 mwn = *(const u32x4*)selrow;
    *(LAS3 u32x4*)(lds + kdst) = kreg; *(LAS3 u32x4*)(lds + vdst) = fp8x8_to_bf16(vreg0); *(LAS3 u32x4*)(lds + vdst + 8192) = fp8x8_to_bf16(vreg1);
    __syncthreads();
#pragma unroll 1
    for (int t2 = 0; t2 < NT2; ++t2) {
        const int cur = (t2 & 1) * 16384, nxt = 16384 - cur, cur8 = (t2 & 1) * 8192, nxt8 = 8192 - cur8; const u32x4 mw = mwn;
        if (t2 + 1 < NT2) { const size_t o = (size_t)(t2 + 1) * 8192; kreg = *(const u32x4*)(ksrc + o); vreg0 = *(const u32x2*)(vsrc + o); vreg1 = *(const u32x2*)(vsrc + o + 4096);
            mwn = *(const u32x4*)(selrow + 4 * (t2 + 1)); }
        if (2 * t2 <= mylast)
            attn_tile8<true>(st, zref, q8, kp0 + cur8, vp0 + cur, tqb + 128 * t2, mw.x >> (4 * hi), mw.y >> (4 * hi), lds + DS_LUT);
        if (2 * t2 + 1 <= mylast)
            attn_tile8<true>(st, zref, q8, kp0 + cur8 + 4096, vp0 + cur + 8192, tqb + 128 * t2 + 64, mw.z >> (4 * hi), mw.w >> (4 * hi), lds + DS_LUT);
        if (t2 + 1 < NT2) { *(LAS3 u32x4*)(lds + kdst + nxt8) = kreg; *(LAS3 u32x4*)(lds + vdst + nxt) = fp8x8_to_bf16(vreg0); *(LAS3 u32x4*)(lds + vdst + nxt + 8192) = fp8x8_to_bf16(vreg1); }
        __syncthreads();
    }
    float lse2; const float rl = attn_finish8(st, lse2);
    attn_store8(st, rl * (1.0f / D8_SCALE), (unsigned char*)(p.ws + OFF_YA) + (size_t)(b * SEQ + qw + r32) * YAB_LD + h * 64, hi);
}
DEVI void phase_dil_merge(const Params& p) {
    const unsigned char* OG = (const unsigned char*)(p.ws + OFF_OG);
    const float* LSE = (const float*)(p.ws + OFF_LSE); unsigned char* YB = (unsigned char*)(p.ws + OFF_YA) + 512;
    const size_t stride = (size_t)gridDim.x * 512;
    for (size_t i0 = (size_t)blockIdx.x * 512 + opaque_tid(); i0 < (size_t)NTOK * 32; i0 += 2 * stride) {
        float l[2][3]; u32x2 x[2][3];
#pragma unroll
        for (int k = 0; k < 2; ++k) { const size_t i = i0 + k * stride < (size_t)NTOK * 32 ? i0 + k * stride : i0; const size_t tok = i >> 5; const int c8 = (int)(i & 31) * 8, j = c8 >> 6;
#pragma unroll
            for (int g = 0; g < 3; ++g) { l[k][g] = LSE[(size_t)NTOK * 4 * g + tok * 4 + j]; x[k][g] = *(const u32x2*)(OG + (size_t)NTOK * 256 * g + tok * 256 + c8); } }
#pragma unroll
        for (int k = 0; k < 2; ++k) { const size_t i = i0 + k * stride; if (i < (size_t)NTOK * 32) { const size_t tok = i >> 5; const int c8 = (int)(i & 31) * 8;
            const float mx = max3f(l[k][0], l[k][1], l[k][2]); float a0 = __builtin_amdgcn_exp2f(l[k][0] - mx), a1 = __builtin_amdgcn_exp2f(l[k][1] - mx), a2 = __builtin_amdgcn_exp2f(l[k][2] - mx);
            const float inv = 1.0f / (a0 + a1 + a2); a0 *= inv; a1 *= inv; a2 *= inv;
            float v[8];
#pragma unroll
            for (int hw = 0; hw < 2; ++hw) { const unsigned w0 = hw ? x[k][0].y : x[k][0].x, w1 = hw ? x[k][1].y : x[k][1].x, w2 = hw ? x[k][2].y : x[k][2].x;
                const f32x2 p0 = __builtin_amdgcn_cvt_pk_f32_fp8(w0, false), q0 = __builtin_amdgcn_cvt_pk_f32_fp8(w0, true), p1 = __builtin_amdgcn_cvt_pk_f32_fp8(w1, false), q1 = __builtin_amdgcn_cvt_pk_f32_fp8(w1, true),
                            p2 = __builtin_amdgcn_cvt_pk_f32_fp8(w2, false), q2 = __builtin_amdgcn_cvt_pk_f32_fp8(w2, true);
                v[4 * hw] = a0 * p0[0] + a1 * p1[0] + a2 * p2[0]; v[4 * hw + 1] = a0 * p0[1] + a1 * p1[1] + a2 * p2[1]; v[4 * hw + 2] = a0 * q0[0] + a1 * q1[0] + a2 * q2[0]; v[4 * hw + 3] = a0 * q0[1] + a1 * q1[1] + a2 * q2[1]; }
            u32x2 o; o.x = pk4_fp8(v[0], v[1], v[2], v[3]); o.y = pk4_fp8(v[4], v[5], v[6], v[7]);
            *(u32x2*)(YB + tok * YAB_LD + c8) = o; } }
    }
}
DEVI void phase_dsa(const Params& p, LAS3 unsigned char* lds) {
    int hprev = -1;
    for (int u = blockIdx.x; u < BATCH * 8 * 4; u += gridDim.x) {
        const int b = u >> 5, h = (u >> 2) & 7, j = u & 3;
        dsa_unit(p, lds, b, h, j, h != hprev); dsa_unit(p, lds, b, h, 7 - j, false); hprev = h;
    }
}

constexpr int DL_SET = 73728, DL_VOFF = 24576, DL_TAB = 2 * DL_SET;
static_assert(DL_TAB + 12 * 224 * 4 <= LDS_XB, "dilated phase LDS overflow");
struct DilU { bool tB; int b, gj, r, ls, res0, res1, i0, sg0, nst; size_t hb; };
DEVI DilU dil_decode(int u) {
    DilU d; d.tB = (u % 3) == 2; const int ix = d.tB ? u / 3 : (u / 3) * 2 + (u % 3);
    if (!d.tB) { const int e8 = ix & 7; d.gj = (ix >> 3) & 7; d.b = ix >> 6; d.r = (d.gj >> 2) ? 4 : 1; d.ls = SEQ / d.r; const int nb = d.ls >> 8; d.res0 = d.res1 = e8 / nb; d.i0 = (e8 % nb) * 256; d.sg0 = d.i0 == 0 ? 1 : 0; d.nst = 3; }
    else { const int e8 = ix & 7; d.gj = 8 + ((ix >> 3) & 3); d.b = ix >> 5; d.r = 16; d.ls = 128; d.res0 = 2 * e8; d.res1 = 2 * e8 + 1; d.i0 = 0; d.sg0 = 0; d.nst = 2; }
    d.hb = ((size_t)d.gj * BATCH + d.b) * SEQ; return d;
}
DEVI void phase_dil(const Params& p, LAS3 unsigned char* lds) {
    const int tid = opaque_tid(), lane = tid & 63, wv = __builtin_amdgcn_readfirstlane(tid >> 6), r32 = lane & 31, hi = lane >> 5;
    LAS3 float* tabs = (LAS3 float*)(lds + DL_TAB);
    LAS3 float* rb = (LAS3 float*)lds;
    { const float b0 = p.rel_bias[tid], b1 = tid < 128 ? p.rel_bias[512 + tid] : 0.f; rb[tid] = b0; if (tid < 128) rb[512 + tid] = b1; }
    __syncthreads();
    for (int i = tid; i < 12 * 224; i += 512) { const int gj = i / 224, dist = i % 224 - 64, g = gj >> 2;
        tabs[i] = (dist < 0 || dist > 128) ? NEGB : rb[rel_bucket(dist * dil_r(g)) * 20 + 8 + gj] * LOG2E; }
    __syncthreads();
    const unsigned char* DQ = (const unsigned char*)(p.ws + OFF_DIL); const unsigned char* DK = DQ + DIL_SZ; const unsigned char* DV = DK + DIL_SZ;
    unsigned char* OG = (unsigned char*)(p.ws + OFF_OG); float* LSE = (float*)(p.ws + OFF_LSE);
    u32x4 kreg[3]; u32x2 vreg[3][2]; pg::v8i_t q8n;
#define DLU_TS(d_, sg_, s_) ((d_).tB ? 64 * (sg_) : (d_).i0 - 128 + 64 * (2 * (sg_) + (s_)))
#define DLU_LOAD(d_) do { _Pragma("unroll") for (int j_ = 0; j_ < 3; ++j_) { const int sg_ = (d_).sg0 + j_; if (sg_ < (d_).nst) { \
        { const int sl_ = wv >> 2, ts_ = DLU_TS(d_, sg_, sl_); int kk = ts_ + lane; kk = kk < 0 ? 0 : (kk > (d_).ls - 1 ? (d_).ls - 1 : kk); \
          kreg[j_] = *(const u32x4*)(DK + ((d_).hb + (size_t)(sl_ ? (d_).res1 : (d_).res0) * (d_).ls + kk) * 64 + (wv & 3) * 16); } \
        _Pragma("unroll") for (int s_ = 0; s_ < 2; ++s_) { const int ts_ = DLU_TS(d_, sg_, s_); int vk = ts_ + 16 * (wv & 3) + (lane >> 2); vk = vk < 0 ? 0 : (vk > (d_).ls - 1 ? (d_).ls - 1 : vk); \
          vreg[j_][s_] = *(const u32x2*)(DV + ((d_).hb + (size_t)(s_ ? (d_).res1 : (d_).res0) * (d_).ls + vk) * 64 + (wv >> 2) * 32 + (lane & 3) * 8); } } } \
        { const int wres_ = (d_).tB ? ((wv >> 2) ? (d_).res1 : (d_).res0) : (d_).res0, qpos_ = (d_).i0 + ((d_).tB ? 32 * (wv & 3) : 32 * wv) + r32; \
          const unsigned char* qp_ = DQ + ((d_).hb + (size_t)wres_ * (d_).ls + qpos_) * 64 + 32 * hi; q8n.lo = *(const pg::v4i_t*)qp_; q8n.hi = *(const pg::v4i_t*)(qp_ + 16); } } while (0)
#define DLU_WRITE(d_, set_) do { _Pragma("unroll") for (int j_ = 0; j_ < 3; ++j_) { const int sg_ = (d_).sg0 + j_; if (sg_ < (d_).nst) { \
        *(LAS3 u32x4*)(lds + (set_) + (2 * sg_ + (wv >> 2)) * 4096 + (wv & 3) * 1024 + lane * 16) = kreg[j_]; \
        _Pragma("unroll") for (int s_ = 0; s_ < 2; ++s_) *(LAS3 u32x4*)(lds + (set_) + DL_VOFF + (2 * sg_ + s_) * 8192 + (wv >> 2) * 4096 + (wv & 3) * 1024 + lane * 16) = fp8x8_to_bf16(vreg[j_][s_]); } } } while (0)
    int u = blockIdx.x; DilU d = dil_decode(u < 3072 ? u : 0); pg::v8i_t q8;
    if (u < 3072) { DLU_LOAD(d); DLU_WRITE(d, 0); }
    q8 = q8n;
#pragma unroll 1
    for (int it = 0; u < 3072; u += gridDim.x, ++it) {
        const int set = (it & 1) * DL_SET; const int un = u + gridDim.x; const bool has_next = un < 3072;
        DilU dn = dil_decode(has_next ? un : u);
        if (has_next) DLU_LOAD(dn);
        __syncthreads();
        const int g = d.gj >> 2, j = d.gj & 3;
        const int wres = d.tB ? ((wv >> 2) ? d.res1 : d.res0) : d.res0, wq = d.tB ? 32 * (wv & 3) : 32 * wv, qpos = d.i0 + wq + r32;
        const int tlo = wq >> 6, thi = (wq + 159) >> 6;
        AttnState8 st; st.m = 0.f; st.mx = NEGB; st.l = 0.f; bool zref = true;
#pragma unroll
        for (int q = 0; q < 16; ++q) { st.o0[q] = 0.f; st.o1[q] = 0.f; }
        const LAS3 float* tb = (const LAS3 float*)(lds + DL_TAB) + d.gj * 224;
        const LAS3 unsigned char* kp0 = lds + set + 2 * hi * 1024 + r32 * 16;
        const LAS3 unsigned char* vp0 = lds + set + DL_VOFF + ((lane >> 4) & 1) * 32 + (lane & 3) * 8 + (4 * hi + ((lane & 15) >> 2)) * 64;
#pragma unroll 1
        for (int sg = d.sg0; sg < d.nst; ++sg) {
#pragma unroll
            for (int s_ = 0; s_ < 2; ++s_) {
                const int tau = d.tB ? 2 + sg : 2 * sg + s_, ts = DLU_TS(d, sg, s_), T = 2 * sg + s_;
                const bool mine = tau >= tlo && tau <= thi && (!d.tB || s_ == (wv >> 2)) && ts + 63 >= 0;
                if (mine) {
                    if (ts >= 0) attn_tile8<false, 0, false>(st, zref, q8, kp0 + T * 4096, vp0 + T * 8192, tb + 64 + qpos - ts - 4 * hi - 63, 0u, 0u);
                    else { const unsigned long long vm = ~0ull << (-ts);
                        attn_tile8<false, 1, false>(st, zref, q8, kp0 + T * 4096, vp0 + T * 8192, tb + 64 + qpos - ts - 4 * hi - 63, (unsigned)vm >> (4 * hi), (unsigned)(vm >> 32) >> (4 * hi)); }
                }
            }
        }
        float lse2; const float rl = attn_finish8l(st, lse2);
        const int stok = qpos * d.r + wres; const size_t tok = (size_t)d.b * SEQ + stok;
        attn_store8(st, rl * (1.0f / D8_SCALE), OG + ((size_t)g * NTOK + tok) * 256 + j * 64, hi);
        if (hi == 0) LSE[((size_t)g * NTOK + tok) * 4 + j] = lse2;
        if (has_next) DLU_WRITE(dn, DL_SET - set);
        d = dn; q8 = q8n;
    }
#undef DLU_TS
#undef DLU_LOAD
#undef DLU_WRITE
}


#define XB_TMO      128
#define XB_XCNT(j)  (256  + 64 * (j))
#define XB_XSUB(j)  (1280 + 64 * (j))
#define XB_XGEN(j)  (2304 + 64 * (j))
#define XB_TOP      3328
#define XB_TOPGEN   3392
#define XCD_BAR_WORDS 3456
#define XB_SPIN_CAP (1u << 18)
#define LAS __attribute__((address_space(3)))

__device__ __forceinline__ unsigned xb_ld(unsigned* p)              { return __hip_atomic_load(p, __ATOMIC_RELAXED, __HIP_MEMORY_SCOPE_AGENT); }
__device__ __forceinline__ unsigned xb_add(unsigned* p, unsigned v) { return __hip_atomic_fetch_add(p, v, __ATOMIC_RELAXED, __HIP_MEMORY_SCOPE_AGENT); }
__device__ __forceinline__ unsigned xb_xcc_id() { return (unsigned)__builtin_amdgcn_s_getreg((3 << 11) | 20) & 0xFu; }
#define XB_SPIN(cond, bar) do { unsigned _sp = 0; while (cond) { __builtin_amdgcn_s_sleep(1); \
    if ((++_sp & 255u) == 0u) { if (xb_ld(&(bar)[XB_TMO])) break; if (_sp > XB_SPIN_CAP) { atomicAdd(&(bar)[XB_TMO], 1u); break; } } } } while (0)

struct XcdBarrier {
    unsigned* bar; unsigned x;
    volatile LAS unsigned* st;
};

__device__ __forceinline__ XcdBarrier xcd_barrier_post(unsigned* bar, volatile LAS unsigned* st) {
    XcdBarrier b; b.bar = bar; b.x = xb_xcc_id(); b.st = st;
    if (threadIdx.x == 0) (void)xb_add(&bar[XB_XCNT(b.x)], 1u);
    return b;
}
__device__ __forceinline__ void xcd_barrier_complete(unsigned* bar, unsigned x, unsigned& nloc, unsigned& nx) {
    const unsigned G = gridDim.x * gridDim.y * gridDim.z;
    unsigned sum, cnt, mine, sp = 0u;
    for (;;) {
        sum = 0u; cnt = 0u; mine = 0u;
#pragma unroll
        for (unsigned j = 0; j < 16; ++j) { const unsigned c = xb_ld(&bar[XB_XCNT(j)]); sum += c; cnt += (c > 0u) ? 1u : 0u; mine = (j == x) ? c : mine; }
        if (sum == G) break;
        __builtin_amdgcn_s_sleep(1);
        if ((++sp & 255u) == 0u) { if (xb_ld(&bar[XB_TMO])) break; if (sp > XB_SPIN_CAP) { atomicAdd(&bar[XB_TMO], 1u); break; } }
    }
    nloc = mine > 0u ? mine : 1u; nx = cnt > 0u ? cnt : 1u;
}

__device__ __forceinline__ void xcd_barrier(const XcdBarrier& b) {
    asm volatile("s_waitcnt vmcnt(0)" ::: "memory");
    __syncthreads();
    if (threadIdx.x == 0) {
        unsigned* bar = b.bar;
        __builtin_amdgcn_s_waitcnt(0);
        unsigned nloc = b.st[0], nx = b.st[1];
        if (nloc == 0u) { xcd_barrier_complete(bar, b.x, nloc, nx); b.st[0] = nloc; b.st[1] = nx; }
        const unsigned old = xb_add(&bar[XB_XSUB(b.x)], 1u);
        const unsigned gen = old / nloc;
        if (old + 1u == (gen + 1u) * nloc) {
            __builtin_amdgcn_fence(__ATOMIC_RELEASE, "agent");
            asm volatile("s_waitcnt vmcnt(0)" ::: "memory");
            const unsigned og = xb_add(&bar[XB_TOP], 1u);
            const unsigned tg = og / nx;
            if (og + 1u == (tg + 1u) * nx) xb_add(&bar[XB_TOPGEN], 1u);
            else XB_SPIN(xb_ld(&bar[XB_TOPGEN]) == tg, bar);
            __builtin_amdgcn_fence(__ATOMIC_ACQUIRE, "agent");
            xb_add(&bar[XB_XGEN(b.x)], 1u);
            asm volatile("s_waitcnt vmcnt(0)" ::: "memory");
        } else {
            XB_SPIN(xb_ld(&bar[XB_XGEN(b.x)]) == gen, bar);
            __builtin_amdgcn_fence(__ATOMIC_ACQUIRE, "agent");
            asm volatile("s_waitcnt vmcnt(0)" ::: "memory");
        }
    }
    __syncthreads();
}


__global__ void __launch_bounds__(512, 2) fwd(Params p) {
    extern __shared__ __attribute__((aligned(16))) unsigned char smem[];
    LAS3 unsigned char* lds = (LAS3 unsigned char*)smem;
    if (threadIdx.x < 4) ((LAS3 unsigned*)(lds + LDS_XB))[threadIdx.x] = 0u;
    __syncthreads();
    XcdBarrier bar = xcd_barrier_post((unsigned*)(p.ws + OFF_BAR), (volatile LAS unsigned*)(lds + LDS_XB));
    phase_prologue(p, lds);
#if PROBE_DUP == 1
    phase_prologue(p, lds);
#endif
    xcd_barrier(bar);
    phase_proj(p, lds);
    xcd_barrier(bar);
    phase_kv(p, lds);
#if PROBE_DUP == 2
    phase_kv(p, lds);
#endif
    phase_topk(p, lds);
#if PROBE_DUP == 3
    phase_topk(p, lds);
#endif
    __syncthreads();
    phase_dil(p, lds);
#if PROBE_DUP == 4
    __syncthreads(); phase_dil(p, lds);
#endif
    xcd_barrier(bar);
    phase_dil_merge(p);
    phase_dsa(p, lds);
#if PROBE_DUP == 5
    phase_dsa(p, lds);
#endif
    xcd_barrier(bar);
    phase_mix(p, lds);
#if PROBE_DUP == 6
    phase_mix(p, lds);
#endif
    __builtin_amdgcn_fence(__ATOMIC_SEQ_CST, "workgroup"); __syncthreads();
    phase_out(p, lds);
#if PROBE_DUP == 7
    phase_out(p, lds);
#endif
    __builtin_amdgcn_fence(__ATOMIC_SEQ_CST, "workgroup"); __syncthreads();
    phase_route(p, lds);
    phase_expert_weights(p, lds);
#if PROBE_DUP == 11
    phase_expert_weights(p, lds);
#endif
    xcd_barrier(bar);
    build_expert_tables(p, lds);
    phase_gu(p, lds);
#if PROBE_DUP == 8
    phase_gu(p, lds);
#endif
    xcd_barrier(bar);
    phase_down(p, lds);
#if PROBE_DUP == 9
    phase_down(p, lds);
#endif
    xcd_barrier(bar);
    phase_final(p, lds);
#if PROBE_DUP == 10
    phase_final(p, lds);
#endif
}
extern "C" void kernel_launch(void* const* d_in, const int* in_sizes, int n_in, void* d_out, int out_size, void* d_ws, size_t ws_size, hipStream_t stream) {
    Params p{};
    p.x = (const float*)d_in[0]; p.attn_norm = (const float*)d_in[1]; p.w_in = (const float*)d_in[2]; p.kv_norm = (const float*)d_in[3];
    p.w_uk = (const float*)d_in[4]; p.w_uv = (const float*)d_in[5]; p.rel_bias = (const float*)d_in[6]; p.w_a = (const float*)d_in[7]; p.w_b = (const float*)d_in[8];
    p.w_out = (const float*)d_in[9]; p.ffn_norm = (const float*)d_in[10]; p.w_rg = (const float*)d_in[11]; p.b_rg = (const float*)d_in[12]; p.w_re = (const float*)d_in[13];
    p.b_re = (const float*)d_in[14]; p.w_gate = (const float*)d_in[15]; p.w_up = (const float*)d_in[16]; p.w_down = (const float*)d_in[17]; p.final_norm = (const float*)d_in[18];
    p.out = (float*)d_out; p.ws = (char*)d_ws;
    static int grid = 0;
    if (!grid) {
        (void)hipFuncSetAttribute((const void*)fwd, hipFuncAttributeMaxDynamicSharedMemorySize, LDS_TOTAL);
        int dev = 0, cus = 0, per_cu = 0; (void)hipGetDevice(&dev); (void)hipDeviceGetAttribute(&cus, hipDeviceAttributeMultiprocessorCount, dev);
        (void)hipOccupancyMaxActiveBlocksPerMultiprocessor(&per_cu, (const void*)fwd, 512, LDS_TOTAL);
        grid = (cus > 0 ? cus : 256) * (per_cu >= 1 ? 1 : 0);
        if (grid <= 0) { fprintf(stderr, "kernel_launch: fwd does not fit a CU (occupancy query %d)\n", per_cu); grid = -1; }
    }
    if (grid < 0) return;
    (void)hipMemsetAsync((char*)d_ws + OFF_BAR, 0, XCD_BAR_WORDS * sizeof(unsigned), stream);
    (void)hipMemsetAsync((char*)d_ws + OFF_ECNT, 0, 1024, stream);
    fwd<<<grid, 512, LDS_TOTAL, stream>>>(p);
}
```
